# Optimizing an MI355X kernel written in HIP

```python
import math
import jax, jax.numpy as jnp
from jax import lax
import numpy as np

D_MODEL = 2048
BATCH = 1
SEQ = 8192
DEPTH = 1

EPS = 1e-6
D_FF = 5632
HY_WIDTH = 1024
HY_GROUPS = 8
SHORT_CONV = 3
FILTER_EMB = 33
FILTER_HIDDEN = 64
SHORT_DECAY_PCT = 0.3
LONG_DECAY_PCT = 1.5
DECAY_TARGET = 1e-2
GLA_HEADS = 4
GLA_DK = 128
GLA_DV = 256
GLA_KW = GLA_HEADS * GLA_DK
GLA_VW = GLA_HEADS * GLA_DV
GATE_RANK = 16
GATE_TEMP = 16.0
CHUNK = 64
MIX_WIDTH = HY_WIDTH + GLA_VW
IN_COLS = 3 * HY_WIDTH + 2 * GLA_KW + 2 * GLA_VW + 2 * GATE_RANK

kernel_name = 'hyena_gla_macaron_hybrid_block'

F32 = jnp.float32


def rmsnorm(x, g):
    xf = x.astype(F32)
    y = xf * lax.rsqrt(jnp.mean(xf * xf, axis=-1, keepdims=True) + EPS)
    return (y * g.astype(F32)).astype(x.dtype)


def group_rmsnorm(y, g, groups):
    shp = y.shape
    yf = y.astype(F32).reshape(shp[:-1] + (groups, shp[-1] // groups))
    yf = yf * lax.rsqrt(jnp.mean(yf * yf, axis=-1, keepdims=True) + EPS)
    return yf.reshape(shp) * g.astype(F32)


def macaron_half_ffn(x, norm_g, w_gate, w_up, w_down):
    h = rmsnorm(x, norm_g)
    return x + 0.5 * ((jax.nn.silu(h @ w_gate) * (h @ w_up)) @ w_down)


def centred_short_conv(u, w, b):
    L = u.shape[1]
    half = SHORT_CONV // 2
    up = jnp.pad(u, ((0, 0), (half, half), (0, 0)))
    out = b
    for tap in range(SHORT_CONV):
        out = out + up[:, tap:tap + L] * w[tap]
    return out


def hyena_filter(L, w1, b1, f1, w2, b2, f2, w3, b3, f3, w4):
    c = lambda a: a.astype(F32)
    t = jnp.linspace(0.0, 1.0, L, dtype=F32)[:, None]
    bands = (FILTER_EMB - 1) // 2
    freqs = jnp.linspace(1e-4, bands - 1, bands, dtype=F32)[None, :]
    ang = (2.0 * math.pi / L) * jnp.arange(L, dtype=F32)[:, None] * freqs
    z = jnp.concatenate([t, jnp.cos(ang), -jnp.sin(ang)], axis=-1)
    hid = jnp.sin(c(f1) * (z @ c(w1) + c(b1)))
    hid = jnp.sin(c(f2) * (hid @ c(w2) + c(b2)))
    hid = jnp.sin(c(f3) * (hid @ c(w3) + c(b3)))
    h = hid @ c(w4)
    min_decay = math.log(DECAY_TARGET) / LONG_DECAY_PCT
    max_decay = math.log(DECAY_TARGET) / SHORT_DECAY_PCT
    deltas = jnp.abs(jnp.linspace(min_decay, max_decay, HY_WIDTH, dtype=F32))
    window = jnp.exp(-t * deltas[None, :])
    h_fwd = h[:, :HY_WIDTH] * window
    h_bwd = h[:, HY_WIDTH:] * window
    filt = jnp.concatenate([h_fwd, jnp.zeros((1, HY_WIDTH), F32), h_bwd[1:][::-1]], axis=0)
    return filt / jnp.sum(jnp.abs(filt), axis=0, keepdims=True)


def bidir_fft_conv(u, filt):
    L = u.shape[1]
    U = jnp.fft.rfft(u, n=2 * L, axis=1)
    K = jnp.fft.rfft(filt, n=2 * L, axis=0)
    return jnp.fft.irfft(U * K[None], n=2 * L, axis=1)[:, :L]


def hyena_mixer(u, conv_w, conv_b, w1, b1, f1, w2, b2, f2, w3, b3, f3, w4, skip, out_g):
    L = u.shape[1]
    u = centred_short_conv(u, conv_w, conv_b)
    x0, x1, v = jnp.split(u, 3, axis=-1)
    filt = hyena_filter(L, w1, b1, f1, w2, b2, f2, w3, b3, f3, w4)
    z = (v * x1).astype(F32)
    z = bidir_fft_conv(z, filt) + z * skip.astype(F32)
    y = z * x0.astype(F32)
    return group_rmsnorm(y, out_g, HY_GROUPS).astype(u.dtype)


def gla_chunked(q, k, v, g, include_diag):
    B, H, L, dk = q.shape
    dv = v.shape[-1]
    n = L // CHUNK
    rs = lambda a: a.reshape(B, H, n, CHUNK, a.shape[-1])
    q, k, v, g = rs(q), rs(k), rs(v), rs(g)
    b = jnp.cumsum(g, axis=3)
    b_last = b[:, :, :, -1:]
    q_in = q * jnp.exp(b)
    k_in = k * jnp.exp(-b)
    k_st = k * jnp.exp(b_last - b)
    att = jnp.einsum('bhncd,bhnsd->bhncs', q_in, k_in)
    mask = jnp.tril(jnp.ones((CHUNK, CHUNK), dtype=bool), 0 if include_diag else -1)
    att = jnp.where(mask, att, 0.0)
    o_intra = jnp.einsum('bhncs,bhnsv->bhncv', att, v)
    kv = jnp.einsum('bhncd,bhncv->bhndv', k_st, v)
    chunk_decay = jnp.exp(b_last[:, :, :, 0])

    def step(S, inp):
        q_c, dec_c, kv_c = inp
        o = jnp.einsum('bhcd,bhdv->bhcv', q_c, S)
        S = dec_c[..., None] * S + kv_c
        return S, o

    xs = (jnp.moveaxis(q_in, 2, 0), jnp.moveaxis(chunk_decay, 2, 0), jnp.moveaxis(kv, 2, 0))
    _, o_inter = lax.scan(step, jnp.zeros((B, H, dk, dv), F32), xs)
    o = o_intra + jnp.moveaxis(o_inter, 0, 2)
    return o.reshape(B, H, L, dv)


def gla_mixer(q, k, v, r, lr_f, lr_b, w_a2_f, b_a_f, w_a2_b, b_a_b, out_g):
    B, L, _ = q.shape
    heads = lambda a, d: a.astype(F32).reshape(B, L, GLA_HEADS, d).transpose(0, 2, 1, 3)
    g_f = jax.nn.log_sigmoid((lr_f @ w_a2_f + b_a_f).astype(F32)) / GATE_TEMP
    g_b = jax.nn.log_sigmoid((lr_b @ w_a2_b + b_a_b).astype(F32)) / GATE_TEMP
    qh = heads(q, GLA_DK) * (GLA_DK ** -0.5)
    kh = heads(k, GLA_DK)
    vh = heads(v, GLA_DV)
    gf = heads(g_f, GLA_DK)
    gb = heads(g_b, GLA_DK)
    flip = lambda a: a[:, :, ::-1]
    o_f = gla_chunked(qh, kh, vh, gf, True)
    o_b = flip(gla_chunked(flip(qh), flip(kh), flip(vh), flip(gb), False))
    o = (o_f + o_b).transpose(0, 2, 1, 3).reshape(B, L, GLA_VW)
    o = group_rmsnorm(o, out_g, GLA_HEADS)
    return (o * jax.nn.silu(r.astype(F32))).astype(q.dtype)


def setup_inputs(seed: int = 0) -> dict:
    key = jax.random.key(seed)
    ks = jax.random.split(key, 40)
    ctr = [0]

    def nxt():
        ctr[0] += 1
        return ks[ctr[0] - 1]

    def nrm(shape, scale):
        return scale * jax.random.normal(nxt(), shape, F32)

    def gain(shape):
        return 1.0 + 0.01 * jax.random.normal(nxt(), shape, F32)

    Dp = DEPTH
    return {
        'x': jax.random.normal(nxt(), (BATCH, SEQ, D_MODEL), F32),
        'ffn1_norm': gain((Dp, D_MODEL)),
        'ffn1_w_gate': nrm((Dp, D_MODEL, D_FF), D_MODEL ** -0.5),
        'ffn1_w_up': nrm((Dp, D_MODEL, D_FF), D_MODEL ** -0.5),
        'ffn1_w_down': nrm((Dp, D_FF, D_MODEL), D_FF ** -0.5),
        'mix_norm': gain((Dp, D_MODEL)),
        'w_in': nrm((Dp, D_MODEL, IN_COLS), D_MODEL ** -0.5),
        'hy_conv_w': nrm((Dp, SHORT_CONV, 3 * HY_WIDTH), SHORT_CONV ** -0.5),
        'hy_conv_b': nrm((Dp, 3 * HY_WIDTH), 0.02),
        'flt_w1': nrm((Dp, FILTER_EMB, FILTER_HIDDEN), FILTER_EMB ** -0.5),
        'flt_b1': nrm((Dp, FILTER_HIDDEN), 0.02),
        'flt_f1': gain((Dp, FILTER_HIDDEN)),
        'flt_w2': nrm((Dp, FILTER_HIDDEN, FILTER_HIDDEN), FILTER_HIDDEN ** -0.5),
        'flt_b2': nrm((Dp, FILTER_HIDDEN), 0.02),
        'flt_f2': gain((Dp, FILTER_HIDDEN)),
        'flt_w3': nrm((Dp, FILTER_HIDDEN, FILTER_HIDDEN), FILTER_HIDDEN ** -0.5),
        'flt_b3': nrm((Dp, FILTER_HIDDEN), 0.02),
        'flt_f3': gain((Dp, FILTER_HIDDEN)),
        'flt_w4': nrm((Dp, FILTER_HIDDEN, 2 * HY_WIDTH), FILTER_HIDDEN ** -0.5),
        'hy_skip': nrm((Dp, HY_WIDTH), 1.0),
        'hy_out_norm': gain((Dp, HY_WIDTH)),
        'gla_w_a2_f': nrm((Dp, GATE_RANK, GLA_KW), GATE_RANK ** -0.5),
        'gla_b_a_f': nrm((Dp, GLA_KW), 0.1),
        'gla_w_a2_b': nrm((Dp, GATE_RANK, GLA_KW), GATE_RANK ** -0.5),
        'gla_b_a_b': nrm((Dp, GLA_KW), 0.1),
        'gla_out_norm': gain((Dp, GLA_VW)),
        'w_out': nrm((Dp, MIX_WIDTH, D_MODEL), MIX_WIDTH ** -0.5),
        'ffn2_norm': gain((Dp, D_MODEL)),
        'ffn2_w_gate': nrm((Dp, D_MODEL, D_FF), D_MODEL ** -0.5),
        'ffn2_w_up': nrm((Dp, D_MODEL, D_FF), D_MODEL ** -0.5),
        'ffn2_w_down': nrm((Dp, D_FF, D_MODEL), D_FF ** -0.5),
        'final_norm': gain((D_MODEL,)),
    }


def reference(x, ffn1_norm, ffn1_w_gate, ffn1_w_up, ffn1_w_down, mix_norm, w_in,
              hy_conv_w, hy_conv_b, flt_w1, flt_b1, flt_f1, flt_w2, flt_b2, flt_f2,
              flt_w3, flt_b3, flt_f3, flt_w4, hy_skip, hy_out_norm,
              gla_w_a2_f, gla_b_a_f, gla_w_a2_b, gla_b_a_b, gla_out_norm, w_out,
              ffn2_norm, ffn2_w_gate, ffn2_w_up, ffn2_w_down, final_norm):
    split_sizes = [3 * HY_WIDTH, GLA_KW, GLA_KW, GLA_VW, GLA_VW, GATE_RANK, GATE_RANK]
    split_idx = [int(i) for i in np.cumsum(split_sizes)[:-1]]
    for l in range(DEPTH):
        x = macaron_half_ffn(x, ffn1_norm[l], ffn1_w_gate[l], ffn1_w_up[l], ffn1_w_down[l])
        h = rmsnorm(x, mix_norm[l])
        p = h @ w_in[l]
        p_hy, q, k, v, r, lr_f, lr_b = jnp.split(p, split_idx, axis=-1)
        y_hy = hyena_mixer(p_hy, hy_conv_w[l], hy_conv_b[l],
                           flt_w1[l], flt_b1[l], flt_f1[l], flt_w2[l], flt_b2[l], flt_f2[l],
                           flt_w3[l], flt_b3[l], flt_f3[l], flt_w4[l], hy_skip[l], hy_out_norm[l])
        y_gla = gla_mixer(q, k, v, r, lr_f, lr_b, gla_w_a2_f[l], gla_b_a_f[l],
                          gla_w_a2_b[l], gla_b_a_b[l], gla_out_norm[l])
        x = x + jnp.concatenate([y_hy, y_gla], axis=-1) @ w_out[l]
        x = macaron_half_ffn(x, ffn2_norm[l], ffn2_w_gate[l], ffn2_w_up[l], ffn2_w_down[l])
    return rmsnorm(x, final_norm)
```

```cpp
#include <hip/hip_runtime.h>
#include <hip/hip_cooperative_groups.h>
#include <cstdio>
#include <cstdint>
namespace cg = cooperative_groups;

namespace pg8 {
#define PG8_LAS __attribute__((address_space(3)))
typedef unsigned short bf16_t;
typedef short bf16x8 __attribute__((ext_vector_type(8)));
typedef float f32x4 __attribute__((ext_vector_type(4)));
typedef unsigned u32x4 __attribute__((ext_vector_type(4)));
constexpr int BM = 256, BK = 64, HALF = 128, HTB = HALF * BK * 2  , STAGE_BYTES = 8 * HTB, NXCD = 8, WGM = 8;

__host__ __device__ __forceinline__ int lds_byte(int r, int c) { const int st = (r >> 4) * 2 + (c >> 5), rr = r & 15, cc = c & 31, ob = rr * 64 + cc * 2; return st * 1024 + (ob ^ (((ob >> 9) & 1) << 5)); }
__host__ __device__ __forceinline__ void stage_rc(int b, int& R, int& C) { const int st = b / 1024, sb = b % 1024, swz = sb ^ (((sb >> 9) & 1) << 5); R = (st >> 1) * 16 + swz / 64; C = (st & 1) * 32 + (swz % 64) / 2; }
__host__ __device__ __forceinline__ int perm32(int rho) { const int n = rho >> 4, i = rho & 15; return 8 * (i >> 2) + 4 * n + (i & 3); }

struct Unit { int pm, pn; };
struct Gemm { const bf16_t* A; const bf16_t* Bt; int M, N, K; };

struct StaticOrder {
    int nM, nN, nwg, G, c;
    __host__ __device__ void init(int M, int N, int G_, int c_) { nM = M / BM; nN = N / BM; nwg = nM * nN; G = G_; c = c_; }
    __host__ __device__ bool next(int i, Unit& u) const {
        const long L = (long)i * G + c; if (L >= nwg) return false;
        int wgid = (int)L; { const int q = nwg / NXCD, r = nwg % NXCD, xcd = wgid % NXCD, off = wgid / NXCD; wgid = (xcd < r ? xcd * (q + 1) : r * (q + 1) + (xcd - r) * q) + off; }
        const int nig = WGM * nN, gid = wgid / nig, fm = gid * WGM, gsz = (nM - fm) < WGM ? (nM - fm) : WGM;
        u.pm = fm + ((wgid % nig) % gsz); u.pn = (wgid % nig) / gsz; return true;
    }
    __device__ __forceinline__ void a_ready(const Unit&) const {}
    __device__ __forceinline__ void done(const Unit&) const {}
};
__device__ __forceinline__ unsigned cvt_pk_bf16(float lo, float hi) { unsigned r; asm volatile("v_cvt_pk_bf16_f32 %0, %1, %2" : "=v"(r) : "v"(lo), "v"(hi)); return r; }
typedef unsigned u32x4 __attribute__((ext_vector_type(4)));
typedef unsigned u32x2 __attribute__((ext_vector_type(2)));
__device__ __forceinline__ float rstd_of(float ss) { return rsqrtf(ss * (1.0f / 2048.0f) + 1e-6f); }
__device__ __forceinline__ float silu_f(float x) { return x * __builtin_amdgcn_rcpf(1.0f + __expf(-x)); }

struct EpiSwiGLU {
    static constexpr bool PERM = true, AFTER_DRAIN = false;
    bf16_t* O; int ldc; const float* rowss;
    __device__ __forceinline__ void operator()(const f32x4 (&acc)[2][2][4][2], const Unit& u, int wr, int wc, int fr, int fq) const {
        const int row0 = u.pm * BM + wr * 64 + fr, col0 = u.pn * 128 + wc * 32 + 8 * fq;
#pragma unroll
        for (int ai = 0; ai < 2; ++ai)
#pragma unroll
            for (int m = 0; m < 4; ++m) {
                const int row = row0 + ai * HALF + m * 16; const float rs = rstd_of(rowss[row]);
                float v[8];
#pragma unroll
                for (int n = 0; n < 2; ++n)
#pragma unroll
                    for (int j = 0; j < 4; ++j) v[n * 4 + j] = silu_f(acc[ai][0][m][n][j] * rs) * (acc[ai][1][m][n][j] * rs);
                u32x4 w; w.x = cvt_pk_bf16(v[0], v[1]); w.y = cvt_pk_bf16(v[2], v[3]); w.z = cvt_pk_bf16(v[4], v[5]); w.w = cvt_pk_bf16(v[6], v[7]);
                *(u32x4*)(O + (size_t)row * ldc + col0) = w;
            }
    }
};
struct EpiResid {
    static constexpr bool PERM = false, AFTER_DRAIN = false;
    const float* base; const bf16_t* base16; bf16_t* ob; float* rowss; float scale;
    __device__ __forceinline__ void operator()(const f32x4 (&acc)[2][2][4][2], const Unit& u, int wr, int wc, int fr, int fq) const {
        const int row0 = u.pm * BM + wr * 64 + fr, col0 = u.pn * BM + wc * 32 + 4 * fq;
#pragma unroll
        for (int ai = 0; ai < 2; ++ai)
#pragma unroll
            for (int m = 0; m < 4; ++m) {
                const int row = row0 + ai * HALF + m * 16; float ss = 0.f;
#pragma unroll
                for (int bj = 0; bj < 2; ++bj)
#pragma unroll
                    for (int n = 0; n < 2; ++n) {
                        const size_t off = (size_t)row * 2048 + col0 + bj * HALF + n * 16;
                        f32x4 b;
                        if (base) b = __builtin_nontemporal_load((const f32x4*)(base + off));
                        else { const u32x2 r = *(const u32x2*)(base16 + off); b = (f32x4){__builtin_bit_cast(float, r.x << 16), __builtin_bit_cast(float, r.x & 0xffff0000u), __builtin_bit_cast(float, r.y << 16), __builtin_bit_cast(float, r.y & 0xffff0000u)}; }
                        const f32x4 v = b + acc[ai][bj][m][n] * scale;
                        { u32x2 w; w.x = cvt_pk_bf16(v[0], v[1]); w.y = cvt_pk_bf16(v[2], v[3]); *(u32x2*)(ob + off) = w; }
                        ss += (v[0] * v[0] + v[1] * v[1]) + (v[2] * v[2] + v[3] * v[3]);
                    }
                ss += __shfl_xor(ss, 16); ss += __shfl_xor(ss, 32);
                if (rowss && fq == 0) atomicAdd(rowss + row, ss);
            }
    }
};
struct EpiP {
    static constexpr bool PERM = true, AFTER_DRAIN = false;
    bf16_t* phy; bf16_t* pr; const float* rowss;
    __device__ __forceinline__ void operator()(const f32x4 (&acc)[2][2][4][2], const Unit& u, int wr, int wc, int fr, int fq) const {
        const int row0 = u.pm * BM + wr * 64 + fr;
        bf16_t* O; int ldc, colt;
        if (u.pn < 12) { O = phy; ldc = 3072; colt = u.pn * BM; } else { O = pr; ldc = 3072; colt = (u.pn - 12) * BM; }
        const int col0 = colt + wc * 32 + 8 * fq;
#pragma unroll
        for (int ai = 0; ai < 2; ++ai)
#pragma unroll
            for (int m = 0; m < 4; ++m) {
                const int row = row0 + ai * HALF + m * 16; const float rs = rstd_of(rowss[row]);
#pragma unroll
                for (int bj = 0; bj < 2; ++bj) {
                    const f32x4 v0 = acc[ai][bj][m][0] * rs, v1 = acc[ai][bj][m][1] * rs;
                    u32x4 w; w.x = cvt_pk_bf16(v0[0], v0[1]); w.y = cvt_pk_bf16(v0[2], v0[3]); w.z = cvt_pk_bf16(v1[0], v1[1]); w.w = cvt_pk_bf16(v1[2], v1[3]);
                    *(u32x4*)(O + (size_t)row * ldc + col0 + bj * HALF) = w;
                }
            }
    }
};

struct EpiFilt {
    static constexpr bool PERM = false, AFTER_DRAIN = false;
    bf16_t* Ff; bf16_t* Fb0; bf16_t* Fb1;
    __device__ __forceinline__ void operator()(const f32x4 (&acc)[2][2][4][2], const Unit& u, int wr, int wc, int fr, int fq) const {
        const int row0 = u.pm * BM + wr * 64 + fr, col0 = u.pn * BM + wc * 32 + 4 * fq;
        const float dmin = -3.0701134573253945f, dmax = -15.350567286626973f;
#pragma unroll
        for (int ai = 0; ai < 2; ++ai)
#pragma unroll
            for (int m = 0; m < 4; ++m) {
                const int cc = row0 + ai * HALF + m * 16, c = cc & 1023;
                const float del = __builtin_fabsf(dmin + (float)c * ((dmax - dmin) / 1023.0f)) * (1.0f / 8191.0f);
                bf16_t* dst = cc < 1024 ? Ff + (size_t)c * 8192 : (c < 768 ? Fb0 + (size_t)c * 8192 : Fb1 + (size_t)(c - 768) * 8192);
#pragma unroll
                for (int bj = 0; bj < 2; ++bj)
#pragma unroll
                    for (int n = 0; n < 2; ++n) {
                        const int i = col0 + bj * HALF + n * 16; f32x4 v = acc[ai][bj][m][n];
#pragma unroll
                        for (int j = 0; j < 4; ++j) v[j] *= __expf(-(float)(i + j) * del);
                        { u32x2 w; w.x = cvt_pk_bf16(v[0], v[1]); w.y = cvt_pk_bf16(v[2], v[3]); *(u32x2*)(dst + i) = w; }
                    }
            }
    }
};

struct EpiFinal {
    static constexpr bool PERM = false, AFTER_DRAIN = false;
    const bf16_t* base16; float* out; float* rowss; unsigned* cnt; const float* g; float scale;
    __device__ __forceinline__ void operator()(f32x4 (&acc)[2][2][4][2], const Unit& u, int wr, int wc, int fr, int fq) const {
        const int row0 = u.pm * BM + wr * 64 + fr, col0 = u.pn * BM + wc * 32 + 4 * fq;
#pragma unroll
        for (int ai = 0; ai < 2; ++ai)
#pragma unroll
            for (int m = 0; m < 4; ++m) {
                const int row = row0 + ai * HALF + m * 16; float ss = 0.f;
#pragma unroll
                for (int bj = 0; bj < 2; ++bj)
#pragma unroll
                    for (int n = 0; n < 2; ++n) {
                        const size_t off = (size_t)row * 2048 + col0 + bj * HALF + n * 16;
                        const u32x2 r = *(const u32x2*)(base16 + off);
                        const f32x4 v = (f32x4){__builtin_bit_cast(float, r.x << 16), __builtin_bit_cast(float, r.x & 0xffff0000u), __builtin_bit_cast(float, r.y << 16), __builtin_bit_cast(float, r.y & 0xffff0000u)} + acc[ai][bj][m][n] * scale;
                        acc[ai][bj][m][n] = v; ss += (v[0] * v[0] + v[1] * v[1]) + (v[2] * v[2] + v[3] * v[3]);
                    }
                ss += __shfl_xor(ss, 16); ss += __shfl_xor(ss, 32);
                if (fq == 0) atomicAdd(rowss + row, ss);
            }
        asm volatile("s_waitcnt vmcnt(0)" ::: "memory");
        __syncthreads();
        if (threadIdx.x == 0) {
            unsigned* c = cnt + 64 * u.pm;
            __builtin_amdgcn_fence(__ATOMIC_RELEASE, "agent"); asm volatile("s_waitcnt vmcnt(0)" ::: "memory");
            __hip_atomic_fetch_add(c, 1u, __ATOMIC_RELAXED, __HIP_MEMORY_SCOPE_AGENT);
            unsigned spins = 0;
            while (__hip_atomic_load(c, __ATOMIC_RELAXED, __HIP_MEMORY_SCOPE_AGENT) < 8u) { __builtin_amdgcn_s_sleep(2); if (++spins > (1u << 22)) break; }
            __builtin_amdgcn_fence(__ATOMIC_ACQUIRE, "agent"); asm volatile("s_waitcnt vmcnt(0)" ::: "memory");
        }
        __syncthreads();
#pragma unroll
        for (int ai = 0; ai < 2; ++ai)
#pragma unroll
            for (int m = 0; m < 4; ++m) {
                const int row = row0 + ai * HALF + m * 16; const float rs = rstd_of(__hip_atomic_load(rowss + row, __ATOMIC_RELAXED, __HIP_MEMORY_SCOPE_AGENT));
#pragma unroll
                for (int bj = 0; bj < 2; ++bj)
#pragma unroll
                    for (int n = 0; n < 2; ++n) {
                        const int col = col0 + bj * HALF + n * 16; const f32x4 gg = *(const f32x4*)(g + col);
                        __builtin_nontemporal_store(acc[ai][bj][m][n] * rs * gg, (f32x4*)(out + (size_t)row * 2048 + col));
                    }
            }
    }
};
template <class Epi, class Sched, bool ALIGN_EPI = false, bool SP2 = false>
__device__ __forceinline__ void gemm_phase(PG8_LAS unsigned char* lds, const Gemm g, const Sched& S, const Epi& E) {
    int tid_ = threadIdx.x; asm volatile("" : "+v"(tid_));
    const int tid = tid_, wid = __builtin_amdgcn_readfirstlane(tid >> 6), lane = tid & 63, wr = wid >> 2, wc = wid & 3, fr = lane & 15, fq = lane >> 4;
    const int K = g.K, nt = K / BK;
    unsigned voffA[2], voffB[2];
#pragma unroll
    for (int i = 0; i < 2; ++i) { int R, C; stage_rc(tid * 16 + i * 8192, R, C); const int Rb = Epi::PERM ? ((R & ~31) + perm32(R & 31)) : R;
        voffA[i] = (unsigned)(R * K + C) * 2u; voffB[i] = (unsigned)(Rb * K + C) * 2u; }
    const size_t kstep = (size_t)(BK * 2);
    const size_t hstep = (size_t)HALF * K * 2;
    const size_t tstep = 2 * hstep;
    const unsigned ldsw = (unsigned)wid * 1024u;
    const int aoff = lds_byte(wr * 64 + fr, fq * 8), boff = lds_byte(wc * 32 + fr, fq * 8);
#define PG8_SA(b, h) (((b) * 2 + (h)) * HTB)
#define PG8_SB(b, h) ((4 + (b) * 2 + (h)) * HTB)
#define PG8_STAGE(bufoff, gbase, voff) do { _Pragma("unroll") for (int _i = 0; _i < 2; ++_i) \
        __builtin_amdgcn_global_load_lds((const unsigned*)((const char*)(gbase) + (voff)[_i]), (PG8_LAS unsigned*)(lds + (bufoff) + ldsw + _i * 8192), 16, 0, 0); } while (0)
#define PG8_LDA(dst, b, h) do { _Pragma("unroll") for (int m = 0; m < 4; ++m) _Pragma("unroll") for (int k = 0; k < 2; ++k) dst[m][k] = *(const PG8_LAS bf16x8*)(lds + PG8_SA(b, h) + aoff + m * 2048 + k * 1024); } while (0)
#define PG8_LDB(dst, b, h) do { _Pragma("unroll") for (int n = 0; n < 2; ++n) _Pragma("unroll") for (int k = 0; k < 2; ++k) dst[n][k] = *(const PG8_LAS bf16x8*)(lds + PG8_SB(b, h) + boff + n * 2048 + k * 1024); } while (0)
#define PG8_MMA(ai, bj, At, Bt) do { __builtin_amdgcn_s_setprio(1); _Pragma("unroll") for (int m = 0; m < 4; ++m) _Pragma("unroll") for (int n = 0; n < 2; ++n) _Pragma("unroll") for (int k = 0; k < 2; ++k) \
        acc[ai][bj][m][n] = __builtin_amdgcn_mfma_f32_16x16x32_bf16(Bt[n][k], At[m][k], acc[ai][bj][m][n], 0, 0, 0); __builtin_amdgcn_s_setprio(0); } while (0)
#define PG8_WAIT_V(n) asm volatile("s_waitcnt vmcnt(" #n ")" ::: "memory")
#define PG8_WAIT_L(n) asm volatile("s_waitcnt lgkmcnt(" #n ")" ::: "memory")
#define PG8_BAR __builtin_amdgcn_s_barrier()
#define PG8_SCHED __builtin_amdgcn_sched_barrier(0)
    Unit cur, nxt; int ui = 0;
    if (!S.next(0, cur)) return;
    f32x4 acc[2][2][4][2];
#pragma unroll
    for (int a = 0; a < 2; ++a)
#pragma unroll
        for (int b = 0; b < 2; ++b)
#pragma unroll
            for (int m = 0; m < 4; ++m)
#pragma unroll
                for (int n = 0; n < 2; ++n) acc[a][b][m][n] = (f32x4){0.f, 0.f, 0.f, 0.f};
    bf16x8 At[4][2], B0[2][2], B1[2][2];
    const char* cA = (const char*)g.A + (size_t)cur.pm * tstep; const char* cB = (const char*)g.Bt + (size_t)cur.pn * tstep;
    S.a_ready(cur);
    if constexpr (SP2) {
        PG8_STAGE(PG8_SB(0, 0), cB, voffB); PG8_STAGE(PG8_SB(0, 1), cB + hstep, voffB); PG8_STAGE(PG8_SA(0, 0), cA, voffA); PG8_STAGE(PG8_SA(0, 1), cA + hstep, voffA);
        if (wr == 1) PG8_BAR;
        PG8_WAIT_V(2); PG8_BAR;
        PG8_STAGE(PG8_SB(1, 0), cB + kstep, voffB); PG8_STAGE(PG8_SA(1, 0), cA + kstep, voffA); PG8_STAGE(PG8_SB(1, 1), cB + hstep + kstep, voffB);
        PG8_WAIT_V(6); PG8_BAR;
    } else {
        PG8_STAGE(PG8_SB(0, 0), cB, voffB); PG8_STAGE(PG8_SA(0, 0), cA, voffA); PG8_STAGE(PG8_SB(0, 1), cB + hstep, voffB); PG8_STAGE(PG8_SA(0, 1), cA + hstep, voffA);
        if (wr == 1) PG8_BAR;
        PG8_WAIT_V(4); PG8_BAR;
        PG8_STAGE(PG8_SB(1, 0), cB + kstep, voffB); PG8_STAGE(PG8_SA(1, 0), cA + kstep, voffA); PG8_STAGE(PG8_SB(1, 1), cB + hstep + kstep, voffB);
        PG8_WAIT_V(6); PG8_BAR;
    }
    for (;;) {
        const bool has_next = S.next(ui + 1, nxt);
        const char* nA = has_next ? (const char*)g.A + (size_t)nxt.pm * tstep : cA; const char* nB = has_next ? (const char*)g.Bt + (size_t)nxt.pn * tstep : cB;
        for (int t = 0; t < nt; t += 2) {
            const bool last = (t == nt - 2);
            const char* a1 = cA + (size_t)(t + 1) * kstep;
            const char* a2 = last ? nA : cA + (size_t)(t + 2) * kstep; const char* b2 = last ? nB : cB + (size_t)(t + 2) * kstep;
            const char* a3 = a2 + kstep; const char* b3 = b2 + kstep;
            if (last && has_next) S.a_ready(nxt);
            if constexpr (SP2) {
            PG8_LDB(B0, 0, 0); PG8_LDB(B1, 0, 1); PG8_SCHED; PG8_LDA(At, 0, 0); PG8_STAGE(PG8_SA(1, 1), a1 + hstep, voffA);
            PG8_WAIT_V(8); PG8_WAIT_L(0); PG8_BAR; PG8_MMA(0, 0, At, B0); PG8_MMA(0, 1, At, B1); PG8_BAR; PG8_SCHED;
            PG8_LDA(At, 0, 1); PG8_STAGE(PG8_SB(0, 0), b2, voffB); PG8_STAGE(PG8_SB(0, 1), b2 + hstep, voffB); PG8_STAGE(PG8_SA(0, 0), a2, voffA);
            PG8_WAIT_V(8); PG8_WAIT_L(0); PG8_BAR; PG8_MMA(1, 0, At, B0); PG8_MMA(1, 1, At, B1); PG8_BAR; PG8_SCHED;
            PG8_LDB(B0, 1, 0); PG8_LDB(B1, 1, 1); PG8_SCHED; PG8_LDA(At, 1, 0); PG8_STAGE(PG8_SA(0, 1), a2 + hstep, voffA);
            PG8_WAIT_V(8); PG8_WAIT_L(0); PG8_BAR; PG8_MMA(0, 0, At, B0); PG8_MMA(0, 1, At, B1); PG8_BAR; PG8_SCHED;
            PG8_LDA(At, 1, 1); PG8_STAGE(PG8_SB(1, 0), b3, voffB); PG8_STAGE(PG8_SB(1, 1), b3 + hstep, voffB); PG8_STAGE(PG8_SA(1, 0), a3, voffA);
            PG8_WAIT_V(8); PG8_WAIT_L(0); PG8_BAR; PG8_MMA(1, 0, At, B0); PG8_MMA(1, 1, At, B1); PG8_BAR; PG8_SCHED;
            } else {
            PG8_LDB(B0, 0, 0); PG8_SCHED; PG8_LDA(At, 0, 0); PG8_STAGE(PG8_SA(1, 1), a1 + hstep, voffA);
            PG8_WAIT_L(8); PG8_BAR; PG8_WAIT_L(0); PG8_MMA(0, 0, At, B0); PG8_BAR; PG8_SCHED;
            PG8_LDB(B1, 0, 1); PG8_STAGE(PG8_SB(0, 0), b2, voffB);
            PG8_BAR; PG8_WAIT_L(0); PG8_MMA(0, 1, At, B1); PG8_BAR;
            PG8_LDA(At, 0, 1); PG8_STAGE(PG8_SA(0, 0), a2, voffA);
            PG8_BAR; PG8_WAIT_L(0); PG8_MMA(1, 0, At, B0); PG8_BAR; PG8_SCHED;
            PG8_STAGE(PG8_SB(0, 1), b2 + hstep, voffB);
            PG8_WAIT_V(6); PG8_BAR; PG8_MMA(1, 1, At, B1); PG8_BAR;
            PG8_LDB(B0, 1, 0); PG8_SCHED; PG8_LDA(At, 1, 0); PG8_STAGE(PG8_SA(0, 1), a2 + hstep, voffA);
            PG8_WAIT_L(8); PG8_BAR; PG8_WAIT_L(0); PG8_MMA(0, 0, At, B0); PG8_BAR; PG8_SCHED;
            PG8_LDB(B1, 1, 1); PG8_STAGE(PG8_SB(1, 0), b3, voffB);
            PG8_BAR; PG8_WAIT_L(0); PG8_MMA(0, 1, At, B1); PG8_BAR;
            PG8_LDA(At, 1, 1); PG8_STAGE(PG8_SA(1, 0), a3, voffA);
            PG8_BAR; PG8_WAIT_L(0); PG8_MMA(1, 0, At, B0); PG8_BAR; PG8_SCHED;
            PG8_STAGE(PG8_SB(1, 1), b3 + hstep, voffB);
            PG8_WAIT_V(6); PG8_BAR; PG8_MMA(1, 1, At, B1); PG8_BAR;
            }
        }
        if constexpr (ALIGN_EPI) { if (wr == 0) PG8_BAR; }
        if constexpr (!Epi::AFTER_DRAIN) { E(acc, cur, wr, wc, fr, fq); S.done(cur); }
        if (!has_next) break;
#pragma unroll
        for (int a = 0; a < 2; ++a)
#pragma unroll
            for (int b = 0; b < 2; ++b)
#pragma unroll
                for (int m = 0; m < 4; ++m)
#pragma unroll
                    for (int n = 0; n < 2; ++n) acc[a][b][m][n] = (f32x4){0.f, 0.f, 0.f, 0.f};
        cur = nxt; cA = nA; cB = nB; ++ui;
        if constexpr (ALIGN_EPI) { if (wr == 1) PG8_BAR; }
    }
    PG8_WAIT_V(0);
    if constexpr (!ALIGN_EPI) { if (wr == 0) PG8_BAR; }
    PG8_BAR;
    if constexpr (Epi::AFTER_DRAIN) { E.fused(acc, cur, wr, wc, fr, fq, lds, wid, lane); S.done(cur); }
#undef PG8_SA
#undef PG8_SB
#undef PG8_STAGE
#undef PG8_LDA
#undef PG8_LDB
#undef PG8_MMA
#undef PG8_WAIT_V
#undef PG8_WAIT_L
#undef PG8_BAR
#undef PG8_SCHED
}
}
using pg8::silu_f;

constexpr int L = 8192, DM = 2048, FF = 5632, NIN = 6176, NING = 6144, HYW = 1024;
constexpr int PHY_LD = 3072, PR_LD = 3072;
constexpr int PR_Q = 0, PR_K = 512, PR_V = 1024, PR_R = 2048;
constexpr int NT = 512;
constexpr int LDS_BYTES = 147456;
constexpr int FN = 16384;

constexpr size_t MiB = 1u << 20;
constexpr size_t WS_ROWSS = 0;
constexpr size_t WS_DEC = 128 * 1024;
constexpr size_t WS_PCNT = 640 * 1024 + 16384;
constexpr size_t WS_BAR = 640 * 1024;
constexpr size_t WS_W4T = 1 * MiB;
constexpr size_t WS_HID = 2 * MiB;
constexpr size_t WS_SK = 6 * MiB;
constexpr size_t SK_STRIDE = 8448;
constexpr size_t WS_WFF = 39 * MiB;
constexpr size_t WS_WDN = WS_WFF + 44 * MiB;
constexpr size_t WS_ST = WS_WFF;
constexpr size_t WS_WIN = 105 * MiB;
constexpr size_t WS_WOUT = 130 * MiB;
constexpr size_t WS_XB = 138 * MiB;
constexpr size_t WS_A = 170 * MiB;
constexpr size_t WS_ZT = WS_A;
constexpr size_t WS_X0T = WS_A + 32 * MiB;
constexpr size_t WS_PHY = 258 * MiB;
constexpr size_t WS_MIX = WS_PHY;
constexpr size_t WS_PR = 306 * MiB;
constexpr size_t WS_LR = WS_PR + 48 * MiB;
constexpr size_t WS_END = 358 * MiB;

typedef unsigned short bf16_t;
typedef short bf16x8 __attribute__((ext_vector_type(8)));
typedef float f32x4 __attribute__((ext_vector_type(4)));
typedef unsigned u32x4 __attribute__((ext_vector_type(4)));
typedef unsigned u32x2 __attribute__((ext_vector_type(2)));
#define LAS __attribute__((address_space(3)))
typedef float c2 __attribute__((ext_vector_type(2)));
__device__ __forceinline__ c2 mk2(float a, float b) { return (c2){a, b}; }
#define LDS_WAIT() asm volatile("s_waitcnt lgkmcnt(0)" ::: "memory")

__device__ __forceinline__ unsigned f2bf(float f) { unsigned u = __builtin_bit_cast(unsigned, f); return (u + 0x7fffu + ((u >> 16) & 1u)) >> 16; }
__device__ __forceinline__ unsigned pk2(float lo, float hi) { return f2bf(lo) | (f2bf(hi) << 16); }
__device__ __forceinline__ float bf2f(unsigned h) { return __builtin_bit_cast(float, h << 16); }
__device__ __forceinline__ float wave_sum(float v) {
#pragma unroll
    for (int o = 1; o < 64; o <<= 1) v += __shfl_xor(v, o);
    return v;
}

struct Params {
    const float* in[32];
    float* out;
    unsigned char* ws;
};

__device__ __forceinline__ void transpose_item(const float* __restrict__ W, int K, int N, bf16_t* __restrict__ WT, int mode, const float* __restrict__ gain, LAS float* scr, int item, int lane) {
    const int nblk = N / 32, kb = item / nblk, nb = item % nblk, k0 = 64 * kb, n0 = 32 * nb;
    const int drow0 = mode == 0 ? n0 : (256 * (n0 >> 7) + (n0 & 127) + (mode == 2 ? 128 : 0));
    const int c = lane & 7;
    f32x4 g0 = (f32x4){1.f, 1.f, 1.f, 1.f}, g1 = g0;
    if (gain) { g0 = *(const f32x4*)(gain + k0 + 8 * c); g1 = *(const f32x4*)(gain + k0 + 8 * c + 4); }
    float v[32];
    const float* wp = W + (size_t)(k0 + (lane >> 5)) * N + n0 + (lane & 31);
#pragma unroll
    for (int i = 0; i < 32; ++i) v[i] = __builtin_nontemporal_load(wp + (size_t)(2 * i) * N);
#pragma unroll
    for (int i = 0; i < 32; ++i) scr[(2 * i + (lane >> 5)) * 33 + (lane & 31)] = v[i];
    LDS_WAIT(); asm volatile("" ::: "memory");
#pragma unroll
    for (int j = 0; j < 4; ++j) { const int n = (lane >> 3) + 8 * j; const LAS float* s = scr + (8 * c) * 33 + n;
        u32x4 o; o.x = pk2(s[0 * 33] * g0[0], s[1 * 33] * g0[1]); o.y = pk2(s[2 * 33] * g0[2], s[3 * 33] * g0[3]); o.z = pk2(s[4 * 33] * g1[0], s[5 * 33] * g1[1]); o.w = pk2(s[6 * 33] * g1[2], s[7 * 33] * g1[3]);
        *(u32x4*)(WT + (size_t)(drow0 + n) * K + k0 + 8 * c) = o; }
    LDS_WAIT(); asm volatile("" ::: "memory");
}
constexpr int IT_FF = (DM / 64) * (FF / 32);
__device__ __forceinline__ void convert_gu(const float* wg, const float* wu, const float* gain, unsigned char* ws, LAS unsigned char* lds, int gw, int ngw, int lane, int wave) {
    LAS float* scr = (LAS float*)(lds + wave * 8448); bf16_t* WGU = (bf16_t*)(ws + WS_WFF);
#pragma unroll 1
    for (int it = gw; it < 2 * IT_FF; it += ngw) { if (it < IT_FF) transpose_item(wg, DM, FF, WGU, 1, gain, scr, it, lane); else transpose_item(wu, DM, FF, WGU, 2, gain, scr, it - IT_FF, lane); }
}
__device__ __forceinline__ void convert_dn(const float* wd, unsigned char* ws, LAS unsigned char* lds, int gw, int ngw, int lane, int wave) {
    LAS float* scr = (LAS float*)(lds + wave * 8448); bf16_t* WDN = (bf16_t*)(ws + WS_WDN);
#pragma unroll 1
    for (int it = gw; it < IT_FF; it += ngw) transpose_item(wd, FF, DM, WDN, 0, nullptr, scr, it, lane);
}
__device__ __forceinline__ void convert_tail1(const Params& p, LAS unsigned char* lds, int gw, int ngw, int lane, int wave) {
    LAS float* scr = (LAS float*)(lds + wave * 8448); unsigned char* ws = p.ws;
    constexpr int IT_IN = (DM / 64) * (NIN / 32), IT_OUT = (DM / 64) * (DM / 32);
#pragma unroll 1
    for (int it = gw; it < IT_FF + IT_IN + IT_OUT; it += ngw) {
        if (it < IT_FF) transpose_item(p.in[4], FF, DM, (bf16_t*)(ws + WS_WDN), 0, nullptr, scr, it, lane);
        else if (it < IT_FF + IT_IN) transpose_item(p.in[6], DM, NIN, (bf16_t*)(ws + WS_WIN), 0, p.in[5], scr, it - IT_FF, lane);
        else transpose_item(p.in[26], DM, DM, (bf16_t*)(ws + WS_WOUT), 0, nullptr, scr, it - IT_FF - IT_IN, lane);
    }
}
__device__ __forceinline__ void hid_pass(const Params& p, LAS float* sm, const LAS float* WL, int pos0, int tid) {
    const float* b1 = p.in[10]; const float* f1 = p.in[11]; const float* b2 = p.in[13]; const float* f2 = p.in[14]; const float* b3 = p.in[16]; const float* f3 = p.in[17];
    bf16_t* hidx = (bf16_t*)(p.ws + WS_HID);
    const int pp = tid >> 6, j = tid & 63, pos = pos0 + pp;
    LAS float* Z = sm; LAS float* H1 = sm + 512; LAS float* H2 = sm + 1024;
    const LAS float* w1 = WL; const LAS float* w2 = WL + 33 * 64; const LAS float* w3 = w2 + 64 * 64;
    if (j < 33) {
        float z;
        if (j == 0) z = (float)pos / 8191.0f;
        else {
            const int b = (j - 1) & 15; const float fj = 1e-4f + (float)b * ((15.0f - 1e-4f) / 15.0f);
            const double r = (double)pos * (double)fj * (1.0 / 8192.0); const float fr = (float)(r - floor(r));
            float s, c; sincospif(2.0f * fr, &s, &c);
            z = (j <= 16) ? c : -s;
        }
        Z[pp * 40 + j] = z;
    }
    __syncthreads();
    float a = b1[j];
#pragma unroll 11
    for (int f = 0; f < 33; ++f) a += Z[pp * 40 + f] * w1[f * 64 + j];
    H1[pp * 64 + j] = sinf(f1[j] * a);
    __syncthreads();
    a = b2[j];
#pragma unroll 16
    for (int k = 0; k < 64; ++k) a += H1[pp * 64 + k] * w2[k * 64 + j];
    H2[pp * 64 + j] = sinf(f2[j] * a);
    __syncthreads();
    a = b3[j];
#pragma unroll 16
    for (int k = 0; k < 64; ++k) a += H2[pp * 64 + k] * w3[k * 64 + j];
    { const float h3 = sinf(f3[j] * a); const unsigned hi = f2bf(h3); bf16_t* hr = hidx + (size_t)pos * 256 + j; hr[0] = (bf16_t)hi; hr[64] = (bf16_t)f2bf(h3 - bf2f(hi)); hr[128] = (bf16_t)hi; hr[192] = 0; }
}
__device__ __forceinline__ void phase0(const Params& p, LAS unsigned char* lds, int tid, int lane, int wave, int mask) {
    const int G = gridDim.x, gw = blockIdx.x * 8 + wave, ngw = G * 8;
    unsigned char* ws = p.ws;
    if (mask & 1) convert_gu(p.in[2], p.in[3], p.in[1], ws, lds, gw, ngw, lane, wave);
    const int gt = blockIdx.x * NT + tid, ngt = G * NT;
    {
      float* rs = (float*)(ws + WS_ROWSS) + L; for (int i = gt; i < 3 * L; i += ngt) rs[i] = 0.f; }
    { const float* w4 = p.in[18]; bf16_t* tx = (bf16_t*)(ws + WS_W4T);
      for (int i = gt; i < 2048 * 64; i += ngt) { const int c = i >> 6, k = i & 63; const float v = w4[k * 2048 + c]; const unsigned hi = f2bf(v); bf16_t* tr = tx + (size_t)c * 256 + k; tr[0] = (bf16_t)hi; tr[64] = (bf16_t)hi; tr[128] = (bf16_t)f2bf(v - bf2f(hi)); tr[192] = 0; } }
    if (mask & 4) {
        const float* x = p.in[0]; bf16_t* xb = (bf16_t*)(ws + WS_XB); float* rs = (float*)(ws + WS_ROWSS);
#pragma unroll 1
        for (int m = gw; m < L; m += ngw) {
            const f32x4* xr = (const f32x4*)(x + (size_t)m * DM) + lane; u32x2* o = (u32x2*)(xb + (size_t)m * DM) + lane; float s = 0.f;
#pragma unroll
            for (int j = 0; j < 8; ++j) { const f32x4 v = __builtin_nontemporal_load(xr + 64 * j); s += (v[0] * v[0] + v[1] * v[1]) + (v[2] * v[2] + v[3] * v[3]);
                u32x2 w; w.x = pk2(v[0], v[1]); w.y = pk2(v[2], v[3]); o[64 * j] = w; }
            s = wave_sum(s); if (lane == 0) rs[m] = s;
        }
    }
    __syncthreads();
    if (mask & 8) { LAS float* WL = (LAS float*)lds + 2048;
      for (int i = tid; i < 33 * 64; i += NT) WL[i] = p.in[9][i];
      for (int i = tid; i < 64 * 64; i += NT) { WL[33 * 64 + i] = p.in[12][i]; WL[33 * 64 + 64 * 64 + i] = p.in[15][i]; }
      __syncthreads();
#pragma unroll 1
      for (int ps = blockIdx.x; ps < L / 8; ps += G) { hid_pass(p, (LAS float*)lds, WL, ps * 8, tid); __syncthreads(); } }
}

__device__ __forceinline__ void convT_fetch(const bf16_t* phy, int tile, int tid, u32x4 (&rw)[4]) {
    const int t0 = (tile >> 4) * 64, c0 = (tile & 15) * 64;
#pragma unroll
    for (int k = 0; k < 4; ++k) { const int idx = tid + NT * k; rw[k] = (u32x4){0u, 0u, 0u, 0u};
        if (idx < 3 * 66 * 8) { const int s = idx / 528, r = (idx % 528) >> 3, c8 = (idx & 7) * 8, tt = t0 - 1 + r;
            if (tt >= 0 && tt < L) rw[k] = __builtin_nontemporal_load((const u32x4*)(phy + (size_t)tt * PHY_LD + s * HYW + c0 + c8)); } }
}
__device__ __forceinline__ void convT_tile(const Params& p, LAS unsigned char* lds, int tile, int tid, const u32x4 (&rw)[4]) {
    bf16_t* zT = (bf16_t*)(p.ws + WS_ZT); bf16_t* x0T = (bf16_t*)(p.ws + WS_X0T);
    const float* cw = p.in[7]; const float* cb = p.in[8];
    LAS float* zt = (LAS float*)lds; LAS float* xt = zt + 64 * 65;
    LAS bf16_t* raw = (LAS bf16_t*)(lds + 33280);
    const int t0 = (tile >> 4) * 64, c0 = (tile & 15) * 64;
#pragma unroll
    for (int k = 0; k < 4; ++k) { const int idx = tid + NT * k; if (idx < 3 * 66 * 8) { const int s = idx / 528, r = (idx % 528) >> 3, c8 = (idx & 7) * 8; *(LAS u32x4*)(raw + (s * 66 + r) * 64 + c8) = rw[k]; } }
    const int c = tid & 63, tg = tid >> 6;
    float w[3][3], b[3];
#pragma unroll
    for (int s = 0; s < 3; ++s) { const int col = s * HYW + c0 + c; b[s] = cb[col];
#pragma unroll
        for (int tap = 0; tap < 3; ++tap) w[s][tap] = cw[tap * 3 * HYW + col]; }
    __syncthreads();
#pragma unroll
    for (int i = 0; i < 8; ++i) {
        const int tl = tg * 8 + i; float u[3];
#pragma unroll
        for (int s = 0; s < 3; ++s) { float a = b[s];
#pragma unroll
            for (int tap = 0; tap < 3; ++tap) a += w[s][tap] * bf2f(raw[(s * 66 + tl + tap) * 64 + c]);
            u[s] = a; }
        zt[c * 65 + tl] = u[2] * u[1]; xt[c * 65 + tl] = u[0];
    }
    __syncthreads();
    { const int t = tid & 63, cg8 = tid >> 6;
#pragma unroll
      for (int i = 0; i < 8; ++i) { const int cc = cg8 * 8 + i; zT[(size_t)(c0 + cc) * L + t0 + t] = (bf16_t)f2bf(zt[cc * 65 + t]); x0T[(size_t)(c0 + cc) * L + t0 + t] = (bf16_t)f2bf(xt[cc * 65 + t]); } }
    __syncthreads();
}

__device__ __forceinline__ float logsig16(float x) { return (fminf(x, 0.f) - __logf(1.0f + __expf(-fabsf(x)))) * (1.0f / 16.0f); }
__device__ __forceinline__ bf16x8 ldfrag(const LAS bf16_t* base, int ld, int row0, int k0, int lane) { return *(const LAS bf16x8*)(base + (row0 + (lane & 15)) * ld + k0 + 8 * (lane >> 4)); }

__device__ __forceinline__ void gla_stage(const bf16_t* pr, const float* lr, int t0, int h, LAS float* lrs, LAS bf16_t* vT, int tid) {
    *(LAS f32x4*)(lrs + tid * 4) = *(const f32x4*)(lr + (size_t)t0 * 32 + tid * 4);
    { const int c = tid & 255, tb = tid >> 8; const bf16_t* vp = pr + (size_t)t0 * PR_LD + PR_V + h * 256 + c;
#pragma unroll
      for (int i = 0; i < 4; ++i) { const int tk = (tb * 4 + i) * 8; unsigned short e[8];
#pragma unroll
          for (int j = 0; j < 8; ++j) e[j] = vp[(size_t)(tk + j) * PR_LD];
          u32x4 w; w.x = e[0] | ((unsigned)e[1] << 16); w.y = e[2] | ((unsigned)e[3] << 16); w.z = e[4] | ((unsigned)e[5] << 16); w.w = e[6] | ((unsigned)e[7] << 16);
          *(LAS u32x4*)(vT + c * 72 + tk) = w; } }
}
struct GateW { float w[16]; float b; };
__device__ __forceinline__ void gate_load(const Params& p, int dir, int h, int d, GateW& g) {
    const float* wa = dir ? p.in[23] : p.in[21]; const float* ba = dir ? p.in[24] : p.in[22];
#pragma unroll
    for (int r = 0; r < 16; ++r) g.w[r] = wa[r * 512 + h * 128 + d];
    g.b = ba[h * 128 + d];
}
__device__ __forceinline__ float gate_eval(const GateW& g, const LAS float* lr) {
    const LAS f32x4* l4 = (const LAS f32x4*)lr; const f32x4 a = l4[0], b = l4[1], c = l4[2], d = l4[3];
    float x0 = g.b, x1 = 0.f, x2 = 0.f, x3 = 0.f;
#pragma unroll
    for (int r = 0; r < 4; ++r) { x0 += a[r] * g.w[r]; x1 += b[r] * g.w[4 + r]; x2 += c[r] * g.w[8 + r]; x3 += d[r] * g.w[12 + r]; }
    return logsig16((x0 + x1) + (x2 + x3));
}

__device__ __forceinline__ void gla_kv_item(const Params& p, LAS unsigned char* lds, int item, int tid, int lane, int wave) {
    const int h = item & 3, n = item >> 2, t0 = n * 64;
    const bf16_t* pr = (const bf16_t*)(p.ws + WS_PR); bf16_t* ST = (bf16_t*)(p.ws + WS_ST); float* dec = (float*)(p.ws + WS_DEC);
    LAS bf16_t* vT = (LAS bf16_t*)lds; LAS bf16_t* kstT = (LAS bf16_t*)(lds + 36864);
    LAS float* lrs = (LAS float*)(lds + 73728); LAS float* tot = (LAS float*)(lds + 81920);
    gla_stage(pr, (const float*)(p.ws + WS_LR), t0, h, lrs, vT, tid);
    const int d = tid & 127, dir = (tid >> 7) & 1, half = tid >> 8;
    GateW gw; gate_load(p, dir, h, d, gw);
    const bf16_t* kp = pr + (size_t)t0 * PR_LD + PR_K + h * 128 + d;
    unsigned short kr[8];
#pragma unroll
    for (int u = 0; u < 8; ++u) { const int q = half * 32 + u, t = dir ? 63 - q : q; kr[u] = kp[(size_t)t * PR_LD]; }
    __syncthreads();
    float sum = 0.f;
#pragma unroll 4
    for (int s = 0; s < 32; ++s) { const int q = half * 32 + s, t = dir ? 63 - q : q; sum += gate_eval(gw, lrs + t * 32 + dir * 16); }
    tot[(dir * 2 + half) * 128 + d] = sum;
    __syncthreads();
    {
        const float t0s = tot[(dir * 2 + 0) * 128 + d], total = t0s + tot[(dir * 2 + 1) * 128 + d];
        float b = half ? t0s : 0.f;
#pragma unroll 1
        for (int sg = 0; sg < 4; ++sg) {
            unsigned short kn[8];
#pragma unroll
            for (int u = 0; u < 8; ++u) { const int q = half * 32 + ((sg * 8 + 8 + u) & 31), t = dir ? 63 - q : q; kn[u] = kp[(size_t)t * PR_LD]; }
            unsigned ke[8];
#pragma unroll
            for (int u = 0; u < 8; ++u) { const int q = half * 32 + sg * 8 + u, t = dir ? 63 - q : q; b += gate_eval(gw, lrs + t * 32 + dir * 16);
                ke[dir ? 7 - u : u] = f2bf(bf2f(kr[u]) * __expf(total - b)); }
            { const int q0 = half * 32 + sg * 8, tlo = dir ? 63 - q0 - 7 : q0; u32x4 w; w.x = ke[0] | (ke[1] << 16); w.y = ke[2] | (ke[3] << 16); w.z = ke[4] | (ke[5] << 16); w.w = ke[6] | (ke[7] << 16);
              *(LAS u32x4*)(kstT + (dir * 128 + d) * 72 + tlo) = w; }
#pragma unroll
            for (int u = 0; u < 8; ++u) kr[u] = kn[u];
        }
        if (half == 0) dec[((size_t)(dir * 128 + n) * 4 + h) * 128 + d] = __expf(total);
    }
    __syncthreads();
    const int q4 = lane >> 4, v0 = wave * 32;
#pragma unroll 1
    for (int dr = 0; dr < 2; ++dr) {
        f32x4 acc[8][2];
#pragma unroll
        for (int mt = 0; mt < 8; ++mt) { acc[mt][0] = (f32x4){0.f, 0.f, 0.f, 0.f}; acc[mt][1] = (f32x4){0.f, 0.f, 0.f, 0.f}; }
#pragma unroll
        for (int ks = 0; ks < 2; ++ks) {
            const bf16x8 b0 = ldfrag(vT, 72, v0, 32 * ks, lane), b1 = ldfrag(vT, 72, v0 + 16, 32 * ks, lane);
#pragma unroll
            for (int mt = 0; mt < 8; ++mt) { const bf16x8 a = ldfrag(kstT + dr * 128 * 72, 72, 16 * mt, 32 * ks, lane);
                acc[mt][0] = __builtin_amdgcn_mfma_f32_16x16x32_bf16(a, b0, acc[mt][0], 0, 0, 0);
                acc[mt][1] = __builtin_amdgcn_mfma_f32_16x16x32_bf16(a, b1, acc[mt][1], 0, 0, 0); }
        }
        bf16_t* S = ST + ((size_t)(dr * 4 + h) * 128 + n) * 32768;
#pragma unroll
        for (int mt = 0; mt < 8; ++mt)
#pragma unroll
            for (int nt = 0; nt < 2; ++nt) { u32x2 w; w.x = pk2(acc[mt][nt][0], acc[mt][nt][1]); w.y = pk2(acc[mt][nt][2], acc[mt][nt][3]);
                *(u32x2*)(S + (size_t)(v0 + 16 * nt + (lane & 15)) * 128 + 16 * mt + 4 * q4) = w; }
    }
    __syncthreads();
}

#ifndef REP_FA
#define REP_FA 0
#endif
#ifndef REP_FB
#define REP_FB 0
#endif
__device__ __forceinline__ void lr_task(const Params& p, LAS unsigned char* lds, int task, int tid, int lane, int wave) {
    const bf16_t* xb = (const bf16_t*)(p.ws + WS_XB); const bf16_t* wt = (const bf16_t*)(p.ws + WS_WIN) + (size_t)NING * DM;
    const float* rowss1 = (const float*)(p.ws + WS_ROWSS) + L; float* lr = (float*)(p.ws + WS_LR);
    const int mt = wave >> 2, nt = (wave >> 1) & 1, kh = wave & 1, fr = lane & 15, q4 = lane >> 4, t0 = task * 32;
    const bf16_t* ap = xb + (size_t)(t0 + 16 * mt + fr) * DM + kh * 1024 + 8 * q4; const bf16_t* bp = wt + (size_t)(16 * nt + fr) * DM + kh * 1024 + 8 * q4;
    f32x4 acc = (f32x4){0.f, 0.f, 0.f, 0.f};
#pragma unroll 1
    for (int kb = 0; kb < 4; ++kb) { bf16x8 a[8], b[8];
#pragma unroll
        for (int u = 0; u < 8; ++u) { a[u] = *(const bf16x8*)(ap + (kb * 8 + u) * 32); b[u] = *(const bf16x8*)(bp + (kb * 8 + u) * 32); }
#pragma unroll
        for (int u = 0; u < 8; ++u) acc = __builtin_amdgcn_mfma_f32_16x16x32_bf16(a[u], b[u], acc, 0, 0, 0); }
    LAS f32x4* ex = (LAS f32x4*)lds;
    if (kh) ex[(wave >> 1) * 64 + lane] = acc;
    __syncthreads();
    if (!kh) { const f32x4 o = ex[(wave >> 1) * 64 + lane];
#pragma unroll
        for (int r = 0; r < 4; ++r) { const int t = t0 + 16 * mt + 4 * q4 + r; lr[(size_t)t * 32 + 16 * nt + fr] = (acc[r] + o[r]) * pg8::rstd_of(rowss1[t]); } }
    __syncthreads();
}
__device__ __forceinline__ c2 cmul(c2 a, c2 b) { return mk2(a.x * b.x - a.y * b.y, a.x * b.y + a.y * b.x); }
__device__ __forceinline__ c2 twid(int m) { const float r = (float)m * (1.0f / 16384.0f); return mk2(__builtin_amdgcn_cosf(r), -__builtin_amdgcn_sinf(r)); }
__device__ __forceinline__ c2 cmulc(c2 a, c2 b) { return mk2(a.x * b.x + a.y * b.y, a.y * b.x - a.x * b.y); }
#define XI(i) ((i) + ((i) >> 5))
constexpr int XPAD_BYTES = (FN + FN / 32) * 8;
__constant__ const float C16c[8] = {1.f, 0.9238795325112867f, 0.7071067811865476f, 0.3826834323650898f, 0.f, -0.3826834323650898f, -0.7071067811865476f, -0.9238795325112867f};
__constant__ const float C16s[8] = {0.f, 0.3826834323650898f, 0.7071067811865476f, 0.9238795325112867f, 1.f, 0.9238795325112867f, 0.7071067811865476f, 0.3826834323650898f};
template <int R, bool INV, int UNR> __device__ __forceinline__ void fft_pass(LAS c2* X, int lo, int tid) {
    constexpr int RAD = 1 << R;
    const int stride = 1 << lo, ls = lo + R - 1;
    int tt = tid; asm volatile("" : "+v"(tt));
#pragma unroll 1
    for (int g = tt; g < FN / RAD; g += NT) {
        const int j0 = g & (stride - 1), i = ((g - j0) << R) + j0;
        c2 e[RAD];
#pragma unroll
        for (int q = 0; q < RAD; ++q) e[q] = X[XI(i + q * stride)];
#pragma unroll
        for (int t = 0; t < R; ++t) {
            const int Hq = INV ? (1 << t) : (RAD >> (t + 1));
            const c2 base = twid(j0 << (INV ? (13 - lo - t) : (13 - ls + t)));
#pragma unroll
            for (int bf = 0; bf < RAD / 2; ++bf) {
                const int qm = bf & (Hq - 1), q = ((bf - qm) << 1) + qm, k16 = qm * (8 / Hq);
                const c2 w = (k16 == 0) ? base : cmul(base, mk2(C16c[k16], -C16s[k16]));
                if (!INV) { const c2 a = e[q], b = e[q + Hq]; e[q] = a + b; e[q + Hq] = cmul(a - b, w); }
                else { const c2 a = e[q], b = cmulc(e[q + Hq], w); e[q] = a + b; e[q + Hq] = a - b; }
            }
        }
#pragma unroll
        for (int q = 0; q < RAD; ++q) X[XI(i + q * stride)] = e[q];
    }
    __syncthreads();
}
__device__ __forceinline__ void fft_dif(LAS c2* X, int tid) { fft_pass<4, false, 2>(X, 10, tid); fft_pass<4, false, 2>(X, 6, tid); fft_pass<4, false, 2>(X, 2, tid); fft_pass<2, false, 4>(X, 0, tid); }
__device__ __forceinline__ void fft_dit_inv(LAS c2* X, int tid) { fft_pass<2, true, 4>(X, 0, tid); fft_pass<4, true, 2>(X, 2, tid); fft_pass<4, true, 2>(X, 6, tid); fft_pass<4, true, 2>(X, 10, tid); }
__device__ __forceinline__ int br14(int x) { return (int)(__brev((unsigned)x) >> 18); }
__device__ __forceinline__ float block_sum(float v, LAS float* red, int tid, int lane, int wave) {
    v = wave_sum(v); __syncthreads(); if (lane == 0) red[wave] = v; __syncthreads();
    float s = 0.f;
#pragma unroll
    for (int i = 0; i < 8; ++i) s += red[i];
    return s;
}
__device__ __forceinline__ void hyena_fft_pair(const Params& p, LAS unsigned char* lds, int pair, int tid, int lane, int wave) {
    const int c = pair * 2;
    const float* skip = p.in[19];
    bf16_t* zT = (bf16_t*)(p.ws + WS_ZT); const bf16_t* x0T = (const bf16_t*)(p.ws + WS_X0T);
    f32x4* SK = (f32x4*)(p.ws + WS_SK) + (size_t)blockIdx.x * SK_STRIDE;
    LAS c2* X = (LAS c2*)lds; LAS float* red = (LAS float*)(lds + XPAD_BYTES);
    const float dmin = -3.0701134573253945f, dmax = -15.350567286626973f;
    const float del0 = fabsf(dmin + (float)c * ((dmax - dmin) / 1023.0f)), del1 = fabsf(dmin + (float)(c + 1) * ((dmax - dmin) / 1023.0f));
    float n0 = 0.f, n1 = 0.f, inv0 = 0.f, inv1 = 0.f;
#pragma unroll 1
    for (int rb = 0; rb <= REP_FB; ++rb) {
    n0 = 0.f; n1 = 0.f;
    {
        const bf16_t* ff = (const bf16_t*)p.out + (size_t)c * L; const bf16_t* fb = (const bf16_t*)p.out + (size_t)(HYW + c) * L;
#pragma unroll 1
        for (int ub = 0; ub < 2; ++ub) { float f0[8], f1[8], g0[8], g1[8];
#pragma unroll
            for (int u = 0; u < 8; ++u) { const int i = tid + NT * (ub * 8 + u); f0[u] = bf2f(__builtin_nontemporal_load(ff + i)); f1[u] = bf2f(__builtin_nontemporal_load(ff + L + i)); g0[u] = bf2f(__builtin_nontemporal_load(fb + i)); g1[u] = bf2f(__builtin_nontemporal_load(fb + L + i)); }
#pragma unroll
            for (int u = 0; u < 8; ++u) { const int i = tid + NT * (ub * 8 + u);
                X[XI(i)] = mk2(f0[u], f1[u]); n0 += fabsf(f0[u]); n1 += fabsf(f1[u]);
                if (i >= 1) { X[XI(FN - i)] = mk2(g0[u], g1[u]); n0 += fabsf(g0[u]); n1 += fabsf(g1[u]); } } }
    }
    if (tid == 0) X[XI(L)] = mk2(0.f, 0.f);
    inv0 = 1.0f / block_sum(n0, red, tid, lane, wave); inv1 = 1.0f / block_sum(n1, red, tid, lane, wave);
    __syncthreads();
    fft_dif(X, tid);
#pragma unroll 2
    for (int m = tid; m < FN / 2; m += NT) { const int pp = 2 * m, k = br14(pp), pm = br14((FN - k) & (FN - 1)); const c2 F = X[XI(pp)], Fm = X[XI(pm)];
        SK[m] = (f32x4){0.5f * (F.x + Fm.x), 0.5f * (F.y - Fm.y), 0.5f * (F.y + Fm.y), -0.5f * (F.x - Fm.x)}; }
    if (tid == 0) { const c2 F = X[XI(1)]; SK[FN / 2] = (f32x4){F.x, 0.f, F.y, 0.f}; }
    __syncthreads();
    }
    { float za[16], zb[16];
#pragma unroll
      for (int u = 0; u < 16; ++u) { za[u] = bf2f(zT[(size_t)c * L + tid + NT * u]); zb[u] = bf2f(zT[(size_t)(c + 1) * L + tid + NT * u]); }
#pragma unroll
      for (int u = 0; u < 16; ++u) { X[XI(tid + NT * u)] = mk2(za[u], zb[u]); X[XI(L + tid + NT * u)] = mk2(0.f, 0.f); } }
    __syncthreads();
    fft_dif(X, tid);
#pragma unroll 2
    for (int m = tid; m < FN / 2; m += NT) {
        const int pp = 2 * m, k = br14(pp); const f32x4 kk = SK[m]; const c2 K1 = mk2(kk[0], kk[1]), K2 = mk2(kk[2], kk[3]);
        if (k == 0) { const c2 F = X[XI(0)]; X[XI(0)] = mk2(F.x * K1.x, F.y * K2.x);
            const f32x4 kh = SK[FN / 2]; const c2 F1 = X[XI(1)]; X[XI(1)] = mk2(F1.x * kh[0], F1.y * kh[2]); }
        else { const int pm = br14(FN - k); const c2 F = X[XI(pp)], Fm = X[XI(pm)];
            const c2 Z1 = mk2(0.5f * (F.x + Fm.x), 0.5f * (F.y - Fm.y)), Z2 = mk2(0.5f * (F.y + Fm.y), -0.5f * (F.x - Fm.x));
            const c2 A = cmul(Z1, K1), B = cmul(Z2, K2);
            X[XI(pp)] = mk2(A.x - B.y, A.y + B.x); X[XI(pm)] = mk2(A.x + B.y, -A.y + B.x); }
    }
    __syncthreads();
    fft_dit_inv(X, tid);
    const float sk0 = skip[c], sk1 = skip[c + 1], sc = 1.0f / (float)FN;
#pragma unroll 1
    for (int ub = 0; ub < 2; ++ub) { float z0[8], z1[8], x0[8], x1[8];
#pragma unroll
        for (int u = 0; u < 8; ++u) { const int i = tid + NT * (ub * 8 + u); const size_t o0 = (size_t)c * L + i, o1 = (size_t)(c + 1) * L + i; z0[u] = bf2f(zT[o0]); z1[u] = bf2f(zT[o1]); x0[u] = bf2f(__builtin_nontemporal_load(x0T + o0)); x1[u] = bf2f(__builtin_nontemporal_load(x0T + o1)); }
#pragma unroll
        for (int u = 0; u < 8; ++u) { const int i = tid + NT * (ub * 8 + u); const size_t o0 = (size_t)c * L + i, o1 = (size_t)(c + 1) * L + i; const c2 y = X[XI(i)];
            zT[o0] = (bf16_t)f2bf((y.x * sc * inv0 + sk0 * z0[u]) * x0[u]); zT[o1] = (bf16_t)f2bf((y.y * sc * inv1 + sk1 * z1[u]) * x1[u]); } }
    __syncthreads();
}
__device__ __forceinline__ void gla_scan(const Params& p, int tid) {
    unsigned* ST = (unsigned*)(p.ws + WS_ST); const float* dec = (const float*)(p.ws + WS_DEC);
    const int gt = blockIdx.x * NT + tid, ngt = gridDim.x * NT;
#pragma unroll 1
    for (int e = gt; e < 8 * 16384; e += ngt) {
        const int dh = e >> 14, idx = e & 16383, dir = dh >> 2, h = dh & 3, d = (2 * idx) & 127;
        unsigned* base = ST + (size_t)dh * 128 * 16384 + idx;
        const float* db = dec + ((size_t)dir * 128 * 4 + h) * 128 + d;
        float s0 = 0.f, s1 = 0.f;
#pragma unroll 1
        for (int nb = 0; nb < 128; nb += 16) {
            unsigned kv[16]; c2 dc[16];
#pragma unroll
            for (int u = 0; u < 16; ++u) { const int n = dir ? 127 - (nb + u) : nb + u; kv[u] = __builtin_nontemporal_load(base + (size_t)n * 16384); dc[u] = *(const c2*)(db + (size_t)n * 512); }
#pragma unroll
            for (int u = 0; u < 16; ++u) { const int n = dir ? 127 - (nb + u) : nb + u; base[(size_t)n * 16384] = pk2(s0, s1);
                s0 = dc[u].x * s0 + bf2f(kv[u] & 0xffffu); s1 = dc[u].y * s1 + bf2f(kv[u] >> 16); }
        }
    }
}

__device__ __forceinline__ void gla_out_item(const Params& p, LAS unsigned char* lds, int item, int tid, int lane, int wave) {
    const int h = item & 3, n = item >> 2, t0 = n * 64;
    const bf16_t* pr = (const bf16_t*)(p.ws + WS_PR); const bf16_t* ST = (const bf16_t*)(p.ws + WS_ST); bf16_t* mix = (bf16_t*)(p.ws + WS_MIX);
    const float* og = p.in[25];
    LAS bf16_t* qin = (LAS bf16_t*)lds;
    LAS bf16_t* kin = (LAS bf16_t*)(lds + 34816);
    LAS bf16_t* vT = (LAS bf16_t*)(lds + 69632);
    LAS bf16_t* P = (LAS bf16_t*)(lds + 106496);
    LAS float* lrs = (LAS float*)(lds + 115712); LAS float* tot = (LAS float*)(lds + 123904); LAS float* red = (LAS float*)(lds + 125952);
    gla_stage(pr, (const float*)(p.ws + WS_LR), t0, h, lrs, vT, tid);
    const int d = tid & 127, dir = (tid >> 7) & 1, half = tid >> 8;
    GateW gw; gate_load(p, dir, h, d, gw);
    const bf16_t* qp = pr + (size_t)t0 * PR_LD + PR_Q + h * 128 + d;
    unsigned short kr[8], qr[8];
#pragma unroll
    for (int u = 0; u < 8; ++u) { const int q = half * 32 + u, t = dir ? 63 - q : q; qr[u] = qp[(size_t)t * PR_LD]; kr[u] = qp[(size_t)t * PR_LD + (PR_K - PR_Q)]; }
    __syncthreads();
    float sum = 0.f;
#pragma unroll 4
    for (int s = 0; s < 32; ++s) { const int q = half * 32 + s, t = dir ? 63 - q : q; sum += gate_eval(gw, lrs + t * 32 + dir * 16); }
    tot[(dir * 2 + half) * 128 + d] = sum;
    __syncthreads();
    {
        float b = half ? tot[(dir * 2 + 0) * 128 + d] : 0.f;
#pragma unroll 1
        for (int sg = 0; sg < 4; ++sg) {
            unsigned short kn[8], qn[8];
#pragma unroll
            for (int u = 0; u < 8; ++u) { const int q = half * 32 + ((sg * 8 + 8 + u) & 31), t = dir ? 63 - q : q; qn[u] = qp[(size_t)t * PR_LD]; kn[u] = qp[(size_t)t * PR_LD + (PR_K - PR_Q)]; }
#pragma unroll
            for (int u = 0; u < 8; ++u) { const int q = half * 32 + sg * 8 + u, t = dir ? 63 - q : q; b += gate_eval(gw, lrs + t * 32 + dir * 16);
                const float qv = bf2f(qr[u]) * 0.08838834764831845f, kv = bf2f(kr[u]);
                qin[(dir * 64 + t) * 136 + d] = (bf16_t)f2bf(qv * __expf(b)); kin[(dir * 64 + t) * 136 + d] = (bf16_t)f2bf(kv * __expf(-b)); }
#pragma unroll
            for (int u = 0; u < 8; ++u) { kr[u] = kn[u]; qr[u] = qn[u]; }
        }
    }
    __syncthreads();
    const int q4 = lane >> 4, fr = lane & 15;
#pragma unroll 1
    for (int ti = 0; ti < 2; ++ti) {
        const int id = wave * 2 + ti, tt = id >> 2, st = id & 3;
        f32x4 af = (f32x4){0.f, 0.f, 0.f, 0.f}, ab = (f32x4){0.f, 0.f, 0.f, 0.f};
        if (tt >= st) {
#pragma unroll
            for (int ks = 0; ks < 4; ++ks) af = __builtin_amdgcn_mfma_f32_16x16x32_bf16(ldfrag(qin, 136, 16 * tt, 32 * ks, lane), ldfrag(kin, 136, 16 * st, 32 * ks, lane), af, 0, 0, 0); }
        if (tt <= st) {
#pragma unroll
            for (int ks = 0; ks < 4; ++ks) ab = __builtin_amdgcn_mfma_f32_16x16x32_bf16(ldfrag(qin + 64 * 136, 136, 16 * tt, 32 * ks, lane), ldfrag(kin + 64 * 136, 136, 16 * st, 32 * ks, lane), ab, 0, 0, 0); }
#pragma unroll
        for (int r = 0; r < 4; ++r) { const int t = 16 * tt + 4 * q4 + r, s = 16 * st + fr; P[t * 72 + s] = (bf16_t)f2bf(t >= s ? af[r] : ab[r]); }
    }
    __syncthreads();
    f32x4 acc[2][4];
#pragma unroll
    for (int mt = 0; mt < 2; ++mt)
#pragma unroll
        for (int nt = 0; nt < 4; ++nt) acc[mt][nt] = (f32x4){0.f, 0.f, 0.f, 0.f};
    const int v0 = wave * 32;
#pragma unroll
    for (int ks = 0; ks < 2; ++ks) {
        const bf16x8 a0 = ldfrag(vT, 72, v0, 32 * ks, lane), a1 = ldfrag(vT, 72, v0 + 16, 32 * ks, lane);
#pragma unroll
        for (int nt = 0; nt < 4; ++nt) { const bf16x8 b = ldfrag(P, 72, 16 * nt, 32 * ks, lane);
            acc[0][nt] = __builtin_amdgcn_mfma_f32_16x16x32_bf16(a0, b, acc[0][nt], 0, 0, 0); acc[1][nt] = __builtin_amdgcn_mfma_f32_16x16x32_bf16(a1, b, acc[1][nt], 0, 0, 0); }
    }
#pragma unroll 1
    for (int dr = 0; dr < 2; ++dr) {
        const bf16_t* S = ST + ((size_t)(dr * 4 + h) * 128 + n) * 32768;
        bf16x8 sa[4][2];
#pragma unroll
        for (int ks = 0; ks < 4; ++ks) { sa[ks][0] = __builtin_nontemporal_load((const bf16x8*)(S + (size_t)(v0 + fr) * 128 + 32 * ks + 8 * q4)); sa[ks][1] = __builtin_nontemporal_load((const bf16x8*)(S + (size_t)(v0 + 16 + fr) * 128 + 32 * ks + 8 * q4)); }
#pragma unroll
        for (int ks = 0; ks < 4; ++ks)
#pragma unroll
            for (int nt = 0; nt < 4; ++nt) { const bf16x8 b = ldfrag(qin + dr * 64 * 136, 136, 16 * nt, 32 * ks, lane);
                acc[0][nt] = __builtin_amdgcn_mfma_f32_16x16x32_bf16(sa[ks][0], b, acc[0][nt], 0, 0, 0); acc[1][nt] = __builtin_amdgcn_mfma_f32_16x16x32_bf16(sa[ks][1], b, acc[1][nt], 0, 0, 0); }
    }
#pragma unroll
    for (int nt = 0; nt < 4; ++nt) { float ss = 0.f;
#pragma unroll
        for (int mt = 0; mt < 2; ++mt) ss += (acc[mt][nt][0] * acc[mt][nt][0] + acc[mt][nt][1] * acc[mt][nt][1]) + (acc[mt][nt][2] * acc[mt][nt][2] + acc[mt][nt][3] * acc[mt][nt][3]);
        ss += __shfl_xor(ss, 16); ss += __shfl_xor(ss, 32);
        if (q4 == 0) red[wave * 64 + 16 * nt + fr] = ss; }
    __syncthreads();
#pragma unroll
    for (int nt = 0; nt < 4; ++nt) { const int t = 16 * nt + fr; float ss = 0.f;
#pragma unroll
        for (int w = 0; w < 8; ++w) ss += red[w * 64 + t];
        const float rs = rsqrtf(ss * (1.0f / 256.0f) + 1e-6f);
#pragma unroll
        for (int mt = 0; mt < 2; ++mt) { const int v = v0 + 16 * mt + 4 * q4; const f32x4 g = *(const f32x4*)(og + h * 256 + v);
            const u32x2 rw = *(const u32x2*)(pr + (size_t)(t0 + t) * PR_LD + PR_R + h * 256 + v);
            const float r0 = bf2f(rw.x & 0xffffu), r1 = bf2f(rw.x >> 16), r2 = bf2f(rw.y & 0xffffu), r3 = bf2f(rw.y >> 16);
            u32x2 w; w.x = pk2(acc[mt][nt][0] * rs * g[0] * silu_f(r0), acc[mt][nt][1] * rs * g[1] * silu_f(r1));
            w.y = pk2(acc[mt][nt][2] * rs * g[2] * silu_f(r2), acc[mt][nt][3] * rs * g[3] * silu_f(r3));
            *(u32x2*)(mix + (size_t)(t0 + t) * DM + HYW + h * 256 + v) = w; }
    }
    __syncthreads();
}
__device__ __forceinline__ void hynorm_tile(const Params& p, LAS unsigned char* lds, int tile, int tid) {
    const bf16_t* yT = (const bf16_t*)(p.ws + WS_ZT); bf16_t* mix = (bf16_t*)(p.ws + WS_MIX); const float* og = p.in[20];
    LAS float* yt = (LAS float*)lds; LAS float* red = yt + 128 * 65;
    const int g = tile & 7, t0 = (tile >> 3) * 64, c0 = g * 128;
    { const int t = tid & 63, cg8 = tid >> 6; float ss = 0.f;
#pragma unroll
      for (int i = 0; i < 16; ++i) { const int cc = cg8 * 16 + i; const float v = bf2f(__builtin_nontemporal_load(yT + (size_t)(c0 + cc) * L + t0 + t)); yt[cc * 65 + t] = v; ss += v * v; }
      red[cg8 * 64 + t] = ss; }
    __syncthreads();
    { const int c2 = (tid & 63) * 2, tg = tid >> 6; const float g0 = og[c0 + c2], g1 = og[c0 + c2 + 1];
#pragma unroll
      for (int i = 0; i < 8; ++i) { const int t = tg * 8 + i; float ss = 0.f;
#pragma unroll
          for (int w = 0; w < 8; ++w) ss += red[w * 64 + t];
          const float rs = rsqrtf(ss * (1.0f / 128.0f) + 1e-6f);
          *(unsigned*)(mix + (size_t)(t0 + t) * DM + c0 + c2) = pk2(yt[c2 * 65 + t] * rs * g0, yt[(c2 + 1) * 65 + t] * rs * g1); } }
    __syncthreads();
}

#define XB_TMO      128
#define XB_XCNT(j)  (256  + 64 * (j))
#define XB_XSUB(j)  (1280 + 64 * (j))
#define XB_XGEN(j)  (2304 + 64 * (j))
#define XB_TOP      3328
#define XB_TOPGEN   3392
#define XCD_BAR_WORDS 3456
#define XB_SPIN_CAP (1u << 18)

__device__ __forceinline__ unsigned xb_ld(unsigned* p)              { return __hip_atomic_load(p, __ATOMIC_RELAXED, __HIP_MEMORY_SCOPE_AGENT); }
__device__ __forceinline__ unsigned xb_add(unsigned* p, unsigned v) { return __hip_atomic_fetch_add(p, v, __ATOMIC_RELAXED, __HIP_MEMORY_SCOPE_AGENT); }
__device__ __forceinline__ unsigned xb_xcc_id() { return (unsigned)__builtin_amdgcn_s_getreg((3 << 11) | 20) & 0xFu; }
#define XB_SPIN(cond, bar) do { unsigned _sp = 0; while (cond) { __builtin_amdgcn_s_sleep(1); \
    if ((++_sp & 255u) == 0u) { if (xb_ld(&(bar)[XB_TMO])) break; if (_sp > XB_SPIN_CAP) { atomicAdd(&(bar)[XB_TMO], 1u); break; } } } } while (0)

struct XcdBarrier {
    unsigned* bar; unsigned x;
    volatile LAS unsigned* st;
};

__device__ __forceinline__ XcdBarrier xcd_barrier_post(unsigned* bar, volatile LAS unsigned* st) {
    XcdBarrier b; b.bar = bar; b.x = xb_xcc_id(); b.st = st;
    if (threadIdx.x == 0) (void)xb_add(&bar[XB_XCNT(b.x)], 1u);
    return b;
}
__device__ __forceinline__ void xcd_barrier_complete(unsigned* bar, unsigned x, unsigned& nloc, unsigned& nx) {
    const unsigned G = gridDim.x * gridDim.y * gridDim.z;
    unsigned sum, cnt, mine, sp = 0u;
    for (;;) {
        sum = 0u; cnt = 0u; mine = 0u;
#pragma unroll
        for (unsigned j = 0; j < 16; ++j) { const unsigned c = xb_ld(&bar[XB_XCNT(j)]); sum += c; cnt += (c > 0u) ? 1u : 0u; mine = (j == x) ? c : mine; }
        if (sum == G) break;
        __builtin_amdgcn_s_sleep(1);
        if ((++sp & 255u) == 0u) { if (xb_ld(&bar[XB_TMO])) break; if (sp > XB_SPIN_CAP) { atomicAdd(&bar[XB_TMO], 1u); break; } }
    }
    nloc = mine > 0u ? mine : 1u; nx = cnt > 0u ? cnt : 1u;
}

__device__ __forceinline__ void xcd_barrier(const XcdBarrier& b) {
    asm volatile("s_waitcnt vmcnt(0)" ::: "memory");
    __syncthreads();
    if (threadIdx.x == 0) {
        unsigned* bar = b.bar;
        __builtin_amdgcn_s_waitcnt(0);
        unsigned nloc = b.st[0], nx = b.st[1]; const unsigned bx = b.st[2];
        if (nloc == 0u) { xcd_barrier_complete(bar, bx, nloc, nx); b.st[0] = nloc; b.st[1] = nx; }
        const unsigned old = xb_add(&bar[XB_XSUB(bx)], 1u);
        const unsigned gen = old / nloc;
        if (old + 1u == (gen + 1u) * nloc) {
            __builtin_amdgcn_fence(__ATOMIC_RELEASE, "agent");
            asm volatile("s_waitcnt vmcnt(0)" ::: "memory");
            const unsigned og = xb_add(&bar[XB_TOP], 1u);
            const unsigned tg = og / nx;
            if (og + 1u == (tg + 1u) * nx) xb_add(&bar[XB_TOPGEN], 1u);
            else XB_SPIN(xb_ld(&bar[XB_TOPGEN]) == tg, bar);
            __builtin_amdgcn_fence(__ATOMIC_ACQUIRE, "agent");
            xb_add(&bar[XB_XGEN(bx)], 1u);
            asm volatile("s_waitcnt vmcnt(0)" ::: "memory");
        } else {
            XB_SPIN(xb_ld(&bar[XB_XGEN(bx)]) == gen, bar);
            __builtin_amdgcn_fence(__ATOMIC_ACQUIRE, "agent");
            asm volatile("s_waitcnt vmcnt(0)" ::: "memory");
        }
    }
    __syncthreads();
}

#ifndef REP_P0
#define REP_P0 0
#endif
#ifndef PA_MASK
#define PA_MASK 3
#endif
#ifndef PC_MASK
#define PC_MASK 3
#endif
#ifndef REP_G1
#define REP_G1 0
#endif
#ifndef REP_G3
#define REP_G3 0
#endif
#ifndef P0_MASK
#define P0_MASK 15
#endif
#ifndef REP_PA
#define REP_PA 0
#endif
#ifndef REP_PAB
#define REP_PAB 0
#endif
#ifndef REP_PC
#define REP_PC 0
#endif
__global__ void __launch_bounds__(NT, 2) fwd_megakernel(Params p) {
    extern __shared__ __attribute__((aligned(16))) unsigned char smem[];
    LAS unsigned char* lds = (LAS unsigned char*)smem;
    cg::grid_group grid = cg::this_grid();
    const int G = gridDim.x;
    volatile LAS unsigned* bst = (volatile LAS unsigned*)(lds + LDS_BYTES - 64);
    if (threadIdx.x < 2) bst[threadIdx.x] = 0u;
    __syncthreads();
    XcdBarrier xbar = xcd_barrier_post((unsigned*)(p.ws + WS_BAR), bst);
    if (threadIdx.x == 0) bst[2] = xbar.x;
    if (p.ws == nullptr) grid.sync();
#define TIDS int tid = threadIdx.x; asm volatile("" : "+v"(tid)); const int lane = tid & 63, wave = __builtin_amdgcn_readfirstlane(tid >> 6); (void)lane; (void)wave;
    unsigned char* ws = p.ws;
    float* rowss = (float*)(ws + WS_ROWSS);
    bf16_t* XB = (bf16_t*)(ws + WS_XB); bf16_t* AB = (bf16_t*)(ws + WS_A);

#pragma unroll 1
    for (int rep = 0; rep <= REP_P0; ++rep) {
#ifndef SKIP_P0
        { TIDS; phase0(p, lds, tid, lane, wave, rep == 0 ? 15 : P0_MASK); }
#endif
        xcd_barrier(xbar); }
#ifndef NO_GEMM
#pragma unroll 1
    for (int rg = 0; rg <= REP_G1; ++rg) {
    { pg8::Gemm g{XB, (const bf16_t*)(ws + WS_WFF), L, 2 * FF, DM}; pg8::StaticOrder S; S.init(L, 2 * FF, G, (int)blockIdx.x);
      pg8::EpiSwiGLU E{AB, FF, rowss}; pg8::gemm_phase<pg8::EpiSwiGLU, pg8::StaticOrder, true, true>(lds, g, S, E); }
    { TIDS; const int rem = ((L / 256) * (2 * FF / 256)) % G, nl = rem ? G - rem : G, li = rem ? (int)blockIdx.x - rem : (int)blockIdx.x;
      if (li >= 0) convert_tail1(p, lds, li * 8 + wave, nl * 8, lane, wave); }
    xcd_barrier(xbar);
    }
    { pg8::Gemm g{AB, (const bf16_t*)(ws + WS_WDN), L, DM, FF}; pg8::StaticOrder S; S.init(L, DM, G, (int)blockIdx.x);
      pg8::EpiResid E{p.in[0], nullptr, XB, rowss + L, 0.5f}; pg8::gemm_phase<pg8::EpiResid, pg8::StaticOrder, true, true>(lds, g, S, E); }
    xcd_barrier(xbar);
#pragma unroll 1
    for (int rg = 0; rg <= REP_G3; ++rg) {
    { pg8::Gemm g{XB, (const bf16_t*)(ws + WS_WIN), L, NING, DM}; pg8::StaticOrder S; S.init(L, NING, G, (int)blockIdx.x);
      pg8::EpiP E{(bf16_t*)(ws + WS_PHY), (bf16_t*)(ws + WS_PR), rowss + L}; pg8::gemm_phase<pg8::EpiP, pg8::StaticOrder, true, true>(lds, g, S, E); }
    { TIDS; for (int it = blockIdx.x; it < L / 32; it += G) lr_task(p, lds, it, tid, lane, wave); }
    xcd_barrier(xbar);
    }
#endif
#pragma unroll 1
    for (int rep = 0; rep <= REP_PAB; ++rep) {
#pragma unroll 1
        for (int r2 = 0; r2 <= REP_PA; ++r2) {
#ifndef SKIP_PA
            { pg8::Gemm g{(const bf16_t*)(ws + WS_W4T), (const bf16_t*)(ws + WS_HID), 2048, L, 256}; pg8::StaticOrder S; S.init(2048, L, G, (int)blockIdx.x);
              pg8::EpiFilt E{(bf16_t*)p.out, (bf16_t*)p.out + (size_t)HYW * L, (bf16_t*)p.out + (size_t)(HYW + 768) * L}; pg8::gemm_phase<pg8::EpiFilt, pg8::StaticOrder, true, true>(lds, g, S, E); }
            if (r2 == 0 || (PA_MASK & 1)) { TIDS; for (int it = blockIdx.x; it < 512; it += G) gla_kv_item(p, lds, it, tid, lane, wave); }
            if (r2 == 0 || (PA_MASK & 2)) { TIDS; const bf16_t* phy = (const bf16_t*)(ws + WS_PHY); u32x4 rw[4], rn[4];
              if ((int)blockIdx.x < 2048) convT_fetch(phy, blockIdx.x, tid, rw);
#pragma unroll 1
              for (int it = blockIdx.x; it < 2048; it += G) { const bool more = it + G < 2048; if (more) convT_fetch(phy, it + G, tid, rn);
                  convT_tile(p, lds, it, tid, rw);
                  if (more) {
#pragma unroll
                      for (int k = 0; k < 4; ++k) rw[k] = rn[k]; } } }
#endif
            xcd_barrier(xbar);
        }
#ifndef SKIP_PB
        { TIDS; gla_scan(p, tid); }
        { TIDS; for (int it = blockIdx.x; it < HYW / 2; it += G) hyena_fft_pair(p, lds, it, tid, lane, wave); }
#endif
        xcd_barrier(xbar);
    }
#pragma unroll 1
    for (int rep = 0; rep <= REP_PC; ++rep) {
#ifndef SKIP_PC
        if (rep == 0 || (PC_MASK & 1)) { TIDS; for (int it = blockIdx.x; it < 512; it += G) gla_out_item(p, lds, it, tid, lane, wave); }
        if (rep == 0 || (PC_MASK & 2)) { TIDS; for (int it = blockIdx.x; it < 1024; it += G) hynorm_tile(p, lds, it, tid); }
#endif
        xcd_barrier(xbar);
    }
#ifndef NO_GEMM
    { pg8::Gemm g{(const bf16_t*)(ws + WS_MIX), (const bf16_t*)(ws + WS_WOUT), L, DM, DM}; pg8::StaticOrder S; S.init(L, DM, G, (int)blockIdx.x);
      pg8::EpiResid E{nullptr, XB, XB, rowss + 2 * L, 1.0f}; pg8::gemm_phase<pg8::EpiResid, pg8::StaticOrder, true, true>(lds, g, S, E); }
    __syncthreads();
    { TIDS; convert_gu(p.in[28], p.in[29], p.in[27], ws, lds, blockIdx.x * 8 + wave, G * 8, lane, wave); }
    xcd_barrier(xbar);
    { pg8::Gemm g{XB, (const bf16_t*)(ws + WS_WFF), L, 2 * FF, DM}; pg8::StaticOrder S; S.init(L, 2 * FF, G, (int)blockIdx.x);
      pg8::EpiSwiGLU E{AB, FF, rowss + 2 * L}; pg8::gemm_phase<pg8::EpiSwiGLU, pg8::StaticOrder, true, true>(lds, g, S, E); }
    { TIDS; const int rem = ((L / 256) * (2 * FF / 256)) % G, nl = rem ? G - rem : G, li = rem ? (int)blockIdx.x - rem : (int)blockIdx.x;
      if (li >= 0) convert_dn(p.in[30], ws, lds, li * 8 + wave, nl * 8, lane, wave); }
    xcd_barrier(xbar);
    { pg8::Gemm g{AB, (const bf16_t*)(ws + WS_WDN), L, DM, FF}; pg8::StaticOrder S; S.init(L, DM, G, (int)blockIdx.x);
      pg8::EpiFinal E{XB, p.out, rowss + 3 * L, (unsigned*)(ws + WS_PCNT), p.in[31], 0.5f}; pg8::gemm_phase<pg8::EpiFinal, pg8::StaticOrder, true, true>(lds, g, S, E); }
#endif
}

extern "C" void kernel_launch(void* const* d_in, const int* in_sizes, int n_in, void* d_out, int out_size, void* d_ws, size_t ws_size, hipStream_t stream) {
    static int grid = 0;
    if (grid == 0) {
        if (n_in != 32 || out_size != L * DM || ws_size < WS_END) { fprintf(stderr, "kernel_launch: unexpected problem: n_in %d out %d ws %zu (need %zu)\n", n_in, out_size, ws_size, (size_t)WS_END); grid = -1; return; }
        int dev = 0, cus = 0, per_cu = 0;
        (void)hipGetDevice(&dev); (void)hipDeviceGetAttribute(&cus, hipDeviceAttributeMultiprocessorCount, dev);
        if (hipFuncSetAttribute((const void*)fwd_megakernel, hipFuncAttributeMaxDynamicSharedMemorySize, LDS_BYTES) != hipSuccess) { fprintf(stderr, "kernel_launch: hipFuncSetAttribute failed\n"); grid = -1; return; }
        if (hipOccupancyMaxActiveBlocksPerMultiprocessor(&per_cu, (const void*)fwd_megakernel, NT, LDS_BYTES) != hipSuccess || per_cu < 1) { fprintf(stderr, "kernel_launch: occupancy query gave %d\n", per_cu); per_cu = 1; }
        (void)hipGetLastError();
        grid = cus * per_cu; if (grid > 256) grid = 256;
        if (grid != 256) { fprintf(stderr, "kernel_launch: this kernel needs a 256-workgroup cooperative grid (256 CUs x 1), got %d; nothing launched\n", grid); grid = -1; return; }
        fprintf(stderr, "kernel_launch: cus %d per_cu %d grid %d\n", cus, per_cu, grid);
    }
    if (grid < 0) return;
    Params p{};
    for (int i = 0; i < 32; ++i) p.in[i] = (const float*)d_in[i];
    p.out = (float*)d_out; p.ws = (unsigned char*)d_ws;
    if (hipMemsetAsync((char*)d_ws + WS_BAR, 0, 16384 + 32 * 256, stream) != hipSuccess) { fprintf(stderr, "kernel_launch: hipMemsetAsync failed\n"); return; }
    void* args[] = {&p};
    hipError_t e = hipLaunchCooperativeKernel((const void*)fwd_megakernel, dim3(grid), dim3(NT), args, LDS_BYTES, stream);
    if (e != hipSuccess) fprintf(stderr, "kernel_launch: cooperative launch failed: %s (grid %d)\n", hipGetErrorString(e), grid);
}
```

```cpp
#include <hip/hip_runtime.h>
#include <hip/hip_cooperative_groups.h>
#include <cstdio>
#include <cstdint>
namespace cg = cooperative_groups;

namespace pg8 {
#define PG8_LAS __attribute__((address_space(3)))
typedef unsigned short bf16_t;
typedef short bf16x8 __attribute__((ext_vector_type(8)));
typedef float f32x4 __attribute__((ext_vector_type(4)));
typedef unsigned u32x4 __attribute__((ext_vector_type(4)));
constexpr int BM = 256, BK = 64, HALF = 128, HTB = HALF * BK * 2  , STAGE_BYTES = 8 * HTB, NXCD = 8, WGM = 8;

__host__ __device__ __forceinline__ int lds_byte(int r, int c) { const int st = (r >> 4) * 2 + (c >> 5), rr = r & 15, cc = c & 31, ob = rr * 64 + cc * 2; return st * 1024 + (ob ^ (((ob >> 9) & 1) << 5)); }
__host__ __device__ __forceinline__ void stage_rc(int b, int& R, int& C) { const int st = b / 1024, sb = b % 1024, swz = sb ^ (((sb >> 9) & 1) << 5); R = (st >> 1) * 16 + swz / 64; C = (st & 1) * 32 + (swz % 64) / 2; }
__host__ __device__ __forceinline__ int perm32(int rho) { const int n = rho >> 4, i = rho & 15; return 8 * (i >> 2) + 4 * n + (i & 3); }

struct Unit { int pm, pn; };
struct Gemm { const bf16_t* A; const bf16_t* Bt; int M, N, K; };

struct StaticOrder {
    int nM, nN, nwg, G, c;
    __host__ __device__ void init(int M, int N, int G_, int c_) { nM = M / BM; nN = N / BM; nwg = nM * nN; G = G_; c = c_; }
    __host__ __device__ bool next(int i, Unit& u) const {
        const long L = (long)i * G + c; if (L >= nwg) return false;
        int wgid = (int)L; { const int q = nwg / NXCD, r = nwg % NXCD, xcd = wgid % NXCD, off = wgid / NXCD; wgid = (xcd < r ? xcd * (q + 1) : r * (q + 1) + (xcd - r) * q) + off; }
        const int nig = WGM * nN, gid = wgid / nig, fm = gid * WGM, gsz = (nM - fm) < WGM ? (nM - fm) : WGM;
        u.pm = fm + ((wgid % nig) % gsz); u.pn = (wgid % nig) / gsz; return true;
    }
    __device__ __forceinline__ void a_ready(const Unit&) const {}
    __device__ __forceinline__ void done(const Unit&) const {}
};
__device__ __forceinline__ unsigned cvt_pk_bf16(float lo, float hi) { unsigned r; asm volatile("v_cvt_pk_bf16_f32 %0, %1, %2" : "=v"(r) : "v"(lo), "v"(hi)); return r; }
typedef unsigned u32x4 __attribute__((ext_vector_type(4)));
typedef unsigned u32x2 __attribute__((ext_vector_type(2)));
__device__ __forceinline__ float rstd_of(float ss) { return rsqrtf(ss * (1.0f / 2048.0f) + 1e-6f); }
__device__ __forceinline__ float silu_f(float x) { return x * __builtin_amdgcn_rcpf(1.0f + __expf(-x)); }

struct EpiSwiGLU {
    static constexpr bool PERM = true, AFTER_DRAIN = false;
    bf16_t* O; int ldc; const float* rowss;
    __device__ __forceinline__ void operator()(const f32x4 (&acc)[2][2][4][2], const Unit& u, int wr, int wc, int fr, int fq) const {
        const int row0 = u.pm * BM + wr * 64 + fr, col0 = u.pn * 128 + wc * 32 + 8 * fq;
#pragma unroll
        for (int ai = 0; ai < 2; ++ai)
#pragma unroll
            for (int m = 0; m < 4; ++m) {
                const int row = row0 + ai * HALF + m * 16; const float rs = rstd_of(rowss[row]);
                float v[8];
#pragma unroll
                for (int n = 0; n < 2; ++n)
#pragma unroll
                    for (int j = 0; j < 4; ++j) v[n * 4 + j] = silu_f(acc[ai][0][m][n][j] * rs) * (acc[ai][1][m][n][j] * rs);
                u32x4 w; w.x = cvt_pk_bf16(v[0], v[1]); w.y = cvt_pk_bf16(v[2], v[3]); w.z = cvt_pk_bf16(v[4], v[5]); w.w = cvt_pk_bf16(v[6], v[7]);
                *(u32x4*)(O + (size_t)row * ldc + col0) = w;
            }
    }
};
struct EpiResid {
    static constexpr bool PERM = false, AFTER_DRAIN = false;
    const float* base; const bf16_t* base16; bf16_t* ob; float* rowss; float scale;
    __device__ __forceinline__ void operator()(const f32x4 (&acc)[2][2][4][2], const Unit& u, int wr, int wc, int fr, int fq) const {
        const int row0 = u.pm * BM + wr * 64 + fr, col0 = u.pn * BM + wc * 32 + 4 * fq;
#pragma unroll
        for (int ai = 0; ai < 2; ++ai)
#pragma unroll
            for (int m = 0; m < 4; ++m) {
                const int row = row0 + ai * HALF + m * 16; float ss = 0.f;
#pragma unroll
                for (int bj = 0; bj < 2; ++bj)
#pragma unroll
                    for (int n = 0; n < 2; ++n) {
                        const size_t off = (size_t)row * 2048 + col0 + bj * HALF + n * 16;
                        f32x4 b;
                        if (base) b = *(const f32x4*)(base + off);
                        else { const u32x2 r = *(const u32x2*)(base16 + off); b = (f32x4){__builtin_bit_cast(float, r.x << 16), __builtin_bit_cast(float, r.x & 0xffff0000u), __builtin_bit_cast(float, r.y << 16), __builtin_bit_cast(float, r.y & 0xffff0000u)}; }
                        const f32x4 v = b + acc[ai][bj][m][n] * scale;
                        { u32x2 w; w.x = cvt_pk_bf16(v[0], v[1]); w.y = cvt_pk_bf16(v[2], v[3]); *(u32x2*)(ob + off) = w; }
                        ss += (v[0] * v[0] + v[1] * v[1]) + (v[2] * v[2] + v[3] * v[3]);
                    }
                ss += __shfl_xor(ss, 16); ss += __shfl_xor(ss, 32);
                if (rowss && fq == 0) atomicAdd(rowss + row, ss);
            }
    }
};
struct EpiP {
    static constexpr bool PERM = true, AFTER_DRAIN = false;
    bf16_t* phy; bf16_t* pr; const float* rowss;
    __device__ __forceinline__ void operator()(const f32x4 (&acc)[2][2][4][2], const Unit& u, int wr, int wc, int fr, int fq) const {
        const int row0 = u.pm * BM + wr * 64 + fr;
        bf16_t* O; int ldc, colt;
        if (u.pn < 12) { O = phy; ldc = 3072; colt = u.pn * BM; } else { O = pr; ldc = 3072; colt = (u.pn - 12) * BM; }
        const int col0 = colt + wc * 32 + 8 * fq;
#pragma unroll
        for (int ai = 0; ai < 2; ++ai)
#pragma unroll
            for (int m = 0; m < 4; ++m) {
                const int row = row0 + ai * HALF + m * 16; const float rs = rstd_of(rowss[row]);
#pragma unroll
                for (int bj = 0; bj < 2; ++bj) {
                    const f32x4 v0 = acc[ai][bj][m][0] * rs, v1 = acc[ai][bj][m][1] * rs;
                    u32x4 w; w.x = cvt_pk_bf16(v0[0], v0[1]); w.y = cvt_pk_bf16(v0[2], v0[3]); w.z = cvt_pk_bf16(v1[0], v1[1]); w.w = cvt_pk_bf16(v1[2], v1[3]);
                    *(u32x4*)(O + (size_t)row * ldc + col0 + bj * HALF) = w;
                }
            }
    }
};

struct EpiFilt {
    static constexpr bool PERM = false, AFTER_DRAIN = false;
    bf16_t* Ff; bf16_t* Fb0; bf16_t* Fb1;
    __device__ __forceinline__ void operator()(const f32x4 (&acc)[2][2][4][2], const Unit& u, int wr, int wc, int fr, int fq) const {
        const int row0 = u.pm * BM + wr * 64 + fr, col0 = u.pn * BM + wc * 32 + 4 * fq;
        const float dmin = -3.0701134573253945f, dmax = -15.350567286626973f;
#pragma unroll
        for (int ai = 0; ai < 2; ++ai)
#pragma unroll
            for (int m = 0; m < 4; ++m) {
                const int cc = row0 + ai * HALF + m * 16, c = cc & 1023;
                const float del = __builtin_fabsf(dmin + (float)c * ((dmax - dmin) / 1023.0f)) * (1.0f / 8191.0f);
                bf16_t* dst = cc < 1024 ? Ff + (size_t)c * 8192 : (c < 768 ? Fb0 + (size_t)c * 8192 : Fb1 + (size_t)(c - 768) * 8192);
#pragma unroll
                for (int bj = 0; bj < 2; ++bj)
#pragma unroll
                    for (int n = 0; n < 2; ++n) {
                        const int i = col0 + bj * HALF + n * 16; f32x4 v = acc[ai][bj][m][n];
#pragma unroll
                        for (int j = 0; j < 4; ++j) v[j] *= __expf(-(float)(i + j) * del);
                        { u32x2 w; w.x = cvt_pk_bf16(v[0], v[1]); w.y = cvt_pk_bf16(v[2], v[3]); *(u32x2*)(dst + i) = w; }
                    }
            }
    }
};

struct EpiFinal {
    static constexpr bool PERM = false, AFTER_DRAIN = false;
    const bf16_t* base16; float* out; float* rowss; unsigned* cnt; const float* g; float scale;
    __device__ __forceinline__ void operator()(f32x4 (&acc)[2][2][4][2], const Unit& u, int wr, int wc, int fr, int fq) const {
        const int row0 = u.pm * BM + wr * 64 + fr, col0 = u.pn * BM + wc * 32 + 4 * fq;
#pragma unroll
        for (int ai = 0; ai < 2; ++ai)
#pragma unroll
            for (int m = 0; m < 4; ++m) {
                const int row = row0 + ai * HALF + m * 16; float ss = 0.f;
#pragma unroll
                for (int bj = 0; bj < 2; ++bj)
#pragma unroll
                    for (int n = 0; n < 2; ++n) {
                        const size_t off = (size_t)row * 2048 + col0 + bj * HALF + n * 16;
                        const u32x2 r = *(const u32x2*)(base16 + off);
                        const f32x4 v = (f32x4){__builtin_bit_cast(float, r.x << 16), __builtin_bit_cast(float, r.x & 0xffff0000u), __builtin_bit_cast(float, r.y << 16), __builtin_bit_cast(float, r.y & 0xffff0000u)} + acc[ai][bj][m][n] * scale;
                        acc[ai][bj][m][n] = v; ss += (v[0] * v[0] + v[1] * v[1]) + (v[2] * v[2] + v[3] * v[3]);
                    }
                ss += __shfl_xor(ss, 16); ss += __shfl_xor(ss, 32);
                if (fq == 0) atomicAdd(rowss + row, ss);
            }
        asm volatile("s_waitcnt vmcnt(0)" ::: "memory");
        __syncthreads();
        if (threadIdx.x == 0) {
            unsigned* c = cnt + 64 * u.pm;
            __builtin_amdgcn_fence(__ATOMIC_RELEASE, "agent"); asm volatile("s_waitcnt vmcnt(0)" ::: "memory");
            __hip_atomic_fetch_add(c, 1u, __ATOMIC_RELAXED, __HIP_MEMORY_SCOPE_AGENT);
            unsigned spins = 0;
            while (__hip_atomic_load(c, __ATOMIC_RELAXED, __HIP_MEMORY_SCOPE_AGENT) < 8u) { __builtin_amdgcn_s_sleep(2); if (++spins > (1u << 22)) break; }
            __builtin_amdgcn_fence(__ATOMIC_ACQUIRE, "agent"); asm volatile("s_waitcnt vmcnt(0)" ::: "memory");
        }
        __syncthreads();
#pragma unroll
        for (int ai = 0; ai < 2; ++ai)
#pragma unroll
            for (int m = 0; m < 4; ++m) {
                const int row = row0 + ai * HALF + m * 16; const float rs = rstd_of(__hip_atomic_load(rowss + row, __ATOMIC_RELAXED, __HIP_MEMORY_SCOPE_AGENT));
#pragma unroll
                for (int bj = 0; bj < 2; ++bj)
#pragma unroll
                    for (int n = 0; n < 2; ++n) {
                        const int col = col0 + bj * HALF + n * 16; const f32x4 gg = *(const f32x4*)(g + col);
                        *(f32x4*)(out + (size_t)row * 2048 + col) = acc[ai][bj][m][n] * rs * gg;
                    }
            }
    }
};
template <class Epi, class Sched, bool ALIGN_EPI = false, bool SP2 = false>
__device__ __forceinline__ void gemm_phase(PG8_LAS unsigned char* lds, const Gemm g, const Sched& S, const Epi& E) {
    int tid_ = threadIdx.x; asm volatile("" : "+v"(tid_));
    const int tid = tid_, wid = __builtin_amdgcn_readfirstlane(tid >> 6), lane = tid & 63, wr = wid >> 2, wc = wid & 3, fr = lane & 15, fq = lane >> 4;
    const int K = g.K, nt = K / BK;
    unsigned voffA[2], voffB[2];
#pragma unroll
    for (int i = 0; i < 2; ++i) { int R, C; stage_rc(tid * 16 + i * 8192, R, C); const int Rb = Epi::PERM ? ((R & ~31) + perm32(R & 31)) : R;
        voffA[i] = (unsigned)(R * K + C) * 2u; voffB[i] = (unsigned)(Rb * K + C) * 2u; }
    const size_t kstep = (size_t)(BK * 2);
    const size_t hstep = (size_t)HALF * K * 2;
    const size_t tstep = 2 * hstep;
    const unsigned ldsw = (unsigned)wid * 1024u;
    const int aoff = lds_byte(wr * 64 + fr, fq * 8), boff = lds_byte(wc * 32 + fr, fq * 8);
#define PG8_SA(b, h) (((b) * 2 + (h)) * HTB)
#define PG8_SB(b, h) ((4 + (b) * 2 + (h)) * HTB)
#define PG8_STAGE(bufoff, gbase, voff) do { _Pragma("unroll") for (int _i = 0; _i < 2; ++_i) \
        __builtin_amdgcn_global_load_lds((const unsigned*)((const char*)(gbase) + (voff)[_i]), (PG8_LAS unsigned*)(lds + (bufoff) + ldsw + _i * 8192), 16, 0, 0); } while (0)
#define PG8_LDA(dst, b, h) do { _Pragma("unroll") for (int m = 0; m < 4; ++m) _Pragma("unroll") for (int k = 0; k < 2; ++k) dst[m][k] = *(const PG8_LAS bf16x8*)(lds + PG8_SA(b, h) + aoff + m * 2048 + k * 1024); } while (0)
#define PG8_LDB(dst, b, h) do { _Pragma("unroll") for (int n = 0; n < 2; ++n) _Pragma("unroll") for (int k = 0; k < 2; ++k) dst[n][k] = *(const PG8_LAS bf16x8*)(lds + PG8_SB(b, h) + boff + n * 2048 + k * 1024); } while (0)
#define PG8_MMA(ai, bj, At, Bt) do { __builtin_amdgcn_s_setprio(1); _Pragma("unroll") for (int m = 0; m < 4; ++m) _Pragma("unroll") for (int n = 0; n < 2; ++n) _Pragma("unroll") for (int k = 0; k < 2; ++k) \
        acc[ai][bj][m][n] = __builtin_amdgcn_mfma_f32_16x16x32_bf16(Bt[n][k], At[m][k], acc[ai][bj][m][n], 0, 0, 0); __builtin_amdgcn_s_setprio(0); } while (0)
#define PG8_WAIT_V(n) asm volatile("s_waitcnt vmcnt(" #n ")" ::: "memory")
#define PG8_WAIT_L(n) asm volatile("s_waitcnt lgkmcnt(" #n ")" ::: "memory")
#define PG8_BAR __builtin_amdgcn_s_barrier()
#define PG8_SCHED __builtin_amdgcn_sched_barrier(0)
    Unit cur, nxt; int ui = 0;
    if (!S.next(0, cur)) return;
    f32x4 acc[2][2][4][2];
#pragma unroll
    for (int a = 0; a < 2; ++a)
#pragma unroll
        for (int b = 0; b < 2; ++b)
#pragma unroll
            for (int m = 0; m < 4; ++m)
#pragma unroll
                for (int n = 0; n < 2; ++n) acc[a][b][m][n] = (f32x4){0.f, 0.f, 0.f, 0.f};
    bf16x8 At[4][2], B0[2][2], B1[2][2];
    const char* cA = (const char*)g.A + (size_t)cur.pm * tstep; const char* cB = (const char*)g.Bt + (size_t)cur.pn * tstep;
    S.a_ready(cur);
    if constexpr (SP2) {
        PG8_STAGE(PG8_SB(0, 0), cB, voffB); PG8_STAGE(PG8_SB(0, 1), cB + hstep, voffB); PG8_STAGE(PG8_SA(0, 0), cA, voffA); PG8_STAGE(PG8_SA(0, 1), cA + hstep, voffA);
        if (wr == 1) PG8_BAR;
        PG8_WAIT_V(2); PG8_BAR;
        PG8_STAGE(PG8_SB(1, 0), cB + kstep, voffB); PG8_STAGE(PG8_SA(1, 0), cA + kstep, voffA); PG8_STAGE(PG8_SB(1, 1), cB + hstep + kstep, voffB);
        PG8_WAIT_V(6); PG8_BAR;
    } else {
        PG8_STAGE(PG8_SB(0, 0), cB, voffB); PG8_STAGE(PG8_SA(0, 0), cA, voffA); PG8_STAGE(PG8_SB(0, 1), cB + hstep, voffB); PG8_STAGE(PG8_SA(0, 1), cA + hstep, voffA);
        if (wr == 1) PG8_BAR;
        PG8_WAIT_V(4); PG8_BAR;
        PG8_STAGE(PG8_SB(1, 0), cB + kstep, voffB); PG8_STAGE(PG8_SA(1, 0), cA + kstep, voffA); PG8_STAGE(PG8_SB(1, 1), cB + hstep + kstep, voffB);
        PG8_WAIT_V(6); PG8_BAR;
    }
    for (;;) {
        const bool has_next = S.next(ui + 1, nxt);
        const char* nA = has_next ? (const char*)g.A + (size_t)nxt.pm * tstep : cA; const char* nB = has_next ? (const char*)g.Bt + (size_t)nxt.pn * tstep : cB;
        for (int t = 0; t < nt; t += 2) {
            const bool last = (t == nt - 2);
            const char* a1 = cA + (size_t)(t + 1) * kstep;
            const char* a2 = last ? nA : cA + (size_t)(t + 2) * kstep; const char* b2 = last ? nB : cB + (size_t)(t + 2) * kstep;
            const char* a3 = a2 + kstep; const char* b3 = b2 + kstep;
            if (last && has_next) S.a_ready(nxt);
            if constexpr (SP2) {
            PG8_LDB(B0, 0, 0); PG8_LDB(B1, 0, 1); PG8_SCHED; PG8_LDA(At, 0, 0); PG8_STAGE(PG8_SA(1, 1), a1 + hstep, voffA);
            PG8_WAIT_V(8); PG8_WAIT_L(0); PG8_BAR; PG8_MMA(0, 0, At, B0); PG8_MMA(0, 1, At, B1); PG8_BAR; PG8_SCHED;
            PG8_LDA(At, 0, 1); PG8_STAGE(PG8_SB(0, 0), b2, voffB); PG8_STAGE(PG8_SB(0, 1), b2 + hstep, voffB); PG8_STAGE(PG8_SA(0, 0), a2, voffA);
            PG8_WAIT_V(8); PG8_WAIT_L(0); PG8_BAR; PG8_MMA(1, 0, At, B0); PG8_MMA(1, 1, At, B1); PG8_BAR; PG8_SCHED;
            PG8_LDB(B0, 1, 0); PG8_LDB(B1, 1, 1); PG8_SCHED; PG8_LDA(At, 1, 0); PG8_STAGE(PG8_SA(0, 1), a2 + hstep, voffA);
            PG8_WAIT_V(8); PG8_WAIT_L(0); PG8_BAR; PG8_MMA(0, 0, At, B0); PG8_MMA(0, 1, At, B1); PG8_BAR; PG8_SCHED;
            PG8_LDA(At, 1, 1); PG8_STAGE(PG8_SB(1, 0), b3, voffB); PG8_STAGE(PG8_SB(1, 1), b3 + hstep, voffB); PG8_STAGE(PG8_SA(1, 0), a3, voffA);
            PG8_WAIT_V(8); PG8_WAIT_L(0); PG8_BAR; PG8_MMA(1, 0, At, B0); PG8_MMA(1, 1, At, B1); PG8_BAR; PG8_SCHED;
            } else {
            PG8_LDB(B0, 0, 0); PG8_SCHED; PG8_LDA(At, 0, 0); PG8_STAGE(PG8_SA(1, 1), a1 + hstep, voffA);
            PG8_WAIT_L(8); PG8_BAR; PG8_WAIT_L(0); PG8_MMA(0, 0, At, B0); PG8_BAR; PG8_SCHED;
            PG8_LDB(B1, 0, 1); PG8_STAGE(PG8_SB(0, 0), b2, voffB);
            PG8_BAR; PG8_WAIT_L(0); PG8_MMA(0, 1, At, B1); PG8_BAR;
            PG8_LDA(At, 0, 1); PG8_STAGE(PG8_SA(0, 0), a2, voffA);
            PG8_BAR; PG8_WAIT_L(0); PG8_MMA(1, 0, At, B0); PG8_BAR; PG8_SCHED;
            PG8_STAGE(PG8_SB(0, 1), b2 + hstep, voffB);
            PG8_WAIT_V(6); PG8_BAR; PG8_MMA(1, 1, At, B1); PG8_BAR;
            PG8_LDB(B0, 1, 0); PG8_SCHED; PG8_LDA(At, 1, 0); PG8_STAGE(PG8_SA(0, 1), a2 + hstep, voffA);
            PG8_WAIT_L(8); PG8_BAR; PG8_WAIT_L(0); PG8_MMA(0, 0, At, B0); PG8_BAR; PG8_SCHED;
            PG8_LDB(B1, 1, 1); PG8_STAGE(PG8_SB(1, 0), b3, voffB);
            PG8_BAR; PG8_WAIT_L(0); PG8_MMA(0, 1, At, B1); PG8_BAR;
            PG8_LDA(At, 1, 1); PG8_STAGE(PG8_SA(1, 0), a3, voffA);
            PG8_BAR; PG8_WAIT_L(0); PG8_MMA(1, 0, At, B0); PG8_BAR; PG8_SCHED;
            PG8_STAGE(PG8_SB(1, 1), b3 + hstep, voffB);
            PG8_WAIT_V(6); PG8_BAR; PG8_MMA(1, 1, At, B1); PG8_BAR;
            }
        }
        if constexpr (ALIGN_EPI) { if (wr == 0) PG8_BAR; }
        if constexpr (!Epi::AFTER_DRAIN) { E(acc, cur, wr, wc, fr, fq); S.done(cur); }
        if (!has_next) break;
#pragma unroll
        for (int a = 0; a < 2; ++a)
#pragma unroll
            for (int b = 0; b < 2; ++b)
#pragma unroll
                for (int m = 0; m < 4; ++m)
#pragma unroll
                    for (int n = 0; n < 2; ++n) acc[a][b][m][n] = (f32x4){0.f, 0.f, 0.f, 0.f};
        cur = nxt; cA = nA; cB = nB; ++ui;
        if constexpr (ALIGN_EPI) { if (wr == 1) PG8_BAR; }
    }
    PG8_WAIT_V(0);
    if constexpr (!ALIGN_EPI) { if (wr == 0) PG8_BAR; }
    PG8_BAR;
    if constexpr (Epi::AFTER_DRAIN) { E.fused(acc, cur, wr, wc, fr, fq, lds, wid, lane); S.done(cur); }
#undef PG8_SA
#undef PG8_SB
#undef PG8_STAGE
#undef PG8_LDA
#undef PG8_LDB
#undef PG8_MMA
#undef PG8_WAIT_V
#undef PG8_WAIT_L
#undef PG8_BAR
#undef PG8_SCHED
}
}
using pg8::silu_f;

constexpr int L = 8192, DM = 2048, FF = 5632, NIN = 6176, NING = 6144, HYW = 1024;
constexpr int PHY_LD = 3072, PR_LD = 3072;
constexpr int PR_Q = 0, PR_K = 512, PR_V = 1024, PR_R = 2048;
constexpr int NT = 512;
constexpr int LDS_BYTES = 147456;
constexpr int FN = 16384;

constexpr size_t MiB = 1u << 20;
constexpr size_t WS_ROWSS = 0;
constexpr size_t WS_DEC = 128 * 1024;
constexpr size_t WS_PCNT = 640 * 1024 + 16384;
constexpr size_t WS_BAR = 640 * 1024;
constexpr size_t WS_W4T = 1 * MiB;
constexpr size_t WS_HID = 2 * MiB;
constexpr size_t WS_SK = 6 * MiB;
constexpr size_t SK_STRIDE = 8448;
constexpr size_t WS_WFF = 39 * MiB;
constexpr size_t WS_WDN = WS_WFF + 44 * MiB;
constexpr size_t WS_ST = WS_WFF;
constexpr size_t WS_WIN = 105 * MiB;
constexpr size_t WS_WOUT = 130 * MiB;
constexpr size_t WS_XB = 138 * MiB;
constexpr size_t WS_A = 170 * MiB;
constexpr size_t WS_ZT = WS_A;
constexpr size_t WS_X0T = WS_A + 32 * MiB;
constexpr size_t WS_PHY = 258 * MiB;
constexpr size_t WS_MIX = WS_PHY;
constexpr size_t WS_PR = 306 * MiB;
constexpr size_t WS_LR = WS_PR + 48 * MiB;
constexpr size_t WS_END = 358 * MiB;

typedef unsigned short bf16_t;
typedef short bf16x8 __attribute__((ext_vector_type(8)));
typedef float f32x4 __attribute__((ext_vector_type(4)));
typedef unsigned u32x4 __attribute__((ext_vector_type(4)));
typedef unsigned u32x2 __attribute__((ext_vector_type(2)));
#define LAS __attribute__((address_space(3)))
typedef float c2 __attribute__((ext_vector_type(2)));
__device__ __forceinline__ c2 mk2(float a, float b) { return (c2){a, b}; }
#define LDS_WAIT() asm volatile("s_waitcnt lgkmcnt(0)" ::: "memory")

__device__ __forceinline__ unsigned f2bf(float f) { unsigned u = __builtin_bit_cast(unsigned, f); return (u + 0x7fffu + ((u >> 16) & 1u)) >> 16; }
__device__ __forceinline__ unsigned pk2(float lo, float hi) { return f2bf(lo) | (f2bf(hi) << 16); }
__device__ __forceinline__ float bf2f(unsigned h) { return __builtin_bit_cast(float, h << 16); }
__device__ __forceinline__ float wave_sum(float v) {
#pragma unroll
    for (int o = 1; o < 64; o <<= 1) v += __shfl_xor(v, o);
    return v;
}

struct Params {
    const float* in[32];
    float* out;
    unsigned char* ws;
};

__device__ __forceinline__ void transpose_item(const float* __restrict__ W, int K, int N, bf16_t* __restrict__ WT, int mode, const float* __restrict__ gain, LAS float* scr, int item, int lane) {
    const int nblk = N / 32, kb = item / nblk, nb = item % nblk, k0 = 64 * kb, n0 = 32 * nb;
    const int drow0 = mode == 0 ? n0 : (256 * (n0 >> 7) + (n0 & 127) + (mode == 2 ? 128 : 0));
    const int c = lane & 7;
    f32x4 g0 = (f32x4){1.f, 1.f, 1.f, 1.f}, g1 = g0;
    if (gain) { g0 = *(const f32x4*)(gain + k0 + 8 * c); g1 = *(const f32x4*)(gain + k0 + 8 * c + 4); }
    float v[32];
    const float* wp = W + (size_t)(k0 + (lane >> 5)) * N + n0 + (lane & 31);
#pragma unroll
    for (int i = 0; i < 32; ++i) v[i] = __builtin_nontemporal_load(wp + (size_t)(2 * i) * N);
#pragma unroll
    for (int i = 0; i < 32; ++i) scr[(2 * i + (lane >> 5)) * 33 + (lane & 31)] = v[i];
    LDS_WAIT(); asm volatile("" ::: "memory");
#pragma unroll
    for (int j = 0; j < 4; ++j) { const int n = (lane >> 3) + 8 * j; const LAS float* s = scr + (8 * c) * 33 + n;
        u32x4 o; o.x = pk2(s[0 * 33] * g0[0], s[1 * 33] * g0[1]); o.y = pk2(s[2 * 33] * g0[2], s[3 * 33] * g0[3]); o.z = pk2(s[4 * 33] * g1[0], s[5 * 33] * g1[1]); o.w = pk2(s[6 * 33] * g1[2], s[7 * 33] * g1[3]);
        *(u32x4*)(WT + (size_t)(drow0 + n) * K + k0 + 8 * c) = o; }
    LDS_WAIT(); asm volatile("" ::: "memory");
}
constexpr int IT_FF = (DM / 64) * (FF / 32);
__device__ __forceinline__ void convert_gu(const float* wg, const float* wu, const float* gain, unsigned char* ws, LAS unsigned char* lds, int gw, int ngw, int lane, int wave) {
    LAS float* scr = (LAS float*)(lds + wave * 8448); bf16_t* WGU = (bf16_t*)(ws + WS_WFF);
#pragma unroll 1
    for (int it = gw; it < 2 * IT_FF; it += ngw) { if (it < IT_FF) transpose_item(wg, DM, FF, WGU, 1, gain, scr, it, lane); else transpose_item(wu, DM, FF, WGU, 2, gain, scr, it - IT_FF, lane); }
}
__device__ __forceinline__ void convert_dn(const float* wd, unsigned char* ws, LAS unsigned char* lds, int gw, int ngw, int lane, int wave) {
    LAS float* scr = (LAS float*)(lds + wave * 8448); bf16_t* WDN = (bf16_t*)(ws + WS_WDN);
#pragma unroll 1
    for (int it = gw; it < IT_FF; it += ngw) transpose_item(wd, FF, DM, WDN, 0, nullptr, scr, it, lane);
}
__device__ __forceinline__ void convert_tail1(const Params& p, LAS unsigned char* lds, int gw, int ngw, int lane, int wave) {
    LAS float* scr = (LAS float*)(lds + wave * 8448); unsigned char* ws = p.ws;
    constexpr int IT_IN = (DM / 64) * (NIN / 32), IT_OUT = (DM / 64) * (DM / 32);
#pragma unroll 1
    for (int it = gw; it < IT_FF + IT_IN + IT_OUT; it += ngw) {
        if (it < IT_FF) transpose_item(p.in[4], FF, DM, (bf16_t*)(ws + WS_WDN), 0, nullptr, scr, it, lane);
        else if (it < IT_FF + IT_IN) transpose_item(p.in[6], DM, NIN, (bf16_t*)(ws + WS_WIN), 0, p.in[5], scr, it - IT_FF, lane);
        else transpose_item(p.in[26], DM, DM, (bf16_t*)(ws + WS_WOUT), 0, nullptr, scr, it - IT_FF - IT_IN, lane);
    }
}
__device__ __forceinline__ void hid_pass(const Params& p, LAS float* sm, const LAS float* WL, int pos0, int tid) {
    const float* b1 = p.in[10]; const float* f1 = p.in[11]; const float* b2 = p.in[13]; const float* f2 = p.in[14]; const float* b3 = p.in[16]; const float* f3 = p.in[17];
    bf16_t* hidx = (bf16_t*)(p.ws + WS_HID);
    const int pp = tid >> 6, j = tid & 63, pos = pos0 + pp;
    LAS float* Z = sm; LAS float* H1 = sm + 512; LAS float* H2 = sm + 1024;
    const LAS float* w1 = WL; const LAS float* w2 = WL + 33 * 64; const LAS float* w3 = w2 + 64 * 64;
    if (j < 33) {
        float z;
        if (j == 0) z = (float)pos / 8191.0f;
        else {
            const int b = (j - 1) & 15; const float fj = 1e-4f + (float)b * ((15.0f - 1e-4f) / 15.0f);
            const double r = (double)pos * (double)fj * (1.0 / 8192.0); const float fr = (float)(r - floor(r));
            float s, c; sincospif(2.0f * fr, &s, &c);
            z = (j <= 16) ? c : -s;
        }
        Z[pp * 40 + j] = z;
    }
    __syncthreads();
    float a, a0 = b1[j] + Z[pp * 40 + 32] * w1[32 * 64 + j], a1 = 0.f, a2 = 0.f, a3 = 0.f;
#pragma unroll
    for (int k4 = 0; k4 < 8; ++k4) { const f32x4 h = *(const LAS f32x4*)(Z + pp * 40 + 4 * k4);
        a0 += h[0] * w1[(4 * k4 + 0) * 64 + j]; a1 += h[1] * w1[(4 * k4 + 1) * 64 + j]; a2 += h[2] * w1[(4 * k4 + 2) * 64 + j]; a3 += h[3] * w1[(4 * k4 + 3) * 64 + j]; }
    a = (a0 + a1) + (a2 + a3);
    H1[pp * 64 + j] = sinf(f1[j] * a);
    __syncthreads();
    a0 = b2[j]; a1 = 0.f; a2 = 0.f; a3 = 0.f;
#pragma unroll
    for (int k4 = 0; k4 < 16; ++k4) { const f32x4 h = *(const LAS f32x4*)(H1 + pp * 64 + 4 * k4);
        a0 += h[0] * w2[(4 * k4 + 0) * 64 + j]; a1 += h[1] * w2[(4 * k4 + 1) * 64 + j]; a2 += h[2] * w2[(4 * k4 + 2) * 64 + j]; a3 += h[3] * w2[(4 * k4 + 3) * 64 + j]; }
    a = (a0 + a1) + (a2 + a3);
    H2[pp * 64 + j] = sinf(f2[j] * a);
    __syncthreads();
    a0 = b3[j]; a1 = 0.f; a2 = 0.f; a3 = 0.f;
#pragma unroll
    for (int k4 = 0; k4 < 16; ++k4) { const f32x4 h = *(const LAS f32x4*)(H2 + pp * 64 + 4 * k4);
        a0 += h[0] * w3[(4 * k4 + 0) * 64 + j]; a1 += h[1] * w3[(4 * k4 + 1) * 64 + j]; a2 += h[2] * w3[(4 * k4 + 2) * 64 + j]; a3 += h[3] * w3[(4 * k4 + 3) * 64 + j]; }
    a = (a0 + a1) + (a2 + a3);
    { const float h3 = sinf(f3[j] * a); const unsigned hi = f2bf(h3); bf16_t* hr = hidx + (size_t)pos * 256 + j; hr[0] = (bf16_t)hi; hr[64] = (bf16_t)f2bf(h3 - bf2f(hi)); hr[128] = (bf16_t)hi; hr[192] = 0; }
}
__device__ __forceinline__ void phase0(const Params& p, LAS unsigned char* lds, int tid, int lane, int wave, int mask) {
    const int G = gridDim.x, gw = blockIdx.x * 8 + wave, ngw = G * 8;
    unsigned char* ws = p.ws;
    if (mask & 1) convert_gu(p.in[2], p.in[3], p.in[1], ws, lds, gw, ngw, lane, wave);
    const int gt = blockIdx.x * NT + tid, ngt = G * NT;
    {
      float* rs = (float*)(ws + WS_ROWSS) + L; for (int i = gt; i < 3 * L; i += ngt) rs[i] = 0.f; }
    { const float* w4 = p.in[18]; bf16_t* tx = (bf16_t*)(ws + WS_W4T);
      for (int i = gt; i < 2048 * 64; i += ngt) { const int c = i >> 6, k = i & 63; const float v = w4[k * 2048 + c]; const unsigned hi = f2bf(v); bf16_t* tr = tx + (size_t)c * 256 + k; tr[0] = (bf16_t)hi; tr[64] = (bf16_t)hi; tr[128] = (bf16_t)f2bf(v - bf2f(hi)); tr[192] = 0; } }
    if (mask & 4) {
        const float* x = p.in[0]; bf16_t* xb = (bf16_t*)(ws + WS_XB); float* rs = (float*)(ws + WS_ROWSS);
#pragma unroll 1
        for (int m = gw; m < L; m += ngw) {
            const f32x4* xr = (const f32x4*)(x + (size_t)m * DM) + lane; u32x2* o = (u32x2*)(xb + (size_t)m * DM) + lane; float s = 0.f;
#pragma unroll
            for (int j = 0; j < 8; ++j) { const f32x4 v = __builtin_nontemporal_load(xr + 64 * j); s += (v[0] * v[0] + v[1] * v[1]) + (v[2] * v[2] + v[3] * v[3]);
                u32x2 w; w.x = pk2(v[0], v[1]); w.y = pk2(v[2], v[3]); o[64 * j] = w; }
            s = wave_sum(s); if (lane == 0) rs[m] = s;
        }
    }
    __syncthreads();
    if (mask & 8) { LAS float* WL = (LAS float*)lds + 2048;
      for (int i = tid; i < 33 * 64; i += NT) WL[i] = p.in[9][i];
      for (int i = tid; i < 64 * 64; i += NT) { WL[33 * 64 + i] = p.in[12][i]; WL[33 * 64 + 64 * 64 + i] = p.in[15][i]; }
      __syncthreads();
#pragma unroll 1
      for (int ps = blockIdx.x; ps < L / 8; ps += G) { hid_pass(p, (LAS float*)lds, WL, ps * 8, tid); __syncthreads(); } }
}

__device__ __forceinline__ void convT_fetch(const bf16_t* phy, int tile, int tid, u32x4 (&rw)[4]) {
    const int t0 = (tile >> 4) * 64, c0 = (tile & 15) * 64;
#pragma unroll
    for (int k = 0; k < 4; ++k) { const int idx = tid + NT * k; rw[k] = (u32x4){0u, 0u, 0u, 0u};
        if (idx < 3 * 66 * 8) { const int s = idx / 528, r = (idx % 528) >> 3, c8 = (idx & 7) * 8, tt = t0 - 1 + r;
            if (tt >= 0 && tt < L) rw[k] = *(const u32x4*)(phy + (size_t)tt * PHY_LD + s * HYW + c0 + c8); } }
}
__device__ __forceinline__ void convT_tile(const Params& p, LAS unsigned char* lds, int tile, int tid, const u32x4 (&rw)[4]) {
    bf16_t* zT = (bf16_t*)(p.ws + WS_ZT); bf16_t* x0T = (bf16_t*)(p.ws + WS_X0T);
    const float* cw = p.in[7]; const float* cb = p.in[8];
    LAS float* zt = (LAS float*)lds; LAS float* xt = zt + 64 * 65;
    LAS bf16_t* raw = (LAS bf16_t*)(lds + 33280);
    const int t0 = (tile >> 4) * 64, c0 = (tile & 15) * 64;
#pragma unroll
    for (int k = 0; k < 4; ++k) { const int idx = tid + NT * k; if (idx < 3 * 66 * 8) { const int s = idx / 528, r = (idx % 528) >> 3, c8 = (idx & 7) * 8; *(LAS u32x4*)(raw + (s * 66 + r) * 64 + c8) = rw[k]; } }
    const int c = tid & 63, tg = tid >> 6;
    float w[3][3], b[3];
#pragma unroll
    for (int s = 0; s < 3; ++s) { const int col = s * HYW + c0 + c; b[s] = cb[col];
#pragma unroll
        for (int tap = 0; tap < 3; ++tap) w[s][tap] = cw[tap * 3 * HYW + col]; }
    __syncthreads();
#pragma unroll
    for (int i = 0; i < 8; ++i) {
        const int tl = tg * 8 + i; float u[3];
#pragma unroll
        for (int s = 0; s < 3; ++s) { float a = b[s];
#pragma unroll
            for (int tap = 0; tap < 3; ++tap) a += w[s][tap] * bf2f(raw[(s * 66 + tl + tap) * 64 + c]);
            u[s] = a; }
        zt[c * 65 + tl] = u[2] * u[1]; xt[c * 65 + tl] = u[0];
    }
    __syncthreads();
    { const int t = tid & 63, cg8 = tid >> 6;
#pragma unroll
      for (int i = 0; i < 8; ++i) { const int cc = cg8 * 8 + i; zT[(size_t)(c0 + cc) * L + t0 + t] = (bf16_t)f2bf(zt[cc * 65 + t]); x0T[(size_t)(c0 + cc) * L + t0 + t] = (bf16_t)f2bf(xt[cc * 65 + t]); } }
    __syncthreads();
}

__device__ __forceinline__ float logsig16(float x) { return (fminf(x, 0.f) - __logf(1.0f + __expf(-fabsf(x)))) * (1.0f / 16.0f); }
__device__ __forceinline__ bf16x8 ldfrag(const LAS bf16_t* base, int ld, int row0, int k0, int lane) { return *(const LAS bf16x8*)(base + (row0 + (lane & 15)) * ld + k0 + 8 * (lane >> 4)); }

__device__ __forceinline__ void gla_stage(const bf16_t* pr, const float* lr, int t0, int h, LAS float* lrs, LAS bf16_t* vT, int tid) {
    *(LAS f32x4*)(lrs + tid * 4) = *(const f32x4*)(lr + (size_t)t0 * 32 + tid * 4);
    { const int c = tid & 255, tb = tid >> 8; const bf16_t* vp = pr + (size_t)t0 * PR_LD + PR_V + h * 256 + c;
#pragma unroll
      for (int i = 0; i < 4; ++i) { const int tk = (tb * 4 + i) * 8; unsigned short e[8];
#pragma unroll
          for (int j = 0; j < 8; ++j) e[j] = vp[(size_t)(tk + j) * PR_LD];
          u32x4 w; w.x = e[0] | ((unsigned)e[1] << 16); w.y = e[2] | ((unsigned)e[3] << 16); w.z = e[4] | ((unsigned)e[5] << 16); w.w = e[6] | ((unsigned)e[7] << 16);
          *(LAS u32x4*)(vT + c * 72 + tk) = w; } }
}
struct GateW { float w[16]; float b; };
__device__ __forceinline__ void gate_load(const Params& p, int dir, int h, int d, GateW& g) {
    const float* wa = dir ? p.in[23] : p.in[21]; const float* ba = dir ? p.in[24] : p.in[22];
#pragma unroll
    for (int r = 0; r < 16; ++r) g.w[r] = wa[r * 512 + h * 128 + d];
    g.b = ba[h * 128 + d];
}
__device__ __forceinline__ float gate_eval(const GateW& g, const LAS float* lr) {
    const LAS f32x4* l4 = (const LAS f32x4*)lr; const f32x4 a = l4[0], b = l4[1], c = l4[2], d = l4[3];
    float x0 = g.b, x1 = 0.f, x2 = 0.f, x3 = 0.f;
#pragma unroll
    for (int r = 0; r < 4; ++r) { x0 += a[r] * g.w[r]; x1 += b[r] * g.w[4 + r]; x2 += c[r] * g.w[8 + r]; x3 += d[r] * g.w[12 + r]; }
    return logsig16((x0 + x1) + (x2 + x3));
}

__device__ __forceinline__ void gla_kv_item(const Params& p, LAS unsigned char* lds, int item, int tid, int lane, int wave) {
    const int h = item & 3, n = item >> 2, t0 = n * 64;
    const bf16_t* pr = (const bf16_t*)(p.ws + WS_PR); bf16_t* ST = (bf16_t*)(p.ws + WS_ST); float* dec = (float*)(p.ws + WS_DEC);
    LAS bf16_t* vT = (LAS bf16_t*)lds; LAS bf16_t* kstT = (LAS bf16_t*)(lds + 36864);
    LAS float* lrs = (LAS float*)(lds + 73728); LAS float* tot = (LAS float*)(lds + 81920);
    gla_stage(pr, (const float*)(p.ws + WS_LR), t0, h, lrs, vT, tid);
    const int d = tid & 127, dir = (tid >> 7) & 1, half = tid >> 8;
    GateW gw; gate_load(p, dir, h, d, gw);
    const bf16_t* kp = pr + (size_t)t0 * PR_LD + PR_K + h * 128 + d;
    unsigned short kr[8];
#pragma unroll
    for (int u = 0; u < 8; ++u) { const int q = half * 32 + u, t = dir ? 63 - q : q; kr[u] = kp[(size_t)t * PR_LD]; }
    __syncthreads();
    float sum = 0.f;
#pragma unroll 4
    for (int s = 0; s < 32; ++s) { const int q = half * 32 + s, t = dir ? 63 - q : q; sum += gate_eval(gw, lrs + t * 32 + dir * 16); }
    tot[(dir * 2 + half) * 128 + d] = sum;
    __syncthreads();
    {
        const float t0s = tot[(dir * 2 + 0) * 128 + d], total = t0s + tot[(dir * 2 + 1) * 128 + d];
        float b = half ? t0s : 0.f;
#pragma unroll 1
        for (int sg = 0; sg < 4; ++sg) {
            unsigned short kn[8];
#pragma unroll
            for (int u = 0; u < 8; ++u) { const int q = half * 32 + ((sg * 8 + 8 + u) & 31), t = dir ? 63 - q : q; kn[u] = kp[(size_t)t * PR_LD]; }
            unsigned ke[8];
#pragma unroll
            for (int u = 0; u < 8; ++u) { const int q = half * 32 + sg * 8 + u, t = dir ? 63 - q : q; b += gate_eval(gw, lrs + t * 32 + dir * 16);
                ke[dir ? 7 - u : u] = f2bf(bf2f(kr[u]) * __expf(total - b)); }
            { const int q0 = half * 32 + sg * 8, tlo = dir ? 63 - q0 - 7 : q0; u32x4 w; w.x = ke[0] | (ke[1] << 16); w.y = ke[2] | (ke[3] << 16); w.z = ke[4] | (ke[5] << 16); w.w = ke[6] | (ke[7] << 16);
              *(LAS u32x4*)(kstT + (dir * 128 + d) * 72 + tlo) = w; }
#pragma unroll
            for (int u = 0; u < 8; ++u) kr[u] = kn[u];
        }
        if (half == 0) dec[((size_t)(dir * 128 + n) * 4 + h) * 128 + d] = __expf(total);
    }
    __syncthreads();
    const int q4 = lane >> 4, v0 = wave * 32;
#pragma unroll 1
    for (int dr = 0; dr < 2; ++dr) {
        f32x4 acc[8][2];
#pragma unroll
        for (int mt = 0; mt < 8; ++mt) { acc[mt][0] = (f32x4){0.f, 0.f, 0.f, 0.f}; acc[mt][1] = (f32x4){0.f, 0.f, 0.f, 0.f}; }
#pragma unroll
        for (int ks = 0; ks < 2; ++ks) {
            const bf16x8 b0 = ldfrag(vT, 72, v0, 32 * ks, lane), b1 = ldfrag(vT, 72, v0 + 16, 32 * ks, lane);
#pragma unroll
            for (int mt = 0; mt < 8; ++mt) { const bf16x8 a = ldfrag(kstT + dr * 128 * 72, 72, 16 * mt, 32 * ks, lane);
                acc[mt][0] = __builtin_amdgcn_mfma_f32_16x16x32_bf16(a, b0, acc[mt][0], 0, 0, 0);
                acc[mt][1] = __builtin_amdgcn_mfma_f32_16x16x32_bf16(a, b1, acc[mt][1], 0, 0, 0); }
        }
        bf16_t* S = ST + ((size_t)(dr * 4 + h) * 128 + n) * 32768;
#pragma unroll
        for (int mt = 0; mt < 8; ++mt)
#pragma unroll
            for (int nt = 0; nt < 2; ++nt) { u32x2 w; w.x = pk2(acc[mt][nt][0], acc[mt][nt][1]); w.y = pk2(acc[mt][nt][2], acc[mt][nt][3]);
                *(u32x2*)(S + (size_t)(v0 + 16 * nt + (lane & 15)) * 128 + 16 * mt + 4 * q4) = w; }
    }
    __syncthreads();
}

#ifndef REP_FA
#define REP_FA 0
#endif
#ifndef REP_FB
#define REP_FB 0
#endif
__device__ __forceinline__ void lr_task(const Params& p, LAS unsigned char* lds, int task, int tid, int lane, int wave) {
    const bf16_t* xb = (const bf16_t*)(p.ws + WS_XB); const bf16_t* wt = (const bf16_t*)(p.ws + WS_WIN) + (size_t)NING * DM;
    const float* rowss1 = (const float*)(p.ws + WS_ROWSS) + L; float* lr = (float*)(p.ws + WS_LR);
    const int mt = wave >> 2, nt = (wave >> 1) & 1, kh = wave & 1, fr = lane & 15, q4 = lane >> 4, t0 = task * 32;
    const bf16_t* ap = xb + (size_t)(t0 + 16 * mt + fr) * DM + kh * 1024 + 8 * q4; const bf16_t* bp = wt + (size_t)(16 * nt + fr) * DM + kh * 1024 + 8 * q4;
    f32x4 acc = (f32x4){0.f, 0.f, 0.f, 0.f};
#pragma unroll 1
    for (int kb = 0; kb < 2; ++kb) { bf16x8 a[16], b[16];
#pragma unroll
        for (int u = 0; u < 16; ++u) { a[u] = *(const bf16x8*)(ap + (kb * 16 + u) * 32); b[u] = *(const bf16x8*)(bp + (kb * 16 + u) * 32); }
#pragma unroll
        for (int u = 0; u < 16; ++u) acc = __builtin_amdgcn_mfma_f32_16x16x32_bf16(a[u], b[u], acc, 0, 0, 0); }
    LAS f32x4* ex = (LAS f32x4*)lds;
    if (kh) ex[(wave >> 1) * 64 + lane] = acc;
    __syncthreads();
    if (!kh) { const f32x4 o = ex[(wave >> 1) * 64 + lane];
#pragma unroll
        for (int r = 0; r < 4; ++r) { const int t = t0 + 16 * mt + 4 * q4 + r; lr[(size_t)t * 32 + 16 * nt + fr] = (acc[r] + o[r]) * pg8::rstd_of(rowss1[t]); } }
    __syncthreads();
}
__device__ __forceinline__ c2 cmul(c2 a, c2 b) { return mk2(a.x * b.x - a.y * b.y, a.x * b.y + a.y * b.x); }
__device__ __forceinline__ c2 twid(int m) { const float r = (float)m * (1.0f / 16384.0f); return mk2(__builtin_amdgcn_cosf(r), -__builtin_amdgcn_sinf(r)); }
__device__ __forceinline__ c2 cmulc(c2 a, c2 b) { return mk2(a.x * b.x + a.y * b.y, a.y * b.x - a.x * b.y); }
#define XI(i) ((i) + ((i) >> 5))
constexpr int XPAD_BYTES = (FN + FN / 32) * 8;
__constant__ const float C16c[8] = {1.f, 0.9238795325112867f, 0.7071067811865476f, 0.3826834323650898f, 0.f, -0.3826834323650898f, -0.7071067811865476f, -0.9238795325112867f};
__constant__ const float C16s[8] = {0.f, 0.3826834323650898f, 0.7071067811865476f, 0.9238795325112867f, 1.f, 0.9238795325112867f, 0.7071067811865476f, 0.3826834323650898f};
template <int R, bool INV, int UNR> __device__ __forceinline__ void fft_pass(LAS c2* X, int lo, int tid) {
    constexpr int RAD = 1 << R;
    const int stride = 1 << lo, ls = lo + R - 1;
    int tt = tid; asm volatile("" : "+v"(tt));
#pragma unroll 1
    for (int g = tt; g < FN / RAD; g += NT) {
        const int j0 = g & (stride - 1), i = ((g - j0) << R) + j0;
        c2 e[RAD];
#pragma unroll
        for (int q = 0; q < RAD; ++q) e[q] = X[XI(i + q * stride)];
#pragma unroll
        for (int t = 0; t < R; ++t) {
            const int Hq = INV ? (1 << t) : (RAD >> (t + 1));
            const c2 base = twid(j0 << (INV ? (13 - lo - t) : (13 - ls + t)));
#pragma unroll
            for (int bf = 0; bf < RAD / 2; ++bf) {
                const int qm = bf & (Hq - 1), q = ((bf - qm) << 1) + qm, k16 = qm * (8 / Hq);
                const c2 w = (k16 == 0) ? base : cmul(base, mk2(C16c[k16], -C16s[k16]));
                if (!INV) { const c2 a = e[q], b = e[q + Hq]; e[q] = a + b; e[q + Hq] = cmul(a - b, w); }
                else { const c2 a = e[q], b = cmulc(e[q + Hq], w); e[q] = a + b; e[q + Hq] = a - b; }
            }
        }
#pragma unroll
        for (int q = 0; q < RAD; ++q) X[XI(i + q * stride)] = e[q];
    }
    __syncthreads();
}
__device__ __forceinline__ void fft_dif(LAS c2* X, int tid) { fft_pass<4, false, 2>(X, 10, tid); fft_pass<4, false, 2>(X, 6, tid); fft_pass<4, false, 2>(X, 2, tid); fft_pass<2, false, 4>(X, 0, tid); }
__device__ __forceinline__ void fft_dit_inv(LAS c2* X, int tid) { fft_pass<2, true, 4>(X, 0, tid); fft_pass<4, true, 2>(X, 2, tid); fft_pass<4, true, 2>(X, 6, tid); fft_pass<4, true, 2>(X, 10, tid); }
__device__ __forceinline__ int br14(int x) { return (int)(__brev((unsigned)x) >> 18); }
__device__ __forceinline__ float block_sum(float v, LAS float* red, int tid, int lane, int wave) {
    v = wave_sum(v); __syncthreads(); if (lane == 0) red[wave] = v; __syncthreads();
    float s = 0.f;
#pragma unroll
    for (int i = 0; i < 8; ++i) s += red[i];
    return s;
}
__device__ __forceinline__ void hyena_fft_pair(const Params& p, LAS unsigned char* lds, int pair, int tid, int lane, int wave) {
    const int c = pair * 2;
    const float* skip = p.in[19];
    bf16_t* zT = (bf16_t*)(p.ws + WS_ZT); const bf16_t* x0T = (const bf16_t*)(p.ws + WS_X0T);
    f32x4* SK = (f32x4*)(p.ws + WS_SK) + (size_t)blockIdx.x * SK_STRIDE;
    LAS c2* X = (LAS c2*)lds; LAS float* red = (LAS float*)(lds + XPAD_BYTES);
    const float dmin = -3.0701134573253945f, dmax = -15.350567286626973f;
    const float del0 = fabsf(dmin + (float)c * ((dmax - dmin) / 1023.0f)), del1 = fabsf(dmin + (float)(c + 1) * ((dmax - dmin) / 1023.0f));
    float n0 = 0.f, n1 = 0.f, inv0 = 0.f, inv1 = 0.f;
#pragma unroll 1
    for (int rb = 0; rb <= REP_FB; ++rb) {
    n0 = 0.f; n1 = 0.f;
    {
        const bf16_t* ff = (const bf16_t*)p.out + (size_t)c * L; const bf16_t* fb = (const bf16_t*)p.out + (size_t)(HYW + c) * L;
#pragma unroll 1
        for (int ub = 0; ub < 2; ++ub) { float f0[8], f1[8], g0[8], g1[8];
#pragma unroll
            for (int u = 0; u < 8; ++u) { const int i = tid + NT * (ub * 8 + u); f0[u] = bf2f(ff[i]); f1[u] = bf2f(ff[L + i]); g0[u] = bf2f(fb[i]); g1[u] = bf2f(fb[L + i]); }
#pragma unroll
            for (int u = 0; u < 8; ++u) { const int i = tid + NT * (ub * 8 + u);
                X[XI(i)] = mk2(f0[u], f1[u]); n0 += fabsf(f0[u]); n1 += fabsf(f1[u]);
                if (i >= 1) { X[XI(FN - i)] = mk2(g0[u], g1[u]); n0 += fabsf(g0[u]); n1 += fabsf(g1[u]); } } }
    }
    if (tid == 0) X[XI(L)] = mk2(0.f, 0.f);
    inv0 = 1.0f / block_sum(n0, red, tid, lane, wave); inv1 = 1.0f / block_sum(n1, red, tid, lane, wave);
    __syncthreads();
    fft_dif(X, tid);
#pragma unroll 2
    for (int m = tid; m < FN / 2; m += NT) { const int pp = 2 * m, k = br14(pp), pm = br14((FN - k) & (FN - 1)); const c2 F = X[XI(pp)], Fm = X[XI(pm)];
        SK[m] = (f32x4){0.5f * (F.x + Fm.x), 0.5f * (F.y - Fm.y), 0.5f * (F.y + Fm.y), -0.5f * (F.x - Fm.x)}; }
    if (tid == 0) { const c2 F = X[XI(1)]; SK[FN / 2] = (f32x4){F.x, 0.f, F.y, 0.f}; }
    __syncthreads();
    }
    { float za[16], zb[16];
#pragma unroll
      for (int u = 0; u < 16; ++u) { za[u] = bf2f(zT[(size_t)c * L + tid + NT * u]); zb[u] = bf2f(zT[(size_t)(c + 1) * L + tid + NT * u]); }
#pragma unroll
      for (int u = 0; u < 16; ++u) { X[XI(tid + NT * u)] = mk2(za[u], zb[u]); X[XI(L + tid + NT * u)] = mk2(0.f, 0.f); } }
    __syncthreads();
    fft_dif(X, tid);
#pragma unroll 2
    for (int m = tid; m < FN / 2; m += NT) {
        const int pp = 2 * m, k = br14(pp); const f32x4 kk = SK[m]; const c2 K1 = mk2(kk[0], kk[1]), K2 = mk2(kk[2], kk[3]);
        if (k == 0) { const c2 F = X[XI(0)]; X[XI(0)] = mk2(F.x * K1.x, F.y * K2.x);
            const f32x4 kh = SK[FN / 2]; const c2 F1 = X[XI(1)]; X[XI(1)] = mk2(F1.x * kh[0], F1.y * kh[2]); }
        else { const int pm = br14(FN - k); const c2 F = X[XI(pp)], Fm = X[XI(pm)];
            const c2 Z1 = mk2(0.5f * (F.x + Fm.x), 0.5f * (F.y - Fm.y)), Z2 = mk2(0.5f * (F.y + Fm.y), -0.5f * (F.x - Fm.x));
            const c2 A = cmul(Z1, K1), B = cmul(Z2, K2);
            X[XI(pp)] = mk2(A.x - B.y, A.y + B.x); X[XI(pm)] = mk2(A.x + B.y, -A.y + B.x); }
    }
    __syncthreads();
    fft_dit_inv(X, tid);
    const float sk0 = skip[c], sk1 = skip[c + 1], sc = 1.0f / (float)FN;
#pragma unroll 1
    for (int ub = 0; ub < 2; ++ub) { float z0[8], z1[8], x0[8], x1[8];
#pragma unroll
        for (int u = 0; u < 8; ++u) { const int i = tid + NT * (ub * 8 + u); const size_t o0 = (size_t)c * L + i, o1 = (size_t)(c + 1) * L + i; z0[u] = bf2f(zT[o0]); z1[u] = bf2f(zT[o1]); x0[u] = bf2f(x0T[o0]); x1[u] = bf2f(x0T[o1]); }
#pragma unroll
        for (int u = 0; u < 8; ++u) { const int i = tid + NT * (ub * 8 + u); const size_t o0 = (size_t)c * L + i, o1 = (size_t)(c + 1) * L + i; const c2 y = X[XI(i)];
            zT[o0] = (bf16_t)f2bf((y.x * sc * inv0 + sk0 * z0[u]) * x0[u]); zT[o1] = (bf16_t)f2bf((y.y * sc * inv1 + sk1 * z1[u]) * x1[u]); } }
    __syncthreads();
}
__device__ __forceinline__ void gla_scan(const Params& p, int tid) {
    unsigned* ST = (unsigned*)(p.ws + WS_ST); const float* dec = (const float*)(p.ws + WS_DEC);
    const int gt = blockIdx.x * NT + tid, ngt = gridDim.x * NT;
#pragma unroll 1
    for (int e = gt; e < 8 * 16384; e += ngt) {
        const int dh = e >> 14, idx = e & 16383, dir = dh >> 2, h = dh & 3, d = (2 * idx) & 127;
        unsigned* base = ST + (size_t)dh * 128 * 16384 + idx;
        const float* db = dec + ((size_t)dir * 128 * 4 + h) * 128 + d;
        float s0 = 0.f, s1 = 0.f;
#pragma unroll 1
        for (int nb = 0; nb < 128; nb += 16) {
            unsigned kv[16]; c2 dc[16];
#pragma unroll
            for (int u = 0; u < 16; ++u) { const int n = dir ? 127 - (nb + u) : nb + u; kv[u] = base[(size_t)n * 16384]; dc[u] = *(const c2*)(db + (size_t)n * 512); }
#pragma unroll
            for (int u = 0; u < 16; ++u) { const int n = dir ? 127 - (nb + u) : nb + u; base[(size_t)n * 16384] = pk2(s0, s1);
                s0 = dc[u].x * s0 + bf2f(kv[u] & 0xffffu); s1 = dc[u].y * s1 + bf2f(kv[u] >> 16); }
        }
    }
}

__device__ __forceinline__ void gla_out_item(const Params& p, LAS unsigned char* lds, int item, int tid, int lane, int wave) {
    const int h = item & 3, n = item >> 2, t0 = n * 64;
    const bf16_t* pr = (const bf16_t*)(p.ws + WS_PR); const bf16_t* ST = (const bf16_t*)(p.ws + WS_ST); bf16_t* mix = (bf16_t*)(p.ws + WS_MIX);
    const float* og = p.in[25];
    LAS bf16_t* qin = (LAS bf16_t*)lds;
    LAS bf16_t* kin = (LAS bf16_t*)(lds + 34816);
    LAS bf16_t* vT = (LAS bf16_t*)(lds + 69632);
    LAS bf16_t* P = (LAS bf16_t*)(lds + 106496);
    LAS float* lrs = (LAS float*)(lds + 115712); LAS float* tot = (LAS float*)(lds + 123904); LAS float* red = (LAS float*)(lds + 125952);
    gla_stage(pr, (const float*)(p.ws + WS_LR), t0, h, lrs, vT, tid);
    const int d = tid & 127, dir = (tid >> 7) & 1, half = tid >> 8;
    GateW gw; gate_load(p, dir, h, d, gw);
    const bf16_t* qp = pr + (size_t)t0 * PR_LD + PR_Q + h * 128 + d;
    unsigned short kr[8], qr[8];
#pragma unroll
    for (int u = 0; u < 8; ++u) { const int q = half * 32 + u, t = dir ? 63 - q : q; qr[u] = qp[(size_t)t * PR_LD]; kr[u] = qp[(size_t)t * PR_LD + (PR_K - PR_Q)]; }
    __syncthreads();
    float sum = 0.f;
#pragma unroll 4
    for (int s = 0; s < 32; ++s) { const int q = half * 32 + s, t = dir ? 63 - q : q; sum += gate_eval(gw, lrs + t * 32 + dir * 16); }
    tot[(dir * 2 + half) * 128 + d] = sum;
    __syncthreads();
    {
        float b = half ? tot[(dir * 2 + 0) * 128 + d] : 0.f;
#pragma unroll 1
        for (int sg = 0; sg < 4; ++sg) {
            unsigned short kn[8], qn[8];
#pragma unroll
            for (int u = 0; u < 8; ++u) { const int q = half * 32 + ((sg * 8 + 8 + u) & 31), t = dir ? 63 - q : q; qn[u] = qp[(size_t)t * PR_LD]; kn[u] = qp[(size_t)t * PR_LD + (PR_K - PR_Q)]; }
#pragma unroll
            for (int u = 0; u < 8; ++u) { const int q = half * 32 + sg * 8 + u, t = dir ? 63 - q : q; b += gate_eval(gw, lrs + t * 32 + dir * 16);
                const float qv = bf2f(qr[u]) * 0.08838834764831845f, kv = bf2f(kr[u]);
                qin[(dir * 64 + t) * 136 + d] = (bf16_t)f2bf(qv * __expf(b)); kin[(dir * 64 + t) * 136 + d] = (bf16_t)f2bf(kv * __expf(-b)); }
#pragma unroll
            for (int u = 0; u < 8; ++u) { kr[u] = kn[u]; qr[u] = qn[u]; }
        }
    }
    __syncthreads();
    const int q4 = lane >> 4, fr = lane & 15;
#pragma unroll 1
    for (int ti = 0; ti < 2; ++ti) {
        const int id = wave * 2 + ti, tt = id >> 2, st = id & 3;
        f32x4 af = (f32x4){0.f, 0.f, 0.f, 0.f}, ab = (f32x4){0.f, 0.f, 0.f, 0.f};
        if (tt >= st) {
#pragma unroll
            for (int ks = 0; ks < 4; ++ks) af = __builtin_amdgcn_mfma_f32_16x16x32_bf16(ldfrag(qin, 136, 16 * tt, 32 * ks, lane), ldfrag(kin, 136, 16 * st, 32 * ks, lane), af, 0, 0, 0); }
        if (tt <= st) {
#pragma unroll
            for (int ks = 0; ks < 4; ++ks) ab = __builtin_amdgcn_mfma_f32_16x16x32_bf16(ldfrag(qin + 64 * 136, 136, 16 * tt, 32 * ks, lane), ldfrag(kin + 64 * 136, 136, 16 * st, 32 * ks, lane), ab, 0, 0, 0); }
#pragma unroll
        for (int r = 0; r < 4; ++r) { const int t = 16 * tt + 4 * q4 + r, s = 16 * st + fr; P[t * 72 + s] = (bf16_t)f2bf(t >= s ? af[r] : ab[r]); }
    }
    __syncthreads();
    f32x4 acc[2][4];
#pragma unroll
    for (int mt = 0; mt < 2; ++mt)
#pragma unroll
        for (int nt = 0; nt < 4; ++nt) acc[mt][nt] = (f32x4){0.f, 0.f, 0.f, 0.f};
    const int v0 = wave * 32;
#pragma unroll
    for (int ks = 0; ks < 2; ++ks) {
        const bf16x8 a0 = ldfrag(vT, 72, v0, 32 * ks, lane), a1 = ldfrag(vT, 72, v0 + 16, 32 * ks, lane);
#pragma unroll
        for (int nt = 0; nt < 4; ++nt) { const bf16x8 b = ldfrag(P, 72, 16 * nt, 32 * ks, lane);
            acc[0][nt] = __builtin_amdgcn_mfma_f32_16x16x32_bf16(a0, b, acc[0][nt], 0, 0, 0); acc[1][nt] = __builtin_amdgcn_mfma_f32_16x16x32_bf16(a1, b, acc[1][nt], 0, 0, 0); }
    }
#pragma unroll 1
    for (int dr = 0; dr < 2; ++dr) {
        const bf16_t* S = ST + ((size_t)(dr * 4 + h) * 128 + n) * 32768;
        bf16x8 sa[4][2];
#pragma unroll
        for (int ks = 0; ks < 4; ++ks) { sa[ks][0] = *(const bf16x8*)(S + (size_t)(v0 + fr) * 128 + 32 * ks + 8 * q4); sa[ks][1] = *(const bf16x8*)(S + (size_t)(v0 + 16 + fr) * 128 + 32 * ks + 8 * q4); }
#pragma unroll
        for (int ks = 0; ks < 4; ++ks)
#pragma unroll
            for (int nt = 0; nt < 4; ++nt) { const bf16x8 b = ldfrag(qin + dr * 64 * 136, 136, 16 * nt, 32 * ks, lane);
                acc[0][nt] = __builtin_amdgcn_mfma_f32_16x16x32_bf16(sa[ks][0], b, acc[0][nt], 0, 0, 0); acc[1][nt] = __builtin_amdgcn_mfma_f32_16x16x32_bf16(sa[ks][1], b, acc[1][nt], 0, 0, 0); }
    }
#pragma unroll
    for (int nt = 0; nt < 4; ++nt) { float ss = 0.f;
#pragma unroll
        for (int mt = 0; mt < 2; ++mt) ss += (acc[mt][nt][0] * acc[mt][nt][0] + acc[mt][nt][1] * acc[mt][nt][1]) + (acc[mt][nt][2] * acc[mt][nt][2] + acc[mt][nt][3] * acc[mt][nt][3]);
        ss += __shfl_xor(ss, 16); ss += __shfl_xor(ss, 32);
        if (q4 == 0) red[wave * 64 + 16 * nt + fr] = ss; }
    __syncthreads();
#pragma unroll
    for (int nt = 0; nt < 4; ++nt) { const int t = 16 * nt + fr; float ss = 0.f;
#pragma unroll
        for (int w = 0; w < 8; ++w) ss += red[w * 64 + t];
        const float rs = rsqrtf(ss * (1.0f / 256.0f) + 1e-6f);
#pragma unroll
        for (int mt = 0; mt < 2; ++mt) { const int v = v0 + 16 * mt + 4 * q4; const f32x4 g = *(const f32x4*)(og + h * 256 + v);
            const u32x2 rw = *(const u32x2*)(pr + (size_t)(t0 + t) * PR_LD + PR_R + h * 256 + v);
            const float r0 = bf2f(rw.x & 0xffffu), r1 = bf2f(rw.x >> 16), r2 = bf2f(rw.y & 0xffffu), r3 = bf2f(rw.y >> 16);
            u32x2 w; w.x = pk2(acc[mt][nt][0] * rs * g[0] * silu_f(r0), acc[mt][nt][1] * rs * g[1] * silu_f(r1));
            w.y = pk2(acc[mt][nt][2] * rs * g[2] * silu_f(r2), acc[mt][nt][3] * rs * g[3] * silu_f(r3));
            *(u32x2*)(mix + (size_t)(t0 + t) * DM + HYW + h * 256 + v) = w; }
    }
    __syncthreads();
}
__device__ __forceinline__ void hynorm_tile(const Params& p, LAS unsigned char* lds, int tile, int tid) {
    const bf16_t* yT = (const bf16_t*)(p.ws + WS_ZT); bf16_t* mix = (bf16_t*)(p.ws + WS_MIX); const float* og = p.in[20];
    LAS float* yt = (LAS float*)lds; LAS float* red = yt + 128 * 65;
    const int g = tile & 7, t0 = (tile >> 3) * 64, c0 = g * 128;
    { const int t = tid & 63, cg8 = tid >> 6; float ss = 0.f;
#pragma unroll
      for (int i = 0; i < 16; ++i) { const int cc = cg8 * 16 + i; const float v = bf2f(yT[(size_t)(c0 + cc) * L + t0 + t]); yt[cc * 65 + t] = v; ss += v * v; }
      red[cg8 * 64 + t] = ss; }
    __syncthreads();
    { const int c2 = (tid & 63) * 2, tg = tid >> 6; const float g0 = og[c0 + c2], g1 = og[c0 + c2 + 1];
#pragma unroll
      for (int i = 0; i < 8; ++i) { const int t = tg * 8 + i; float ss = 0.f;
#pragma unroll
          for (int w = 0; w < 8; ++w) ss += red[w * 64 + t];
          const float rs = rsqrtf(ss * (1.0f / 128.0f) + 1e-6f);
          *(unsigned*)(mix + (size_t)(t0 + t) * DM + c0 + c2) = pk2(yt[c2 * 65 + t] * rs * g0, yt[(c2 + 1) * 65 + t] * rs * g1); } }
    __syncthreads();
}

#define XB_TMO      128
#define XB_XCNT(j)  (256  + 64 * (j))
#define XB_XSUB(j)  (1280 + 64 * (j))
#define XB_XGEN(j)  (2304 + 64 * (j))
#define XB_TOP      3328
#define XB_TOPGEN   3392
#define XCD_BAR_WORDS 3456
#define XB_SPIN_CAP (1u << 18)

__device__ __forceinline__ unsigned xb_ld(unsigned* p)              { return __hip_atomic_load(p, __ATOMIC_RELAXED, __HIP_MEMORY_SCOPE_AGENT); }
__device__ __forceinline__ unsigned xb_add(unsigned* p, unsigned v) { return __hip_atomic_fetch_add(p, v, __ATOMIC_RELAXED, __HIP_MEMORY_SCOPE_AGENT); }
__device__ __forceinline__ unsigned xb_xcc_id() { return (unsigned)__builtin_amdgcn_s_getreg((3 << 11) | 20) & 0xFu; }
#define XB_SPIN(cond, bar) do { unsigned _sp = 0; while (cond) { __builtin_amdgcn_s_sleep(1); \
    if ((++_sp & 255u) == 0u) { if (xb_ld(&(bar)[XB_TMO])) break; if (_sp > XB_SPIN_CAP) { atomicAdd(&(bar)[XB_TMO], 1u); break; } } } } while (0)

struct XcdBarrier {
    unsigned* bar; unsigned x;
    volatile LAS unsigned* st;
};

__device__ __forceinline__ XcdBarrier xcd_barrier_post(unsigned* bar, volatile LAS unsigned* st) {
    XcdBarrier b; b.bar = bar; b.x = xb_xcc_id(); b.st = st;
    if (threadIdx.x == 0) (void)xb_add(&bar[XB_XCNT(b.x)], 1u);
    return b;
}
__device__ __forceinline__ void xcd_barrier_complete(unsigned* bar, unsigned x, unsigned& nloc, unsigned& nx) {
    const unsigned G = gridDim.x * gridDim.y * gridDim.z;
    unsigned sum, cnt, mine, sp = 0u;
    for (;;) {
        sum = 0u; cnt = 0u; mine = 0u;
#pragma unroll
        for (unsigned j = 0; j < 16; ++j) { const unsigned c = xb_ld(&bar[XB_XCNT(j)]); sum += c; cnt += (c > 0u) ? 1u : 0u; mine = (j == x) ? c : mine; }
        if (sum == G) break;
        __builtin_amdgcn_s_sleep(1);
        if ((++sp & 255u) == 0u) { if (xb_ld(&bar[XB_TMO])) break; if (sp > XB_SPIN_CAP) { atomicAdd(&bar[XB_TMO], 1u); break; } }
    }
    nloc = mine > 0u ? mine : 1u; nx = cnt > 0u ? cnt : 1u;
}

__device__ __forceinline__ void xcd_barrier(const XcdBarrier& b) {
    asm volatile("s_waitcnt vmcnt(0)" ::: "memory");
    __syncthreads();
    if (threadIdx.x == 0) {
        unsigned* bar = b.bar;
        __builtin_amdgcn_s_waitcnt(0);
        unsigned nloc = b.st[0], nx = b.st[1]; const unsigned bx = b.st[2];
        if (nloc == 0u) { xcd_barrier_complete(bar, bx, nloc, nx); b.st[0] = nloc; b.st[1] = nx; }
        const unsigned old = xb_add(&bar[XB_XSUB(bx)], 1u);
        const unsigned gen = old / nloc;
        if (old + 1u == (gen + 1u) * nloc) {
            __builtin_amdgcn_fence(__ATOMIC_RELEASE, "agent");
            asm volatile("s_waitcnt vmcnt(0)" ::: "memory");
            const unsigned og = xb_add(&bar[XB_TOP], 1u);
            const unsigned tg = og / nx;
            if (og + 1u == (tg + 1u) * nx) xb_add(&bar[XB_TOPGEN], 1u);
            else XB_SPIN(xb_ld(&bar[XB_TOPGEN]) == tg, bar);
            __builtin_amdgcn_fence(__ATOMIC_ACQUIRE, "agent");
            xb_add(&bar[XB_XGEN(bx)], 1u);
            asm volatile("s_waitcnt vmcnt(0)" ::: "memory");
        } else {
            XB_SPIN(xb_ld(&bar[XB_XGEN(bx)]) == gen, bar);
            __builtin_amdgcn_fence(__ATOMIC_ACQUIRE, "agent");
            asm volatile("s_waitcnt vmcnt(0)" ::: "memory");
        }
    }
    __syncthreads();
}

#ifndef REP_P0
#define REP_P0 0
#endif
#ifndef PA_MASK
#define PA_MASK 3
#endif
#ifndef PC_MASK
#define PC_MASK 3
#endif
#ifndef REP_G1
#define REP_G1 0
#endif
#ifndef REP_G3
#define REP_G3 0
#endif
#ifndef P0_MASK
#define P0_MASK 15
#endif
#ifndef REP_PA
#define REP_PA 0
#endif
#ifndef REP_PAB
#define REP_PAB 0
#endif
#ifndef REP_PC
#define REP_PC 0
#endif
__global__ void __launch_bounds__(NT, 2) fwd_megakernel(Params p) {
    extern __shared__ __attribute__((aligned(16))) unsigned char smem[];
    LAS unsigned char* lds = (LAS unsigned char*)smem;
    cg::grid_group grid = cg::this_grid();
    const int G = gridDim.x;
    volatile LAS unsigned* bst = (volatile LAS unsigned*)(lds + LDS_BYTES - 64);
    if (threadIdx.x < 2) bst[threadIdx.x] = 0u;
    __syncthreads();
    XcdBarrier xbar = xcd_barrier_post((unsigned*)(p.ws + WS_BAR), bst);
    if (threadIdx.x == 0) bst[2] = xbar.x;
    if (p.ws == nullptr) grid.sync();
#define TIDS int tid = threadIdx.x; asm volatile("" : "+v"(tid)); const int lane = tid & 63, wave = __builtin_amdgcn_readfirstlane(tid >> 6); (void)lane; (void)wave;
    unsigned char* ws = p.ws;
    float* rowss = (float*)(ws + WS_ROWSS);
    bf16_t* XB = (bf16_t*)(ws + WS_XB); bf16_t* AB = (bf16_t*)(ws + WS_A);

#pragma unroll 1
    for (int rep = 0; rep <= REP_P0; ++rep) {
#ifndef SKIP_P0
        { TIDS; phase0(p, lds, tid, lane, wave, rep == 0 ? 15 : P0_MASK); }
#endif
        xcd_barrier(xbar); }
#ifndef NO_GEMM
#pragma unroll 1
    for (int rg = 0; rg <= REP_G1; ++rg) {
    { pg8::Gemm g{XB, (const bf16_t*)(ws + WS_WFF), L, 2 * FF, DM}; pg8::StaticOrder S; S.init(L, 2 * FF, G, (int)blockIdx.x);
      pg8::EpiSwiGLU E{AB, FF, rowss}; pg8::gemm_phase<pg8::EpiSwiGLU, pg8::StaticOrder, true, true>(lds, g, S, E); }
    { TIDS; const int rem = ((L / 256) * (2 * FF / 256)) % G, nl = rem ? G - rem : G, li = rem ? (int)blockIdx.x - rem : (int)blockIdx.x;
      if (li >= 0) convert_tail1(p, lds, li * 8 + wave, nl * 8, lane, wave); }
    xcd_barrier(xbar);
    }
    { pg8::Gemm g{AB, (const bf16_t*)(ws + WS_WDN), L, DM, FF}; pg8::StaticOrder S; S.init(L, DM, G, (int)blockIdx.x);
      pg8::EpiResid E{p.in[0], nullptr, XB, rowss + L, 0.5f}; pg8::gemm_phase<pg8::EpiResid, pg8::StaticOrder, true, true>(lds, g, S, E); }
    xcd_barrier(xbar);
#pragma unroll 1
    for (int rg = 0; rg <= REP_G3; ++rg) {
    { pg8::Gemm g{XB, (const bf16_t*)(ws + WS_WIN), L, NING, DM}; pg8::StaticOrder S; S.init(L, NING, G, (int)blockIdx.x);
      pg8::EpiP E{(bf16_t*)(ws + WS_PHY), (bf16_t*)(ws + WS_PR), rowss + L}; pg8::gemm_phase<pg8::EpiP, pg8::StaticOrder, true, true>(lds, g, S, E); }
    { TIDS; for (int it = blockIdx.x; it < L / 32; it += G) lr_task(p, lds, it, tid, lane, wave); }
    xcd_barrier(xbar);
    }
#endif
#pragma unroll 1
    for (int rep = 0; rep <= REP_PAB; ++rep) {
#pragma unroll 1
        for (int r2 = 0; r2 <= REP_PA; ++r2) {
#ifndef SKIP_PA
            { pg8::Gemm g{(const bf16_t*)(ws + WS_W4T), (const bf16_t*)(ws + WS_HID), 2048, L, 256}; pg8::StaticOrder S; S.init(2048, L, G, (int)blockIdx.x);
              pg8::EpiFilt E{(bf16_t*)p.out, (bf16_t*)p.out + (size_t)HYW * L, (bf16_t*)p.out + (size_t)(HYW + 768) * L}; pg8::gemm_phase<pg8::EpiFilt, pg8::StaticOrder, true, true>(lds, g, S, E); }
            if (r2 == 0 || (PA_MASK & 1)) { TIDS; for (int it = blockIdx.x; it < 512; it += G) gla_kv_item(p, lds, it, tid, lane, wave); }
            if (r2 == 0 || (PA_MASK & 2)) { TIDS; const bf16_t* phy = (const bf16_t*)(ws + WS_PHY); u32x4 rw[4], rn[4];
              if ((int)blockIdx.x < 2048) convT_fetch(phy, blockIdx.x, tid, rw);
#pragma unroll 1
              for (int it = blockIdx.x; it < 2048; it += G) { const bool more = it + G < 2048; if (more) convT_fetch(phy, it + G, tid, rn);
                  convT_tile(p, lds, it, tid, rw);
                  if (more) {
#pragma unroll
                      for (int k = 0; k < 4; ++k) rw[k] = rn[k]; } } }
#endif
            xcd_barrier(xbar);
        }
#ifndef SKIP_PB
        { TIDS; gla_scan(p, tid); }
        { TIDS; for (int it = blockIdx.x; it < HYW / 2; it += G) hyena_fft_pair(p, lds, it, tid, lane, wave); }
#endif
        xcd_barrier(xbar);
    }
#pragma unroll 1
    for (int rep = 0; rep <= REP_PC; ++rep) {
#ifndef SKIP_PC
        if (rep == 0 || (PC_MASK & 1)) { TIDS; for (int it = blockIdx.x; it < 512; it += G) gla_out_item(p, lds, it, tid, lane, wave); }
        if (rep == 0 || (PC_MASK & 2)) { TIDS; for (int it = blockIdx.x; it < 1024; it += G) hynorm_tile(p, lds, it, tid); }
#endif
        xcd_barrier(xbar);
    }
#ifndef NO_GEMM
    { pg8::Gemm g{(const bf16_t*)(ws + WS_MIX), (const bf16_t*)(ws + WS_WOUT), L, DM, DM}; pg8::StaticOrder S; S.init(L, DM, G, (int)blockIdx.x);
      pg8::EpiResid E{nullptr, XB, XB, rowss + 2 * L, 1.0f}; pg8::gemm_phase<pg8::EpiResid, pg8::StaticOrder, true, true>(lds, g, S, E); }
    __syncthreads();
    { TIDS; convert_gu(p.in[28], p.in[29], p.in[27], ws, lds, blockIdx.x * 8 + wave, G * 8, lane, wave); }
    xcd_barrier(xbar);
    { pg8::Gemm g{XB, (const bf16_t*)(ws + WS_WFF), L, 2 * FF, DM}; pg8::StaticOrder S; S.init(L, 2 * FF, G, (int)blockIdx.x);
      pg8::EpiSwiGLU E{AB, FF, rowss + 2 * L}; pg8::gemm_phase<pg8::EpiSwiGLU, pg8::StaticOrder, true, true>(lds, g, S, E); }
    { TIDS; const int rem = ((L / 256) * (2 * FF / 256)) % G, nl = rem ? G - rem : G, li = rem ? (int)blockIdx.x - rem : (int)blockIdx.x;
      if (li >= 0) convert_dn(p.in[30], ws, lds, li * 8 + wave, nl * 8, lane, wave); }
    xcd_barrier(xbar);
    { pg8::Gemm g{AB, (const bf16_t*)(ws + WS_WDN), L, DM, FF}; pg8::StaticOrder S; S.init(L, DM, G, (int)blockIdx.x);
      pg8::EpiFinal E{XB, p.out, rowss + 3 * L, (unsigned*)(ws + WS_PCNT), p.in[31], 0.5f}; pg8::gemm_phase<pg8::EpiFinal, pg8::StaticOrder, true, true>(lds, g, S, E); }
#endif
}

extern "C" void kernel_launch(void* const* d_in, const int* in_sizes, int n_in, void* d_out, int out_size, void* d_ws, size_t ws_size, hipStream_t stream) {
    static int grid = 0;
    if (grid == 0) {
        if (n_in != 32 || out_size != L * DM || ws_size < WS_END) { fprintf(stderr, "kernel_launch: unexpected problem: n_in %d out %d ws %zu (need %zu)\n", n_in, out_size, ws_size, (size_t)WS_END); grid = -1; return; }
        int dev = 0, cus = 0, per_cu = 0;
        (void)hipGetDevice(&dev); (void)hipDeviceGetAttribute(&cus, hipDeviceAttributeMultiprocessorCount, dev);
        if (hipFuncSetAttribute((const void*)fwd_megakernel, hipFuncAttributeMaxDynamicSharedMemorySize, LDS_BYTES) != hipSuccess) { fprintf(stderr, "kernel_launch: hipFuncSetAttribute failed\n"); grid = -1; return; }
        if (hipOccupancyMaxActiveBlocksPerMultiprocessor(&per_cu, (const void*)fwd_megakernel, NT, LDS_BYTES) != hipSuccess || per_cu < 1) { fprintf(stderr, "kernel_launch: occupancy query gave %d\n", per_cu); per_cu = 1; }
        (void)hipGetLastError();
        grid = cus * per_cu; if (grid > 256) grid = 256;
        if (grid != 256) { fprintf(stderr, "kernel_launch: this kernel needs a 256-workgroup cooperative grid (256 CUs x 1), got %d; nothing launched\n", grid); grid = -1; return; }
        fprintf(stderr, "kernel_launch: cus %d per_cu %d grid %d\n", cus, per_cu, grid);
    }
    if (grid < 0) return;
    Params p{};
    for (int i = 0; i < 32; ++i) p.in[i] = (const float*)d_in[i];
    p.out = (float*)d_out; p.ws = (unsigned char*)d_ws;
    if (hipMemsetAsync((char*)d_ws + WS_BAR, 0, 16384 + 32 * 256, stream) != hipSuccess) { fprintf(stderr, "kernel_launch: hipMemsetAsync failed\n"); return; }
    void* args[] = {&p};
    hipError_t e = hipLaunchCooperativeKernel((const void*)fwd_megakernel, dim3(grid), dim3(NT), args, LDS_BYTES, stream);
    if (e != hipSuccess) fprintf(stderr, "kernel_launch: cooperative launch failed: %s (grid %d)\n", hipGetErrorString(e), grid);
}
```

```cpp
#include <hip/hip_runtime.h>
#include <hip/hip_cooperative_groups.h>
#include <cstdio>
#include <cstdint>
namespace cg = cooperative_groups;

namespace pg8 {
#define PG8_LAS __attribute__((address_space(3)))
typedef unsigned short bf16_t;
typedef short bf16x8 __attribute__((ext_vector_type(8)));
typedef float f32x4 __attribute__((ext_vector_type(4)));
typedef unsigned u32x4 __attribute__((ext_vector_type(4)));
constexpr int BM = 256, BK = 64, HALF = 128, HTB = HALF * BK * 2  , STAGE_BYTES = 8 * HTB, NXCD = 8, WGM = 8;

__host__ __device__ __forceinline__ int lds_byte(int r, int c) { const int st = (r >> 4) * 2 + (c >> 5), rr = r & 15, cc = c & 31, ob = rr * 64 + cc * 2; return st * 1024 + (ob ^ (((ob >> 9) & 1) << 5)); }
__host__ __device__ __forceinline__ void stage_rc(int b, int& R, int& C) { const int st = b / 1024, sb = b % 1024, swz = sb ^ (((sb >> 9) & 1) << 5); R = (st >> 1) * 16 + swz / 64; C = (st & 1) * 32 + (swz % 64) / 2; }
__host__ __device__ __forceinline__ int perm32(int rho) { const int n = rho >> 4, i = rho & 15; return 8 * (i >> 2) + 4 * n + (i & 3); }

struct Unit { int pm, pn; };
struct Gemm { const bf16_t* A; const bf16_t* Bt; int M, N, K; };

struct StaticOrder {
    int nM, nN, nwg, G, c;
    __host__ __device__ void init(int M, int N, int G_, int c_) { nM = M / BM; nN = N / BM; nwg = nM * nN; G = G_; c = c_; }
    __host__ __device__ bool next(int i, Unit& u) const {
        const long L = (long)i * G + c; if (L >= nwg) return false;
        int wgid = (int)L; { const int q = nwg / NXCD, r = nwg % NXCD, xcd = wgid % NXCD, off = wgid / NXCD; wgid = (xcd < r ? xcd * (q + 1) : r * (q + 1) + (xcd - r) * q) + off; }
        const int nig = WGM * nN, gid = wgid / nig, fm = gid * WGM, gsz = (nM - fm) < WGM ? (nM - fm) : WGM;
        u.pm = fm + ((wgid % nig) % gsz); u.pn = (wgid % nig) / gsz; return true;
    }
    __device__ __forceinline__ void a_ready(const Unit&) const {}
    __device__ __forceinline__ void done(const Unit&) const {}
};
__device__ __forceinline__ unsigned cvt_pk_bf16(float lo, float hi) { unsigned r; asm volatile("v_cvt_pk_bf16_f32 %0, %1, %2" : "=v"(r) : "v"(lo), "v"(hi)); return r; }
typedef unsigned u32x4 __attribute__((ext_vector_type(4)));
typedef unsigned u32x2 __attribute__((ext_vector_type(2)));
__device__ __forceinline__ float rstd_of(float ss) { return rsqrtf(ss * (1.0f / 2048.0f) + 1e-6f); }
__device__ __forceinline__ float silu_f(float x) { return x * __builtin_amdgcn_rcpf(1.0f + __expf(-x)); }

struct EpiSwiGLU {
    static constexpr bool PERM = true, AFTER_DRAIN = false;
    bf16_t* O; int ldc; const float* rowss;
    __device__ __forceinline__ void operator()(const f32x4 (&acc)[2][2][4][2], const Unit& u, int wr, int wc, int fr, int fq) const {
        const int row0 = u.pm * BM + wr * 64 + fr, col0 = u.pn * 128 + wc * 32 + 8 * fq;
#pragma unroll
        for (int ai = 0; ai < 2; ++ai)
#pragma unroll
            for (int m = 0; m < 4; ++m) {
                const int row = row0 + ai * HALF + m * 16; const float rs = rstd_of(rowss[row]);
                float v[8];
#pragma unroll
                for (int n = 0; n < 2; ++n)
#pragma unroll
                    for (int j = 0; j < 4; ++j) v[n * 4 + j] = silu_f(acc[ai][0][m][n][j] * rs) * (acc[ai][1][m][n][j] * rs);
                u32x4 w; w.x = cvt_pk_bf16(v[0], v[1]); w.y = cvt_pk_bf16(v[2], v[3]); w.z = cvt_pk_bf16(v[4], v[5]); w.w = cvt_pk_bf16(v[6], v[7]);
                *(u32x4*)(O + (size_t)row * ldc + col0) = w;
            }
    }
};
struct EpiResid {
    static constexpr bool PERM = false, AFTER_DRAIN = false;
    const float* base; const bf16_t* base16; bf16_t* ob; float* rowss; float scale;
    __device__ __forceinline__ void operator()(const f32x4 (&acc)[2][2][4][2], const Unit& u, int wr, int wc, int fr, int fq) const {
        const int row0 = u.pm * BM + wr * 64 + fr, col0 = u.pn * BM + wc * 32 + 4 * fq;
#pragma unroll
        for (int ai = 0; ai < 2; ++ai)
#pragma unroll
            for (int m = 0; m < 4; ++m) {
                const int row = row0 + ai * HALF + m * 16; float ss = 0.f;
#pragma unroll
                for (int bj = 0; bj < 2; ++bj)
#pragma unroll
                    for (int n = 0; n < 2; ++n) {
                        const size_t off = (size_t)row * 2048 + col0 + bj * HALF + n * 16;
                        f32x4 b;
                        if (base) b = *(const f32x4*)(base + off);
                        else { const u32x2 r = *(const u32x2*)(base16 + off); b = (f32x4){__builtin_bit_cast(float, r.x << 16), __builtin_bit_cast(float, r.x & 0xffff0000u), __builtin_bit_cast(float, r.y << 16), __builtin_bit_cast(float, r.y & 0xffff0000u)}; }
                        const f32x4 v = b + acc[ai][bj][m][n] * scale;
                        { u32x2 w; w.x = cvt_pk_bf16(v[0], v[1]); w.y = cvt_pk_bf16(v[2], v[3]); *(u32x2*)(ob + off) = w; }
                        ss += (v[0] * v[0] + v[1] * v[1]) + (v[2] * v[2] + v[3] * v[3]);
                    }
                ss += __shfl_xor(ss, 16); ss += __shfl_xor(ss, 32);
                if (rowss && fq == 0) atomicAdd(rowss + row, ss);
            }
    }
};
struct EpiP {
    static constexpr bool PERM = true, AFTER_DRAIN = false;
    bf16_t* phy; bf16_t* pr; const float* rowss;
    __device__ __forceinline__ void operator()(const f32x4 (&acc)[2][2][4][2], const Unit& u, int wr, int wc, int fr, int fq) const {
        const int row0 = u.pm * BM + wr * 64 + fr;
        bf16_t* O; int ldc, colt;
        if (u.pn < 12) { O = phy; ldc = 3072; colt = u.pn * BM; } else { O = pr; ldc = 3072; colt = (u.pn - 12) * BM; }
        const int col0 = colt + wc * 32 + 8 * fq;
#pragma unroll
        for (int ai = 0; ai < 2; ++ai)
#pragma unroll
            for (int m = 0; m < 4; ++m) {
                const int row = row0 + ai * HALF + m * 16; const float rs = rstd_of(rowss[row]);
#pragma unroll
                for (int bj = 0; bj < 2; ++bj) {
                    const f32x4 v0 = acc[ai][bj][m][0] * rs, v1 = acc[ai][bj][m][1] * rs;
                    u32x4 w; w.x = cvt_pk_bf16(v0[0], v0[1]); w.y = cvt_pk_bf16(v0[2], v0[3]); w.z = cvt_pk_bf16(v1[0], v1[1]); w.w = cvt_pk_bf16(v1[2], v1[3]);
                    *(u32x4*)(O + (size_t)row * ldc + col0 + bj * HALF) = w;
                }
            }
    }
};

struct EpiFilt {
    static constexpr bool PERM = false, AFTER_DRAIN = false;
    bf16_t* Ff; bf16_t* Fb0; bf16_t* Fb1;
    __device__ __forceinline__ void operator()(const f32x4 (&acc)[2][2][4][2], const Unit& u, int wr, int wc, int fr, int fq) const {
        const int row0 = u.pm * BM + wr * 64 + fr, col0 = u.pn * BM + wc * 32 + 4 * fq;
        const float dmin = -3.0701134573253945f, dmax = -15.350567286626973f;
#pragma unroll
        for (int ai = 0; ai < 2; ++ai)
#pragma unroll
            for (int m = 0; m < 4; ++m) {
                const int cc = row0 + ai * HALF + m * 16, c = cc & 1023;
                const float del = __builtin_fabsf(dmin + (float)c * ((dmax - dmin) / 1023.0f)) * (1.0f / 8191.0f);
                bf16_t* dst = cc < 1024 ? Ff + (size_t)c * 8192 : (c < 768 ? Fb0 + (size_t)c * 8192 : Fb1 + (size_t)(c - 768) * 8192);
#pragma unroll
                for (int bj = 0; bj < 2; ++bj)
#pragma unroll
                    for (int n = 0; n < 2; ++n) {
                        const int i = col0 + bj * HALF + n * 16; f32x4 v = acc[ai][bj][m][n];
#pragma unroll
                        for (int j = 0; j < 4; ++j) v[j] *= __expf(-(float)(i + j) * del);
                        { u32x2 w; w.x = cvt_pk_bf16(v[0], v[1]); w.y = cvt_pk_bf16(v[2], v[3]); *(u32x2*)(dst + i) = w; }
                    }
            }
    }
};

struct EpiFinal {
    static constexpr bool PERM = false, AFTER_DRAIN = false;
    const bf16_t* base16; float* out; float* rowss; unsigned* cnt; const float* g; float scale;
    __device__ __forceinline__ void operator()(f32x4 (&acc)[2][2][4][2], const Unit& u, int wr, int wc, int fr, int fq) const {
        const int row0 = u.pm * BM + wr * 64 + fr, col0 = u.pn * BM + wc * 32 + 4 * fq;
#pragma unroll
        for (int ai = 0; ai < 2; ++ai)
#pragma unroll
            for (int m = 0; m < 4; ++m) {
                const int row = row0 + ai * HALF + m * 16; float ss = 0.f;
#pragma unroll
                for (int bj = 0; bj < 2; ++bj)
#pragma unroll
                    for (int n = 0; n < 2; ++n) {
                        const size_t off = (size_t)row * 2048 + col0 + bj * HALF + n * 16;
                        const u32x2 r = *(const u32x2*)(base16 + off);
                        const f32x4 v = (f32x4){__builtin_bit_cast(float, r.x << 16), __builtin_bit_cast(float, r.x & 0xffff0000u), __builtin_bit_cast(float, r.y << 16), __builtin_bit_cast(float, r.y & 0xffff0000u)} + acc[ai][bj][m][n] * scale;
                        acc[ai][bj][m][n] = v; ss += (v[0] * v[0] + v[1] * v[1]) + (v[2] * v[2] + v[3] * v[3]);
                    }
                ss += __shfl_xor(ss, 16); ss += __shfl_xor(ss, 32);
                if (fq == 0) atomicAdd(rowss + row, ss);
            }
        asm volatile("s_waitcnt vmcnt(0)" ::: "memory");
        __syncthreads();
        if (threadIdx.x == 0) {
            unsigned* c = cnt + 64 * u.pm;
            __builtin_amdgcn_fence(__ATOMIC_RELEASE, "agent"); asm volatile("s_waitcnt vmcnt(0)" ::: "memory");
            __hip_atomic_fetch_add(c, 1u, __ATOMIC_RELAXED, __HIP_MEMORY_SCOPE_AGENT);
            unsigned spins = 0;
            while (__hip_atomic_load(c, __ATOMIC_RELAXED, __HIP_MEMORY_SCOPE_AGENT) < 8u) { __builtin_amdgcn_s_sleep(2); if (++spins > (1u << 22)) break; }
            __builtin_amdgcn_fence(__ATOMIC_ACQUIRE, "agent"); asm volatile("s_waitcnt vmcnt(0)" ::: "memory");
        }
        __syncthreads();
#pragma unroll
        for (int ai = 0; ai < 2; ++ai)
#pragma unroll
            for (int m = 0; m < 4; ++m) {
                const int row = row0 + ai * HALF + m * 16; const float rs = rstd_of(__hip_atomic_load(rowss + row, __ATOMIC_RELAXED, __HIP_MEMORY_SCOPE_AGENT));
#pragma unroll
                for (int bj = 0; bj < 2; ++bj)
#pragma unroll
                    for (int n = 0; n < 2; ++n) {
                        const int col = col0 + bj * HALF + n * 16; const f32x4 gg = *(const f32x4*)(g + col);
                        *(f32x4*)(out + (size_t)row * 2048 + col) = acc[ai][bj][m][n] * rs * gg;
                    }
            }
    }
};
template <class Epi, class Sched, bool ALIGN_EPI = false, bool SP2 = false>
__device__ __forceinline__ void gemm_phase(PG8_LAS unsigned char* lds, const Gemm g, const Sched& S, const Epi& E) {
    int tid_ = threadIdx.x; asm volatile("" : "+v"(tid_));
    const int tid = tid_, wid = __builtin_amdgcn_readfirstlane(tid >> 6), lane = tid & 63, wr = wid >> 2, wc = wid & 3, fr = lane & 15, fq = lane >> 4;
    const int K = g.K, nt = K / BK;
    unsigned voffA[2], voffB[2];
#pragma unroll
    for (int i = 0; i < 2; ++i) { int R, C; stage_rc(tid * 16 + i * 8192, R, C); const int Rb = Epi::PERM ? ((R & ~31) + perm32(R & 31)) : R;
        voffA[i] = (unsigned)(R * K + C) * 2u; voffB[i] = (unsigned)(Rb * K + C) * 2u; }
    const size_t kstep = (size_t)(BK * 2);
    const size_t hstep = (size_t)HALF * K * 2;
    const size_t tstep = 2 * hstep;
    const unsigned ldsw = (unsigned)wid * 1024u;
    const int aoff = lds_byte(wr * 64 + fr, fq * 8), boff = lds_byte(wc * 32 + fr, fq * 8);
#define PG8_SA(b, h) (((b) * 2 + (h)) * HTB)
#define PG8_SB(b, h) ((4 + (b) * 2 + (h)) * HTB)
#define PG8_STAGE(bufoff, gbase, voff) do { _Pragma("unroll") for (int _i = 0; _i < 2; ++_i) \
        __builtin_amdgcn_global_load_lds((const unsigned*)((const char*)(gbase) + (voff)[_i]), (PG8_LAS unsigned*)(lds + (bufoff) + ldsw + _i * 8192), 16, 0, 0); } while (0)
#define PG8_LDA(dst, b, h) do { _Pragma("unroll") for (int m = 0; m < 4; ++m) _Pragma("unroll") for (int k = 0; k < 2; ++k) dst[m][k] = *(const PG8_LAS bf16x8*)(lds + PG8_SA(b, h) + aoff + m * 2048 + k * 1024); } while (0)
#define PG8_LDB(dst, b, h) do { _Pragma("unroll") for (int n = 0; n < 2; ++n) _Pragma("unroll") for (int k = 0; k < 2; ++k) dst[n][k] = *(const PG8_LAS bf16x8*)(lds + PG8_SB(b, h) + boff + n * 2048 + k * 1024); } while (0)
#define PG8_MMA(ai, bj, At, Bt) do { __builtin_amdgcn_s_setprio(1); _Pragma("unroll") for (int m = 0; m < 4; ++m) _Pragma("unroll") for (int n = 0; n < 2; ++n) _Pragma("unroll") for (int k = 0; k < 2; ++k) \
        acc[ai][bj][m][n] = __builtin_amdgcn_mfma_f32_16x16x32_bf16(Bt[n][k], At[m][k], acc[ai][bj][m][n], 0, 0, 0); __builtin_amdgcn_s_setprio(0); } while (0)
#define PG8_WAIT_V(n) asm volatile("s_waitcnt vmcnt(" #n ")" ::: "memory")
#define PG8_WAIT_L(n) asm volatile("s_waitcnt lgkmcnt(" #n ")" ::: "memory")
#define PG8_BAR __builtin_amdgcn_s_barrier()
#define PG8_SCHED __builtin_amdgcn_sched_barrier(0)
    Unit cur, nxt; int ui = 0;
    if (!S.next(0, cur)) return;
    f32x4 acc[2][2][4][2];
#pragma unroll
    for (int a = 0; a < 2; ++a)
#pragma unroll
        for (int b = 0; b < 2; ++b)
#pragma unroll
            for (int m = 0; m < 4; ++m)
#pragma unroll
                for (int n = 0; n < 2; ++n) acc[a][b][m][n] = (f32x4){0.f, 0.f, 0.f, 0.f};
    bf16x8 At[4][2], B0[2][2], B1[2][2];
    const char* cA = (const char*)g.A + (size_t)cur.pm * tstep; const char* cB = (const char*)g.Bt + (size_t)cur.pn * tstep;
    S.a_ready(cur);
    if constexpr (SP2) {
        PG8_STAGE(PG8_SB(0, 0), cB, voffB); PG8_STAGE(PG8_SB(0, 1), cB + hstep, voffB); PG8_STAGE(PG8_SA(0, 0), cA, voffA); PG8_STAGE(PG8_SA(0, 1), cA + hstep, voffA);
        if (wr == 1) PG8_BAR;
        PG8_WAIT_V(2); PG8_BAR;
        PG8_STAGE(PG8_SB(1, 0), cB + kstep, voffB); PG8_STAGE(PG8_SA(1, 0), cA + kstep, voffA); PG8_STAGE(PG8_SB(1, 1), cB + hstep + kstep, voffB);
        PG8_WAIT_V(6); PG8_BAR;
    } else {
        PG8_STAGE(PG8_SB(0, 0), cB, voffB); PG8_STAGE(PG8_SA(0, 0), cA, voffA); PG8_STAGE(PG8_SB(0, 1), cB + hstep, voffB); PG8_STAGE(PG8_SA(0, 1), cA + hstep, voffA);
        if (wr == 1) PG8_BAR;
        PG8_WAIT_V(4); PG8_BAR;
        PG8_STAGE(PG8_SB(1, 0), cB + kstep, voffB); PG8_STAGE(PG8_SA(1, 0), cA + kstep, voffA); PG8_STAGE(PG8_SB(1, 1), cB + hstep + kstep, voffB);
        PG8_WAIT_V(6); PG8_BAR;
    }
    for (;;) {
        const bool has_next = S.next(ui + 1, nxt);
        const char* nA = has_next ? (const char*)g.A + (size_t)nxt.pm * tstep : cA; const char* nB = has_next ? (const char*)g.Bt + (size_t)nxt.pn * tstep : cB;
        for (int t = 0; t < nt; t += 2) {
            const bool last = (t == nt - 2);
            const char* a1 = cA + (size_t)(t + 1) * kstep;
            const char* a2 = last ? nA : cA + (size_t)(t + 2) * kstep; const char* b2 = last ? nB : cB + (size_t)(t + 2) * kstep;
            const char* a3 = a2 + kstep; const char* b3 = b2 + kstep;
            if (last && has_next) S.a_ready(nxt);
            if constexpr (SP2) {
            PG8_LDB(B0, 0, 0); PG8_LDB(B1, 0, 1); PG8_SCHED; PG8_LDA(At, 0, 0); PG8_STAGE(PG8_SA(1, 1), a1 + hstep, voffA);
            PG8_WAIT_V(8); PG8_WAIT_L(0); PG8_BAR; PG8_MMA(0, 0, At, B0); PG8_MMA(0, 1, At, B1); PG8_BAR; PG8_SCHED;
            PG8_LDA(At, 0, 1); PG8_STAGE(PG8_SB(0, 0), b2, voffB); PG8_STAGE(PG8_SB(0, 1), b2 + hstep, voffB); PG8_STAGE(PG8_SA(0, 0), a2, voffA);
            PG8_WAIT_V(8); PG8_WAIT_L(0); PG8_BAR; PG8_MMA(1, 0, At, B0); PG8_MMA(1, 1, At, B1); PG8_BAR; PG8_SCHED;
            PG8_LDB(B0, 1, 0); PG8_LDB(B1, 1, 1); PG8_SCHED; PG8_LDA(At, 1, 0); PG8_STAGE(PG8_SA(0, 1), a2 + hstep, voffA);
            PG8_WAIT_V(8); PG8_WAIT_L(0); PG8_BAR; PG8_MMA(0, 0, At, B0); PG8_MMA(0, 1, At, B1); PG8_BAR; PG8_SCHED;
            PG8_LDA(At, 1, 1); PG8_STAGE(PG8_SB(1, 0), b3, voffB); PG8_STAGE(PG8_SB(1, 1), b3 + hstep, voffB); PG8_STAGE(PG8_SA(1, 0), a3, voffA);
            PG8_WAIT_V(8); PG8_WAIT_L(0); PG8_BAR; PG8_MMA(1, 0, At, B0); PG8_MMA(1, 1, At, B1); PG8_BAR; PG8_SCHED;
            } else {
            PG8_LDB(B0, 0, 0); PG8_SCHED; PG8_LDA(At, 0, 0); PG8_STAGE(PG8_SA(1, 1), a1 + hstep, voffA);
            PG8_WAIT_L(8); PG8_BAR; PG8_WAIT_L(0); PG8_MMA(0, 0, At, B0); PG8_BAR; PG8_SCHED;
            PG8_LDB(B1, 0, 1); PG8_STAGE(PG8_SB(0, 0), b2, voffB);
            PG8_BAR; PG8_WAIT_L(0); PG8_MMA(0, 1, At, B1); PG8_BAR;
            PG8_LDA(At, 0, 1); PG8_STAGE(PG8_SA(0, 0), a2, voffA);
            PG8_BAR; PG8_WAIT_L(0); PG8_MMA(1, 0, At, B0); PG8_BAR; PG8_SCHED;
            PG8_STAGE(PG8_SB(0, 1), b2 + hstep, voffB);
            PG8_WAIT_V(6); PG8_BAR; PG8_MMA(1, 1, At, B1); PG8_BAR;
            PG8_LDB(B0, 1, 0); PG8_SCHED; PG8_LDA(At, 1, 0); PG8_STAGE(PG8_SA(0, 1), a2 + hstep, voffA);
            PG8_WAIT_L(8); PG8_BAR; PG8_WAIT_L(0); PG8_MMA(0, 0, At, B0); PG8_BAR; PG8_SCHED;
            PG8_LDB(B1, 1, 1); PG8_STAGE(PG8_SB(1, 0), b3, voffB);
            PG8_BAR; PG8_WAIT_L(0); PG8_MMA(0, 1, At, B1); PG8_BAR;
            PG8_LDA(At, 1, 1); PG8_STAGE(PG8_SA(1, 0), a3, voffA);
            PG8_BAR; PG8_WAIT_L(0); PG8_MMA(1, 0, At, B0); PG8_BAR; PG8_SCHED;
            PG8_STAGE(PG8_SB(1, 1), b3 + hstep, voffB);
            PG8_WAIT_V(6); PG8_BAR; PG8_MMA(1, 1, At, B1); PG8_BAR;
            }
        }
        if constexpr (ALIGN_EPI) { if (wr == 0) PG8_BAR; }
        if constexpr (!Epi::AFTER_DRAIN) { E(acc, cur, wr, wc, fr, fq); S.done(cur); }
        if (!has_next) break;
#pragma unroll
        for (int a = 0; a < 2; ++a)
#pragma unroll
            for (int b = 0; b < 2; ++b)
#pragma unroll
                for (int m = 0; m < 4; ++m)
#pragma unroll
                    for (int n = 0; n < 2; ++n) acc[a][b][m][n] = (f32x4){0.f, 0.f, 0.f, 0.f};
        cur = nxt; cA = nA; cB = nB; ++ui;
        if constexpr (ALIGN_EPI) { if (wr == 1) PG8_BAR; }
    }
    PG8_WAIT_V(0);
    if constexpr (!ALIGN_EPI) { if (wr == 0) PG8_BAR; }
    PG8_BAR;
    if constexpr (Epi::AFTER_DRAIN) { E.fused(acc, cur, wr, wc, fr, fq, lds, wid, lane); S.done(cur); }
#undef PG8_SA
#undef PG8_SB
#undef PG8_STAGE
#undef PG8_LDA
#undef PG8_LDB
#undef PG8_MMA
#undef PG8_WAIT_V
#undef PG8_WAIT_L
#undef PG8_BAR
#undef PG8_SCHED
}
}
using pg8::silu_f;

constexpr int L = 8192, DM = 2048, FF = 5632, NIN = 6176, NING = 6144, HYW = 1024;
constexpr int PHY_LD = 3072, PR_LD = 3072;
constexpr int PR_Q = 0, PR_K = 512, PR_V = 1024, PR_R = 2048;
constexpr int NT = 512;
constexpr int LDS_BYTES = 147456;
constexpr int FN = 16384;

constexpr size_t MiB = 1u << 20;
constexpr size_t WS_ROWSS = 0;
constexpr size_t WS_DEC = 128 * 1024;
constexpr size_t WS_PCNT = 640 * 1024 + 16384;
constexpr size_t WS_BAR = 640 * 1024;
constexpr size_t WS_W4T = 1 * MiB;
constexpr size_t WS_HID = 2 * MiB;
constexpr size_t WS_SK = 6 * MiB;
constexpr size_t SK_STRIDE = 8448;
constexpr size_t WS_WFF = 39 * MiB;
constexpr size_t WS_WDN = WS_WFF + 44 * MiB;
constexpr size_t WS_ST = WS_WFF;
constexpr size_t WS_WIN = 105 * MiB;
constexpr size_t WS_WOUT = 130 * MiB;
constexpr size_t WS_XB = 138 * MiB;
constexpr size_t WS_A = 170 * MiB;
constexpr size_t WS_ZT = WS_A;
constexpr size_t WS_X0T = WS_A + 32 * MiB;
constexpr size_t WS_PHY = 258 * MiB;
constexpr size_t WS_MIX = WS_PHY;
constexpr size_t WS_PR = 306 * MiB;
constexpr size_t WS_LR = WS_PR + 48 * MiB;
constexpr size_t WS_END = 358 * MiB;

typedef unsigned short bf16_t;
typedef short bf16x8 __attribute__((ext_vector_type(8)));
typedef float f32x4 __attribute__((ext_vector_type(4)));
typedef unsigned u32x4 __attribute__((ext_vector_type(4)));
typedef unsigned u32x2 __attribute__((ext_vector_type(2)));
#define LAS __attribute__((address_space(3)))
typedef float c2 __attribute__((ext_vector_type(2)));
__device__ __forceinline__ c2 mk2(float a, float b) { return (c2){a, b}; }
#define LDS_WAIT() asm volatile("s_waitcnt lgkmcnt(0)" ::: "memory")

__device__ __forceinline__ unsigned f2bf(float f) { unsigned u = __builtin_bit_cast(unsigned, f); return (u + 0x7fffu + ((u >> 16) & 1u)) >> 16; }
__device__ __forceinline__ unsigned pk2(float lo, float hi) { return f2bf(lo) | (f2bf(hi) << 16); }
__device__ __forceinline__ float bf2f(unsigned h) { return __builtin_bit_cast(float, h << 16); }
__device__ __forceinline__ float wave_sum(float v) {
#pragma unroll
    for (int o = 1; o < 64; o <<= 1) v += __shfl_xor(v, o);
    return v;
}

struct Params {
    const float* in[32];
    float* out;
    unsigned char* ws;
};

__device__ __forceinline__ void transpose_item(const float* __restrict__ W, int K, int N, bf16_t* __restrict__ WT, int mode, const float* __restrict__ gain, LAS float* scr, int item, int lane) {
    const int nblk = N / 32, kb = item / nblk, nb = item % nblk, k0 = 64 * kb, n0 = 32 * nb;
    const int drow0 = mode == 0 ? n0 : (256 * (n0 >> 7) + (n0 & 127) + (mode == 2 ? 128 : 0));
    const int c = lane & 7;
    f32x4 g0 = (f32x4){1.f, 1.f, 1.f, 1.f}, g1 = g0;
    if (gain) { g0 = *(const f32x4*)(gain + k0 + 8 * c); g1 = *(const f32x4*)(gain + k0 + 8 * c + 4); }
    float v[32];
    const float* wp = W + (size_t)(k0 + (lane >> 5)) * N + n0 + (lane & 31);
#pragma unroll
    for (int i = 0; i < 32; ++i) v[i] = __builtin_nontemporal_load(wp + (size_t)(2 * i) * N);
#pragma unroll
    for (int i = 0; i < 32; ++i) scr[(2 * i + (lane >> 5)) * 33 + (lane & 31)] = v[i];
    LDS_WAIT(); asm volatile("" ::: "memory");
#pragma unroll
    for (int j = 0; j < 4; ++j) { const int n = (lane >> 3) + 8 * j; const LAS float* s = scr + (8 * c) * 33 + n;
        u32x4 o; o.x = pk2(s[0 * 33] * g0[0], s[1 * 33] * g0[1]); o.y = pk2(s[2 * 33] * g0[2], s[3 * 33] * g0[3]); o.z = pk2(s[4 * 33] * g1[0], s[5 * 33] * g1[1]); o.w = pk2(s[6 * 33] * g1[2], s[7 * 33] * g1[3]);
        *(u32x4*)(WT + (size_t)(drow0 + n) * K + k0 + 8 * c) = o; }
    LDS_WAIT(); asm volatile("" ::: "memory");
}
constexpr int IT_FF = (DM / 64) * (FF / 32);
__device__ __forceinline__ void convert_gu(const float* wg, const float* wu, const float* gain, unsigned char* ws, LAS unsigned char* lds, int gw, int ngw, int lane, int wave) {
    LAS float* scr = (LAS float*)(lds + wave * 8448); bf16_t* WGU = (bf16_t*)(ws + WS_WFF);
#pragma unroll 1
    for (int it = gw; it < 2 * IT_FF; it += ngw) { if (it < IT_FF) transpose_item(wg, DM, FF, WGU, 1, gain, scr, it, lane); else transpose_item(wu, DM, FF, WGU, 2, gain, scr, it - IT_FF, lane); }
}
__device__ __forceinline__ void convert_dn(const float* wd, unsigned char* ws, LAS unsigned char* lds, int gw, int ngw, int lane, int wave) {
    LAS float* scr = (LAS float*)(lds + wave * 8448); bf16_t* WDN = (bf16_t*)(ws + WS_WDN);
#pragma unroll 1
    for (int it = gw; it < IT_FF; it += ngw) transpose_item(wd, FF, DM, WDN, 0, nullptr, scr, it, lane);
}
__device__ __forceinline__ void convert_tail1(const Params& p, LAS unsigned char* lds, int gw, int ngw, int lane, int wave) {
    LAS float* scr = (LAS float*)(lds + wave * 8448); unsigned char* ws = p.ws;
    constexpr int IT_IN = (DM / 64) * (NIN / 32), IT_OUT = (DM / 64) * (DM / 32);
#pragma unroll 1
    for (int it = gw; it < IT_FF + IT_IN + IT_OUT; it += ngw) {
        if (it < IT_FF) transpose_item(p.in[4], FF, DM, (bf16_t*)(ws + WS_WDN), 0, nullptr, scr, it, lane);
        else if (it < IT_FF + IT_IN) transpose_item(p.in[6], DM, NIN, (bf16_t*)(ws + WS_WIN), 0, p.in[5], scr, it - IT_FF, lane);
        else transpose_item(p.in[26], DM, DM, (bf16_t*)(ws + WS_WOUT), 0, nullptr, scr, it - IT_FF - IT_IN, lane);
    }
}
__device__ __forceinline__ void hid_pass(const Params& p, LAS float* sm, const LAS float* WL, int pos0, int tid) {
    const float* b1 = p.in[10]; const float* f1 = p.in[11]; const float* b2 = p.in[13]; const float* f2 = p.in[14]; const float* b3 = p.in[16]; const float* f3 = p.in[17];
    bf16_t* hidx = (bf16_t*)(p.ws + WS_HID);
    const int pp = tid >> 6, j = tid & 63, pos = pos0 + pp;
    LAS float* Z = sm; LAS float* H1 = sm + 512; LAS float* H2 = sm + 1024;
    const LAS float* w1 = WL; const LAS float* w2 = WL + 33 * 64; const LAS float* w3 = w2 + 64 * 64;
    if (j < 33) {
        float z;
        if (j == 0) z = (float)pos / 8191.0f;
        else {
            const int b = (j - 1) & 15; const float fj = 1e-4f + (float)b * ((15.0f - 1e-4f) / 15.0f);
            const double r = (double)pos * (double)fj * (1.0 / 8192.0); const float fr = (float)(r - floor(r));
            float s, c; sincospif(2.0f * fr, &s, &c);
            z = (j <= 16) ? c : -s;
        }
        Z[pp * 40 + j] = z;
    }
    __syncthreads();
    float a, a0 = b1[j] + Z[pp * 40 + 32] * w1[32 * 64 + j], a1 = 0.f, a2 = 0.f, a3 = 0.f;
#pragma unroll
    for (int k4 = 0; k4 < 8; ++k4) { const f32x4 h = *(const LAS f32x4*)(Z + pp * 40 + 4 * k4);
        a0 += h[0] * w1[(4 * k4 + 0) * 64 + j]; a1 += h[1] * w1[(4 * k4 + 1) * 64 + j]; a2 += h[2] * w1[(4 * k4 + 2) * 64 + j]; a3 += h[3] * w1[(4 * k4 + 3) * 64 + j]; }
    a = (a0 + a1) + (a2 + a3);
    H1[pp * 64 + j] = sinf(f1[j] * a);
    __syncthreads();
    a0 = b2[j]; a1 = 0.f; a2 = 0.f; a3 = 0.f;
#pragma unroll
    for (int k4 = 0; k4 < 16; ++k4) { const f32x4 h = *(const LAS f32x4*)(H1 + pp * 64 + 4 * k4);
        a0 += h[0] * w2[(4 * k4 + 0) * 64 + j]; a1 += h[1] * w2[(4 * k4 + 1) * 64 + j]; a2 += h[2] * w2[(4 * k4 + 2) * 64 + j]; a3 += h[3] * w2[(4 * k4 + 3) * 64 + j]; }
    a = (a0 + a1) + (a2 + a3);
    H2[pp * 64 + j] = sinf(f2[j] * a);
    __syncthreads();
    a0 = b3[j]; a1 = 0.f; a2 = 0.f; a3 = 0.f;
#pragma unroll
    for (int k4 = 0; k4 < 16; ++k4) { const f32x4 h = *(const LAS f32x4*)(H2 + pp * 64 + 4 * k4);
        a0 += h[0] * w3[(4 * k4 + 0) * 64 + j]; a1 += h[1] * w3[(4 * k4 + 1) * 64 + j]; a2 += h[2] * w3[(4 * k4 + 2) * 64 + j]; a3 += h[3] * w3[(4 * k4 + 3) * 64 + j]; }
    a = (a0 + a1) + (a2 + a3);
    { const float h3 = sinf(f3[j] * a); const unsigned hi = f2bf(h3); bf16_t* hr = hidx + (size_t)pos * 256 + j; hr[0] = (bf16_t)hi; hr[64] = (bf16_t)f2bf(h3 - bf2f(hi)); hr[128] = (bf16_t)hi; hr[192] = 0; }
}
__device__ __forceinline__ void phase0(const Params& p, LAS unsigned char* lds, int tid, int lane, int wave, int mask) {
    const int G = gridDim.x, gw = blockIdx.x * 8 + wave, ngw = G * 8;
    unsigned char* ws = p.ws;
    if (mask & 1) convert_gu(p.in[2], p.in[3], p.in[1], ws, lds, gw, ngw, lane, wave);
    const int gt = blockIdx.x * NT + tid, ngt = G * NT;
    {
      float* rs = (float*)(ws + WS_ROWSS) + L; for (int i = gt; i < 3 * L; i += ngt) rs[i] = 0.f; }
    { const float* w4 = p.in[18]; bf16_t* tx = (bf16_t*)(ws + WS_W4T);
      for (int i = gt; i < 2048 * 64; i += ngt) { const int c = i >> 6, k = i & 63; const float v = w4[k * 2048 + c]; const unsigned hi = f2bf(v); bf16_t* tr = tx + (size_t)c * 256 + k; tr[0] = (bf16_t)hi; tr[64] = (bf16_t)hi; tr[128] = (bf16_t)f2bf(v - bf2f(hi)); tr[192] = 0; } }
    if (mask & 4) {
        const float* x = p.in[0]; bf16_t* xb = (bf16_t*)(ws + WS_XB); float* rs = (float*)(ws + WS_ROWSS);
#pragma unroll 1
        for (int m = gw; m < L; m += ngw) {
            const f32x4* xr = (const f32x4*)(x + (size_t)m * DM) + lane; u32x2* o = (u32x2*)(xb + (size_t)m * DM) + lane; float s = 0.f;
#pragma unroll
            for (int j = 0; j < 8; ++j) { const f32x4 v = __builtin_nontemporal_load(xr + 64 * j); s += (v[0] * v[0] + v[1] * v[1]) + (v[2] * v[2] + v[3] * v[3]);
                u32x2 w; w.x = pk2(v[0], v[1]); w.y = pk2(v[2], v[3]); o[64 * j] = w; }
            s = wave_sum(s); if (lane == 0) rs[m] = s;
        }
    }
    __syncthreads();
    if (mask & 8) { LAS float* WL = (LAS float*)lds + 2048;
      for (int i = tid; i < 33 * 64; i += NT) WL[i] = p.in[9][i];
      for (int i = tid; i < 64 * 64; i += NT) { WL[33 * 64 + i] = p.in[12][i]; WL[33 * 64 + 64 * 64 + i] = p.in[15][i]; }
      __syncthreads();
#pragma unroll 1
      for (int ps = blockIdx.x; ps < L / 8; ps += G) { hid_pass(p, (LAS float*)lds, WL, ps * 8, tid); __syncthreads(); } }
}

__device__ __forceinline__ void convT_fetch(const bf16_t* phy, int tile, int tid, u32x4 (&rw)[4]) {
    const int t0 = (tile >> 4) * 64, c0 = (tile & 15) * 64;
#pragma unroll
    for (int k = 0; k < 4; ++k) { const int idx = tid + NT * k; rw[k] = (u32x4){0u, 0u, 0u, 0u};
        if (idx < 3 * 66 * 8) { const int s = idx / 528, r = (idx % 528) >> 3, c8 = (idx & 7) * 8, tt = t0 - 1 + r;
            if (tt >= 0 && tt < L) rw[k] = *(const u32x4*)(phy + (size_t)tt * PHY_LD + s * HYW + c0 + c8); } }
}
__device__ __forceinline__ void convT_tile(const Params& p, LAS unsigned char* lds, int tile, int tid, const u32x4 (&rw)[4]) {
    bf16_t* zT = (bf16_t*)(p.ws + WS_ZT); bf16_t* x0T = (bf16_t*)(p.ws + WS_X0T);
    const float* cw = p.in[7]; const float* cb = p.in[8];
    LAS float* zt = (LAS float*)lds; LAS float* xt = zt + 64 * 65;
    LAS bf16_t* raw = (LAS bf16_t*)(lds + 33280);
    const int t0 = (tile >> 4) * 64, c0 = (tile & 15) * 64;
#pragma unroll
    for (int k = 0; k < 4; ++k) { const int idx = tid + NT * k; if (idx < 3 * 66 * 8) { const int s = idx / 528, r = (idx % 528) >> 3, c8 = (idx & 7) * 8; *(LAS u32x4*)(raw + (s * 66 + r) * 64 + c8) = rw[k]; } }
    const int c = tid & 63, tg = tid >> 6;
    float w[3][3], b[3];
#pragma unroll
    for (int s = 0; s < 3; ++s) { const int col = s * HYW + c0 + c; b[s] = cb[col];
#pragma unroll
        for (int tap = 0; tap < 3; ++tap) w[s][tap] = cw[tap * 3 * HYW + col]; }
    __syncthreads();
#pragma unroll
    for (int i = 0; i < 8; ++i) {
        const int tl = tg * 8 + i; float u[3];
#pragma unroll
        for (int s = 0; s < 3; ++s) { float a = b[s];
#pragma unroll
            for (int tap = 0; tap < 3; ++tap) a += w[s][tap] * bf2f(raw[(s * 66 + tl + tap) * 64 + c]);
            u[s] = a; }
        zt[c * 65 + tl] = u[2] * u[1]; xt[c * 65 + tl] = u[0];
    }
    __syncthreads();
    { const int t = tid & 63, cg8 = tid >> 6;
#pragma unroll
      for (int i = 0; i < 8; ++i) { const int cc = cg8 * 8 + i; zT[(size_t)(c0 + cc) * L + t0 + t] = (bf16_t)f2bf(zt[cc * 65 + t]); x0T[(size_t)(c0 + cc) * L + t0 + t] = (bf16_t)f2bf(xt[cc * 65 + t]); } }
    __syncthreads();
}

__device__ __forceinline__ float logsig16(float x) { return (fminf(x, 0.f) - __logf(1.0f + __expf(-fabsf(x)))) * (1.0f / 16.0f); }
__device__ __forceinline__ bf16x8 ldfrag(const LAS bf16_t* base, int ld, int row0, int k0, int lane) { return *(const LAS bf16x8*)(base + (row0 + (lane & 15)) * ld + k0 + 8 * (lane >> 4)); }

__device__ __forceinline__ void gla_stage(const bf16_t* pr, const float* lr, int t0, int h, LAS float* lrs, LAS bf16_t* vT, int tid) {
    *(LAS f32x4*)(lrs + tid * 4) = *(const f32x4*)(lr + (size_t)t0 * 32 + tid * 4);
    { const int c = tid & 255, tb = tid >> 8; const bf16_t* vp = pr + (size_t)t0 * PR_LD + PR_V + h * 256 + c;
#pragma unroll
      for (int i = 0; i < 4; ++i) { const int tk = (tb * 4 + i) * 8; unsigned short e[8];
#pragma unroll
          for (int j = 0; j < 8; ++j) e[j] = vp[(size_t)(tk + j) * PR_LD];
          u32x4 w; w.x = e[0] | ((unsigned)e[1] << 16); w.y = e[2] | ((unsigned)e[3] << 16); w.z = e[4] | ((unsigned)e[5] << 16); w.w = e[6] | ((unsigned)e[7] << 16);
          *(LAS u32x4*)(vT + c * 72 + tk) = w; } }
}
struct GateW { float w[16]; float b; };
__device__ __forceinline__ void gate_load(const Params& p, int dir, int h, int d, GateW& g) {
    const float* wa = dir ? p.in[23] : p.in[21]; const float* ba = dir ? p.in[24] : p.in[22];
#pragma unroll
    for (int r = 0; r < 16; ++r) g.w[r] = wa[r * 512 + h * 128 + d];
    g.b = ba[h * 128 + d];
}
__device__ __forceinline__ float gate_eval(const GateW& g, const LAS float* lr) {
    const LAS f32x4* l4 = (const LAS f32x4*)lr; const f32x4 a = l4[0], b = l4[1], c = l4[2], d = l4[3];
    float x0 = g.b, x1 = 0.f, x2 = 0.f, x3 = 0.f;
#pragma unroll
    for (int r = 0; r < 4; ++r) { x0 += a[r] * g.w[r]; x1 += b[r] * g.w[4 + r]; x2 += c[r] * g.w[8 + r]; x3 += d[r] * g.w[12 + r]; }
    return logsig16((x0 + x1) + (x2 + x3));
}

__device__ __forceinline__ void gla_kv_item(const Params& p, LAS unsigned char* lds, int item, int tid, int lane, int wave) {
    const int h = item & 3, n = item >> 2, t0 = n * 64;
    const bf16_t* pr = (const bf16_t*)(p.ws + WS_PR); bf16_t* ST = (bf16_t*)(p.ws + WS_ST); float* dec = (float*)(p.ws + WS_DEC);
    LAS bf16_t* vT = (LAS bf16_t*)lds; LAS bf16_t* kstT = (LAS bf16_t*)(lds + 36864);
    LAS float* lrs = (LAS float*)(lds + 73728); LAS float* tot = (LAS float*)(lds + 81920);
    gla_stage(pr, (const float*)(p.ws + WS_LR), t0, h, lrs, vT, tid);
    const int d = tid & 127, dir = (tid >> 7) & 1, half = tid >> 8;
    GateW gw; gate_load(p, dir, h, d, gw);
    const bf16_t* kp = pr + (size_t)t0 * PR_LD + PR_K + h * 128 + d;
    unsigned short kr[8];
#pragma unroll
    for (int u = 0; u < 8; ++u) { const int q = half * 32 + u, t = dir ? 63 - q : q; kr[u] = kp[(size_t)t * PR_LD]; }
    __syncthreads();
    {
        float b = 0.f;
#pragma unroll 1
        for (int sg = 0; sg < 4; ++sg) {
            unsigned short kn[8];
#pragma unroll
            for (int u = 0; u < 8; ++u) { const int q = half * 32 + ((sg * 8 + 8 + u) & 31), t = dir ? 63 - q : q; kn[u] = kp[(size_t)t * PR_LD]; }
            unsigned ke[8];
#pragma unroll
            for (int u = 0; u < 8; ++u) { const int q = half * 32 + sg * 8 + u, t = dir ? 63 - q : q; b += gate_eval(gw, lrs + t * 32 + dir * 16);
                ke[dir ? 7 - u : u] = f2bf(bf2f(kr[u]) * __expf(-b)); }
            { const int q0 = half * 32 + sg * 8, tlo = dir ? 63 - q0 - 7 : q0; u32x4 w; w.x = ke[0] | (ke[1] << 16); w.y = ke[2] | (ke[3] << 16); w.z = ke[4] | (ke[5] << 16); w.w = ke[6] | (ke[7] << 16);
              *(LAS u32x4*)(kstT + (dir * 128 + d) * 72 + tlo) = w; }
#pragma unroll
            for (int u = 0; u < 8; ++u) kr[u] = kn[u];
        }
        tot[(dir * 2 + half) * 128 + d] = b;
    }
    __syncthreads();
    if (half == 0) dec[((size_t)(dir * 128 + n) * 4 + h) * 128 + d] = __expf(tot[(dir * 2 + 0) * 128 + d] + tot[(dir * 2 + 1) * 128 + d]);
    const int q4 = lane >> 4, v0 = wave * 32;
#pragma unroll 1
    for (int dr = 0; dr < 2; ++dr) {
        f32x4 acc[8][2];
#pragma unroll
        for (int mt = 0; mt < 8; ++mt) { acc[mt][0] = (f32x4){0.f, 0.f, 0.f, 0.f}; acc[mt][1] = (f32x4){0.f, 0.f, 0.f, 0.f}; }
#pragma unroll
        for (int ks = 0; ks < 2; ++ks) {
            const bf16x8 b0 = ldfrag(vT, 72, v0, 32 * ks, lane), b1 = ldfrag(vT, 72, v0 + 16, 32 * ks, lane);
#pragma unroll
            for (int mt = 0; mt < 8; ++mt) { const bf16x8 a = ldfrag(kstT + dr * 128 * 72, 72, 16 * mt, 32 * ks, lane);
                acc[mt][0] = __builtin_amdgcn_mfma_f32_16x16x32_bf16(a, b0, acc[mt][0], 0, 0, 0);
                acc[mt][1] = __builtin_amdgcn_mfma_f32_16x16x32_bf16(a, b1, acc[mt][1], 0, 0, 0); }
            if (ks == 0) {
#pragma unroll
                for (int mt = 0; mt < 8; ++mt) { const f32x4 T0 = *(const LAS f32x4*)(tot + (dr * 2 + 0) * 128 + 16 * mt + 4 * q4);
                    f32x4 rt;
#pragma unroll
                    for (int r = 0; r < 4; ++r) rt[r] = __expf(dr ? -T0[r] : T0[r]);
                    acc[mt][0] *= rt; acc[mt][1] *= rt; }
            }
        }
        bf16_t* S = ST + ((size_t)(dr * 4 + h) * 128 + n) * 32768;
#pragma unroll
        for (int mt = 0; mt < 8; ++mt) {
            const f32x4 T0 = *(const LAS f32x4*)(tot + (dr * 2 + 0) * 128 + 16 * mt + 4 * q4), T1 = *(const LAS f32x4*)(tot + (dr * 2 + 1) * 128 + 16 * mt + 4 * q4);
            f32x4 s1;
#pragma unroll
            for (int r = 0; r < 4; ++r) s1[r] = __expf(dr ? T0[r] + T1[r] : T1[r]);
#pragma unroll
            for (int nt = 0; nt < 2; ++nt) { const f32x4 v = acc[mt][nt] * s1; u32x2 w; w.x = pk2(v[0], v[1]); w.y = pk2(v[2], v[3]);
                *(u32x2*)(S + (size_t)(v0 + 16 * nt + (lane & 15)) * 128 + 16 * mt + 4 * q4) = w; }
        }
    }
    __syncthreads();
}

#ifndef REP_FA
#define REP_FA 0
#endif
#ifndef REP_FB
#define REP_FB 0
#endif
__device__ __forceinline__ void lr_task(const Params& p, LAS unsigned char* lds, int task, int tid, int lane, int wave) {
    const bf16_t* xb = (const bf16_t*)(p.ws + WS_XB); const bf16_t* wt = (const bf16_t*)(p.ws + WS_WIN) + (size_t)NING * DM;
    const float* rowss1 = (const float*)(p.ws + WS_ROWSS) + L; float* lr = (float*)(p.ws + WS_LR);
    const int mt = wave >> 2, nt = (wave >> 1) & 1, kh = wave & 1, fr = lane & 15, q4 = lane >> 4, t0 = task * 32;
    const bf16_t* ap = xb + (size_t)(t0 + 16 * mt + fr) * DM + kh * 1024 + 8 * q4; const bf16_t* bp = wt + (size_t)(16 * nt + fr) * DM + kh * 1024 + 8 * q4;
    f32x4 acc = (f32x4){0.f, 0.f, 0.f, 0.f};
#pragma unroll 1
    for (int kb = 0; kb < 2; ++kb) { bf16x8 a[16], b[16];
#pragma unroll
        for (int u = 0; u < 16; ++u) { a[u] = *(const bf16x8*)(ap + (kb * 16 + u) * 32); b[u] = *(const bf16x8*)(bp + (kb * 16 + u) * 32); }
#pragma unroll
        for (int u = 0; u < 16; ++u) acc = __builtin_amdgcn_mfma_f32_16x16x32_bf16(a[u], b[u], acc, 0, 0, 0); }
    LAS f32x4* ex = (LAS f32x4*)lds;
    if (kh) ex[(wave >> 1) * 64 + lane] = acc;
    __syncthreads();
    if (!kh) { const f32x4 o = ex[(wave >> 1) * 64 + lane];
#pragma unroll
        for (int r = 0; r < 4; ++r) { const int t = t0 + 16 * mt + 4 * q4 + r; lr[(size_t)t * 32 + 16 * nt + fr] = (acc[r] + o[r]) * pg8::rstd_of(rowss1[t]); } }
    __syncthreads();
}
__device__ __forceinline__ c2 cmul(c2 a, c2 b) { return mk2(a.x * b.x - a.y * b.y, a.x * b.y + a.y * b.x); }
__device__ __forceinline__ c2 twid(int m) { const float r = (float)m * (1.0f / 16384.0f); return mk2(__builtin_amdgcn_cosf(r), -__builtin_amdgcn_sinf(r)); }
__device__ __forceinline__ c2 cmulc(c2 a, c2 b) { return mk2(a.x * b.x + a.y * b.y, a.y * b.x - a.x * b.y); }
#define XI(i) ((i) + ((i) >> 5))
constexpr int XPAD_BYTES = (FN + FN / 32) * 8;
__constant__ const float C16c[8] = {1.f, 0.9238795325112867f, 0.7071067811865476f, 0.3826834323650898f, 0.f, -0.3826834323650898f, -0.7071067811865476f, -0.9238795325112867f};
__constant__ const float C16s[8] = {0.f, 0.3826834323650898f, 0.7071067811865476f, 0.9238795325112867f, 1.f, 0.9238795325112867f, 0.7071067811865476f, 0.3826834323650898f};
template <int R, bool INV, int UNR> __device__ __forceinline__ void fft_pass(LAS c2* X, int lo, int tid) {
    constexpr int RAD = 1 << R;
    const int stride = 1 << lo, ls = lo + R - 1;
    int tt = tid; asm volatile("" : "+v"(tt));
#pragma unroll 1
    for (int g = tt; g < FN / RAD; g += NT) {
        const int j0 = g & (stride - 1), i = ((g - j0) << R) + j0;
        c2 e[RAD];
#pragma unroll
        for (int q = 0; q < RAD; ++q) e[q] = X[XI(i + q * stride)];
#pragma unroll
        for (int t = 0; t < R; ++t) {
            const int Hq = INV ? (1 << t) : (RAD >> (t + 1));
            const c2 base = twid(j0 << (INV ? (13 - lo - t) : (13 - ls + t)));
#pragma unroll
            for (int bf = 0; bf < RAD / 2; ++bf) {
                const int qm = bf & (Hq - 1), q = ((bf - qm) << 1) + qm, k16 = qm * (8 / Hq);
                const c2 w = (k16 == 0) ? base : cmul(base, mk2(C16c[k16], -C16s[k16]));
                if (!INV) { const c2 a = e[q], b = e[q + Hq]; e[q] = a + b; e[q + Hq] = cmul(a - b, w); }
                else { const c2 a = e[q], b = cmulc(e[q + Hq], w); e[q] = a + b; e[q + Hq] = a - b; }
            }
        }
#pragma unroll
        for (int q = 0; q < RAD; ++q) X[XI(i + q * stride)] = e[q];
    }
    __syncthreads();
}
__device__ __forceinline__ void fft_dif(LAS c2* X, int tid) { fft_pass<4, false, 2>(X, 10, tid); fft_pass<4, false, 2>(X, 6, tid); fft_pass<4, false, 2>(X, 2, tid); fft_pass<2, false, 4>(X, 0, tid); }
__device__ __forceinline__ void fft_dit_inv(LAS c2* X, int tid) { fft_pass<2, true, 4>(X, 0, tid); fft_pass<4, true, 2>(X, 2, tid); fft_pass<4, true, 2>(X, 6, tid); fft_pass<4, true, 2>(X, 10, tid); }
__device__ __forceinline__ int br14(int x) { return (int)(__brev((unsigned)x) >> 18); }
__device__ __forceinline__ float block_sum(float v, LAS float* red, int tid, int lane, int wave) {
    v = wave_sum(v); __syncthreads(); if (lane == 0) red[wave] = v; __syncthreads();
    float s = 0.f;
#pragma unroll
    for (int i = 0; i < 8; ++i) s += red[i];
    return s;
}
__device__ __forceinline__ void hyena_fft_pair(const Params& p, LAS unsigned char* lds, int pair, int tid, int lane, int wave) {
    const int c = pair * 2;
    const float* skip = p.in[19];
    bf16_t* zT = (bf16_t*)(p.ws + WS_ZT); const bf16_t* x0T = (const bf16_t*)(p.ws + WS_X0T);
    f32x4* SK = (f32x4*)(p.ws + WS_SK) + (size_t)blockIdx.x * SK_STRIDE;
    LAS c2* X = (LAS c2*)lds; LAS float* red = (LAS float*)(lds + XPAD_BYTES);
    const float dmin = -3.0701134573253945f, dmax = -15.350567286626973f;
    const float del0 = fabsf(dmin + (float)c * ((dmax - dmin) / 1023.0f)), del1 = fabsf(dmin + (float)(c + 1) * ((dmax - dmin) / 1023.0f));
    float n0 = 0.f, n1 = 0.f, inv0 = 0.f, inv1 = 0.f;
#pragma unroll 1
    for (int rb = 0; rb <= REP_FB; ++rb) {
    n0 = 0.f; n1 = 0.f;
    {
        const bf16_t* ff = (const bf16_t*)p.out + (size_t)c * L; const bf16_t* fb = (const bf16_t*)p.out + (size_t)(HYW + c) * L;
#pragma unroll 1
        for (int ub = 0; ub < 2; ++ub) { float f0[8], f1[8], g0[8], g1[8];
#pragma unroll
            for (int u = 0; u < 8; ++u) { const int i = tid + NT * (ub * 8 + u); f0[u] = bf2f(ff[i]); f1[u] = bf2f(ff[L + i]); g0[u] = bf2f(fb[i]); g1[u] = bf2f(fb[L + i]); }
#pragma unroll
            for (int u = 0; u < 8; ++u) { const int i = tid + NT * (ub * 8 + u);
                X[XI(i)] = mk2(f0[u], f1[u]); n0 += fabsf(f0[u]); n1 += fabsf(f1[u]);
                if (i >= 1) { X[XI(FN - i)] = mk2(g0[u], g1[u]); n0 += fabsf(g0[u]); n1 += fabsf(g1[u]); } } }
    }
    if (tid == 0) X[XI(L)] = mk2(0.f, 0.f);
    inv0 = 1.0f / block_sum(n0, red, tid, lane, wave); inv1 = 1.0f / block_sum(n1, red, tid, lane, wave);
    __syncthreads();
    fft_dif(X, tid);
#pragma unroll 2
    for (int m = tid; m < FN / 2; m += NT) { const int pp = 2 * m, k = br14(pp), pm = br14((FN - k) & (FN - 1)); const c2 F = X[XI(pp)], Fm = X[XI(pm)];
        SK[m] = (f32x4){0.5f * (F.x + Fm.x), 0.5f * (F.y - Fm.y), 0.5f * (F.y + Fm.y), -0.5f * (F.x - Fm.x)}; }
    if (tid == 0) { const c2 F = X[XI(1)]; SK[FN / 2] = (f32x4){F.x, 0.f, F.y, 0.f}; }
    __syncthreads();
    }
    { float za[16], zb[16];
#pragma unroll
      for (int u = 0; u < 16; ++u) { za[u] = bf2f(zT[(size_t)c * L + tid + NT * u]); zb[u] = bf2f(zT[(size_t)(c + 1) * L + tid + NT * u]); }
#pragma unroll
      for (int u = 0; u < 16; ++u) { X[XI(tid + NT * u)] = mk2(za[u], zb[u]); X[XI(L + tid + NT * u)] = mk2(0.f, 0.f); } }
    __syncthreads();
    fft_dif(X, tid);
#pragma unroll 2
    for (int m = tid; m < FN / 2; m += NT) {
        const int pp = 2 * m, k = br14(pp); const f32x4 kk = SK[m]; const c2 K1 = mk2(kk[0], kk[1]), K2 = mk2(kk[2], kk[3]);
        if (k == 0) { const c2 F = X[XI(0)]; X[XI(0)] = mk2(F.x * K1.x, F.y * K2.x);
            const f32x4 kh = SK[FN / 2]; const c2 F1 = X[XI(1)]; X[XI(1)] = mk2(F1.x * kh[0], F1.y * kh[2]); }
        else { const int pm = br14(FN - k); const c2 F = X[XI(pp)], Fm = X[XI(pm)];
            const c2 Z1 = mk2(0.5f * (F.x + Fm.x), 0.5f * (F.y - Fm.y)), Z2 = mk2(0.5f * (F.y + Fm.y), -0.5f * (F.x - Fm.x));
            const c2 A = cmul(Z1, K1), B = cmul(Z2, K2);
            X[XI(pp)] = mk2(A.x - B.y, A.y + B.x); X[XI(pm)] = mk2(A.x + B.y, -A.y + B.x); }
    }
    __syncthreads();
    fft_dit_inv(X, tid);
    const float sk0 = skip[c], sk1 = skip[c + 1], sc = 1.0f / (float)FN;
#pragma unroll 1
    for (int ub = 0; ub < 2; ++ub) { float z0[8], z1[8], x0[8], x1[8];
#pragma unroll
        for (int u = 0; u < 8; ++u) { const int i = tid + NT * (ub * 8 + u); const size_t o0 = (size_t)c * L + i, o1 = (size_t)(c + 1) * L + i; z0[u] = bf2f(zT[o0]); z1[u] = bf2f(zT[o1]); x0[u] = bf2f(x0T[o0]); x1[u] = bf2f(x0T[o1]); }
#pragma unroll
        for (int u = 0; u < 8; ++u) { const int i = tid + NT * (ub * 8 + u); const size_t o0 = (size_t)c * L + i, o1 = (size_t)(c + 1) * L + i; const c2 y = X[XI(i)];
            zT[o0] = (bf16_t)f2bf((y.x * sc * inv0 + sk0 * z0[u]) * x0[u]); zT[o1] = (bf16_t)f2bf((y.y * sc * inv1 + sk1 * z1[u]) * x1[u]); } }
    __syncthreads();
}
__device__ __forceinline__ void gla_scan(const Params& p, int tid) {
    unsigned* ST = (unsigned*)(p.ws + WS_ST); const float* dec = (const float*)(p.ws + WS_DEC);
    const int gt = blockIdx.x * NT + tid, ngt = gridDim.x * NT;
#pragma unroll 1
    for (int e = gt; e < 8 * 16384; e += ngt) {
        const int dh = e >> 14, idx = e & 16383, dir = dh >> 2, h = dh & 3, d = (2 * idx) & 127;
        unsigned* base = ST + (size_t)dh * 128 * 16384 + idx;
        const float* db = dec + ((size_t)dir * 128 * 4 + h) * 128 + d;
        float s0 = 0.f, s1 = 0.f;
#pragma unroll 1
        for (int nb = 0; nb < 128; nb += 16) {
            unsigned kv[16]; c2 dc[16];
#pragma unroll
            for (int u = 0; u < 16; ++u) { const int n = dir ? 127 - (nb + u) : nb + u; kv[u] = base[(size_t)n * 16384]; dc[u] = *(const c2*)(db + (size_t)n * 512); }
#pragma unroll
            for (int u = 0; u < 16; ++u) { const int n = dir ? 127 - (nb + u) : nb + u; base[(size_t)n * 16384] = pk2(s0, s1);
                s0 = dc[u].x * s0 + bf2f(kv[u] & 0xffffu); s1 = dc[u].y * s1 + bf2f(kv[u] >> 16); }
        }
    }
}

__device__ __forceinline__ void gla_out_item(const Params& p, LAS unsigned char* lds, int item, int tid, int lane, int wave) {
    const int h = item & 3, n = item >> 2, t0 = n * 64;
    const bf16_t* pr = (const bf16_t*)(p.ws + WS_PR); const bf16_t* ST = (const bf16_t*)(p.ws + WS_ST); bf16_t* mix = (bf16_t*)(p.ws + WS_MIX);
    const float* og = p.in[25];
    LAS bf16_t* qin = (LAS bf16_t*)lds;
    LAS bf16_t* kin = (LAS bf16_t*)(lds + 34816);
    LAS bf16_t* vT = (LAS bf16_t*)(lds + 69632);
    LAS bf16_t* P = (LAS bf16_t*)(lds + 106496);
    LAS float* lrs = (LAS float*)(lds + 115712); LAS float* tot = (LAS float*)(lds + 123904); LAS float* red = (LAS float*)(lds + 125952);
    gla_stage(pr, (const float*)(p.ws + WS_LR), t0, h, lrs, vT, tid);
    const int d = tid & 127, dir = (tid >> 7) & 1, half = tid >> 8;
    GateW gw; gate_load(p, dir, h, d, gw);
    const bf16_t* qp = pr + (size_t)t0 * PR_LD + PR_Q + h * 128 + d;
    unsigned short kr[8], qr[8];
#pragma unroll
    for (int u = 0; u < 8; ++u) { const int q = half * 32 + u, t = dir ? 63 - q : q; qr[u] = qp[(size_t)t * PR_LD]; kr[u] = qp[(size_t)t * PR_LD + (PR_K - PR_Q)]; }
    __syncthreads();
    float sum = 0.f;
#pragma unroll 4
    for (int s = 0; s < 32; ++s) { const int q = half * 32 + s, t = dir ? 63 - q : q; sum += gate_eval(gw, lrs + t * 32 + dir * 16); }
    tot[(dir * 2 + half) * 128 + d] = sum;
    __syncthreads();
    {
        float b = half ? tot[(dir * 2 + 0) * 128 + d] : 0.f;
#pragma unroll 1
        for (int sg = 0; sg < 4; ++sg) {
            unsigned short kn[8], qn[8];
#pragma unroll
            for (int u = 0; u < 8; ++u) { const int q = half * 32 + ((sg * 8 + 8 + u) & 31), t = dir ? 63 - q : q; qn[u] = qp[(size_t)t * PR_LD]; kn[u] = qp[(size_t)t * PR_LD + (PR_K - PR_Q)]; }
#pragma unroll
            for (int u = 0; u < 8; ++u) { const int q = half * 32 + sg * 8 + u, t = dir ? 63 - q : q; b += gate_eval(gw, lrs + t * 32 + dir * 16);
                const float qv = bf2f(qr[u]) * 0.08838834764831845f, kv = bf2f(kr[u]);
                qin[(dir * 64 + t) * 136 + d] = (bf16_t)f2bf(qv * __expf(b)); kin[(dir * 64 + t) * 136 + d] = (bf16_t)f2bf(kv * __expf(-b)); }
#pragma unroll
            for (int u = 0; u < 8; ++u) { kr[u] = kn[u]; qr[u] = qn[u]; }
        }
    }
    __syncthreads();
    const int q4 = lane >> 4, fr = lane & 15;
#pragma unroll 1
    for (int ti = 0; ti < 2; ++ti) {
        const int id = wave * 2 + ti, tt = id >> 2, st = id & 3;
        f32x4 af = (f32x4){0.f, 0.f, 0.f, 0.f}, ab = (f32x4){0.f, 0.f, 0.f, 0.f};
        if (tt >= st) {
#pragma unroll
            for (int ks = 0; ks < 4; ++ks) af = __builtin_amdgcn_mfma_f32_16x16x32_bf16(ldfrag(qin, 136, 16 * tt, 32 * ks, lane), ldfrag(kin, 136, 16 * st, 32 * ks, lane), af, 0, 0, 0); }
        if (tt <= st) {
#pragma unroll
            for (int ks = 0; ks < 4; ++ks) ab = __builtin_amdgcn_mfma_f32_16x16x32_bf16(ldfrag(qin + 64 * 136, 136, 16 * tt, 32 * ks, lane), ldfrag(kin + 64 * 136, 136, 16 * st, 32 * ks, lane), ab, 0, 0, 0); }
#pragma unroll
        for (int r = 0; r < 4; ++r) { const int t = 16 * tt + 4 * q4 + r, s = 16 * st + fr; P[t * 72 + s] = (bf16_t)f2bf(t >= s ? af[r] : ab[r]); }
    }
    __syncthreads();
    f32x4 acc[2][4];
#pragma unroll
    for (int mt = 0; mt < 2; ++mt)
#pragma unroll
        for (int nt = 0; nt < 4; ++nt) acc[mt][nt] = (f32x4){0.f, 0.f, 0.f, 0.f};
    const int v0 = wave * 32;
#pragma unroll
    for (int ks = 0; ks < 2; ++ks) {
        const bf16x8 a0 = ldfrag(vT, 72, v0, 32 * ks, lane), a1 = ldfrag(vT, 72, v0 + 16, 32 * ks, lane);
#pragma unroll
        for (int nt = 0; nt < 4; ++nt) { const bf16x8 b = ldfrag(P, 72, 16 * nt, 32 * ks, lane);
            acc[0][nt] = __builtin_amdgcn_mfma_f32_16x16x32_bf16(a0, b, acc[0][nt], 0, 0, 0); acc[1][nt] = __builtin_amdgcn_mfma_f32_16x16x32_bf16(a1, b, acc[1][nt], 0, 0, 0); }
    }
#pragma unroll 1
    for (int dr = 0; dr < 2; ++dr) {
        const bf16_t* S = ST + ((size_t)(dr * 4 + h) * 128 + n) * 32768;
        bf16x8 sa[4][2];
#pragma unroll
        for (int ks = 0; ks < 4; ++ks) { sa[ks][0] = *(const bf16x8*)(S + (size_t)(v0 + fr) * 128 + 32 * ks + 8 * q4); sa[ks][1] = *(const bf16x8*)(S + (size_t)(v0 + 16 + fr) * 128 + 32 * ks + 8 * q4); }
#pragma unroll
        for (int ks = 0; ks < 4; ++ks)
#pragma unroll
            for (int nt = 0; nt < 4; ++nt) { const bf16x8 b = ldfrag(qin + dr * 64 * 136, 136, 16 * nt, 32 * ks, lane);
                acc[0][nt] = __builtin_amdgcn_mfma_f32_16x16x32_bf16(sa[ks][0], b, acc[0][nt], 0, 0, 0); acc[1][nt] = __builtin_amdgcn_mfma_f32_16x16x32_bf16(sa[ks][1], b, acc[1][nt], 0, 0, 0); }
    }
#pragma unroll
    for (int nt = 0; nt < 4; ++nt) { float ss = 0.f;
#pragma unroll
        for (int mt = 0; mt < 2; ++mt) ss += (acc[mt][nt][0] * acc[mt][nt][0] + acc[mt][nt][1] * acc[mt][nt][1]) + (acc[mt][nt][2] * acc[mt][nt][2] + acc[mt][nt][3] * acc[mt][nt][3]);
        ss += __shfl_xor(ss, 16); ss += __shfl_xor(ss, 32);
        if (q4 == 0) red[wave * 64 + 16 * nt + fr] = ss; }
    __syncthreads();
#pragma unroll
    for (int nt = 0; nt < 4; ++nt) { const int t = 16 * nt + fr; float ss = 0.f;
#pragma unroll
        for (int w = 0; w < 8; ++w) ss += red[w * 64 + t];
        const float rs = rsqrtf(ss * (1.0f / 256.0f) + 1e-6f);
#pragma unroll
        for (int mt = 0; mt < 2; ++mt) { const int v = v0 + 16 * mt + 4 * q4; const f32x4 g = *(const f32x4*)(og + h * 256 + v);
            const u32x2 rw = *(const u32x2*)(pr + (size_t)(t0 + t) * PR_LD + PR_R + h * 256 + v);
            const float r0 = bf2f(rw.x & 0xffffu), r1 = bf2f(rw.x >> 16), r2 = bf2f(rw.y & 0xffffu), r3 = bf2f(rw.y >> 16);
            u32x2 w; w.x = pk2(acc[mt][nt][0] * rs * g[0] * silu_f(r0), acc[mt][nt][1] * rs * g[1] * silu_f(r1));
            w.y = pk2(acc[mt][nt][2] * rs * g[2] * silu_f(r2), acc[mt][nt][3] * rs * g[3] * silu_f(r3));
            *(u32x2*)(mix + (size_t)(t0 + t) * DM + HYW + h * 256 + v) = w; }
    }
    __syncthreads();
}
__device__ __forceinline__ void hynorm_tile(const Params& p, LAS unsigned char* lds, int tile, int tid) {
    const bf16_t* yT = (const bf16_t*)(p.ws + WS_ZT); bf16_t* mix = (bf16_t*)(p.ws + WS_MIX); const float* og = p.in[20];
    LAS float* yt = (LAS float*)lds; LAS float* red = yt + 128 * 65;
    const int g = tile & 7, t0 = (tile >> 3) * 64, c0 = g * 128;
    { const int t = tid & 63, cg8 = tid >> 6; float ss = 0.f;
#pragma unroll
      for (int i = 0; i < 16; ++i) { const int cc = cg8 * 16 + i; const float v = bf2f(yT[(size_t)(c0 + cc) * L + t0 + t]); yt[cc * 65 + t] = v; ss += v * v; }
      red[cg8 * 64 + t] = ss; }
    __syncthreads();
    { const int c2 = (tid & 63) * 2, tg = tid >> 6; const float g0 = og[c0 + c2], g1 = og[c0 + c2 + 1];
#pragma unroll
      for (int i = 0; i < 8; ++i) { const int t = tg * 8 + i; float ss = 0.f;
#pragma unroll
          for (int w = 0; w < 8; ++w) ss += red[w * 64 + t];
          const float rs = rsqrtf(ss * (1.0f / 128.0f) + 1e-6f);
          *(unsigned*)(mix + (size_t)(t0 + t) * DM + c0 + c2) = pk2(yt[c2 * 65 + t] * rs * g0, yt[(c2 + 1) * 65 + t] * rs * g1); } }
    __syncthreads();
}

#define XB_TMO      128
#define XB_XCNT(j)  (256  + 64 * (j))
#define XB_XSUB(j)  (1280 + 64 * (j))
#define XB_XGEN(j)  (2304 + 64 * (j))
#define XB_TOP      3328
#define XB_TOPGEN   3392
#define XCD_BAR_WORDS 3456
#define XB_SPIN_CAP (1u << 18)

__device__ __forceinline__ unsigned xb_ld(unsigned* p)              { return __hip_atomic_load(p, __ATOMIC_RELAXED, __HIP_MEMORY_SCOPE_AGENT); }
__device__ __forceinline__ unsigned xb_add(unsigned* p, unsigned v) { return __hip_atomic_fetch_add(p, v, __ATOMIC_RELAXED, __HIP_MEMORY_SCOPE_AGENT); }
__device__ __forceinline__ unsigned xb_xcc_id() { return (unsigned)__builtin_amdgcn_s_getreg((3 << 11) | 20) & 0xFu; }
#define XB_SPIN(cond, bar) do { unsigned _sp = 0; while (cond) { __builtin_amdgcn_s_sleep(1); \
    if ((++_sp & 255u) == 0u) { if (xb_ld(&(bar)[XB_TMO])) break; if (_sp > XB_SPIN_CAP) { atomicAdd(&(bar)[XB_TMO], 1u); break; } } } } while (0)

struct XcdBarrier {
    unsigned* bar; unsigned x;
    volatile LAS unsigned* st;
};

__device__ __forceinline__ XcdBarrier xcd_barrier_post(unsigned* bar, volatile LAS unsigned* st) {
    XcdBarrier b; b.bar = bar; b.x = xb_xcc_id(); b.st = st;
    if (threadIdx.x == 0) (void)xb_add(&bar[XB_XCNT(b.x)], 1u);
    return b;
}
__device__ __forceinline__ void xcd_barrier_complete(unsigned* bar, unsigned x, unsigned& nloc, unsigned& nx) {
    const unsigned G = gridDim.x * gridDim.y * gridDim.z;
    unsigned sum, cnt, mine, sp = 0u;
    for (;;) {
        sum = 0u; cnt = 0u; mine = 0u;
#pragma unroll
        for (unsigned j = 0; j < 16; ++j) { const unsigned c = xb_ld(&bar[XB_XCNT(j)]); sum += c; cnt += (c > 0u) ? 1u : 0u; mine = (j == x) ? c : mine; }
        if (sum == G) break;
        __builtin_amdgcn_s_sleep(1);
        if ((++sp & 255u) == 0u) { if (xb_ld(&bar[XB_TMO])) break; if (sp > XB_SPIN_CAP) { atomicAdd(&bar[XB_TMO], 1u); break; } }
    }
    nloc = mine > 0u ? mine : 1u; nx = cnt > 0u ? cnt : 1u;
}

__device__ __forceinline__ void xcd_barrier(const XcdBarrier& b) {
    asm volatile("s_waitcnt vmcnt(0)" ::: "memory");
    __syncthreads();
    if (threadIdx.x == 0) {
        unsigned* bar = b.bar;
        __builtin_amdgcn_s_waitcnt(0);
        unsigned nloc = b.st[0], nx = b.st[1]; const unsigned bx = b.st[2];
        if (nloc == 0u) { xcd_barrier_complete(bar, bx, nloc, nx); b.st[0] = nloc; b.st[1] = nx; }
        const unsigned old = xb_add(&bar[XB_XSUB(bx)], 1u);
        const unsigned gen = old / nloc;
        if (old + 1u == (gen + 1u) * nloc) {
            __builtin_amdgcn_fence(__ATOMIC_RELEASE, "agent");
            asm volatile("s_waitcnt vmcnt(0)" ::: "memory");
            const unsigned og = xb_add(&bar[XB_TOP], 1u);
            const unsigned tg = og / nx;
            if (og + 1u == (tg + 1u) * nx) xb_add(&bar[XB_TOPGEN], 1u);
            else XB_SPIN(xb_ld(&bar[XB_TOPGEN]) == tg, bar);
            __builtin_amdgcn_fence(__ATOMIC_ACQUIRE, "agent");
            xb_add(&bar[XB_XGEN(bx)], 1u);
            asm volatile("s_waitcnt vmcnt(0)" ::: "memory");
        } else {
            XB_SPIN(xb_ld(&bar[XB_XGEN(bx)]) == gen, bar);
            __builtin_amdgcn_fence(__ATOMIC_ACQUIRE, "agent");
            asm volatile("s_waitcnt vmcnt(0)" ::: "memory");
        }
    }
    __syncthreads();
}

#ifndef REP_P0
#define REP_P0 0
#endif
#ifndef PA_MASK
#define PA_MASK 3
#endif
#ifndef PC_MASK
#define PC_MASK 3
#endif
#ifndef REP_G1
#define REP_G1 0
#endif
#ifndef REP_G3
#define REP_G3 0
#endif
#ifndef P0_MASK
#define P0_MASK 15
#endif
#ifndef REP_PA
#define REP_PA 0
#endif
#ifndef REP_PAB
#define REP_PAB 0
#endif
#ifndef REP_PC
#define REP_PC 0
#endif
__global__ void __launch_bounds__(NT, 2) fwd_megakernel(Params p) {
    extern __shared__ __attribute__((aligned(16))) unsigned char smem[];
    LAS unsigned char* lds = (LAS unsigned char*)smem;
    cg::grid_group grid = cg::this_grid();
    const int G = gridDim.x;
    volatile LAS unsigned* bst = (volatile LAS unsigned*)(lds + LDS_BYTES - 64);
    if (threadIdx.x < 2) bst[threadIdx.x] = 0u;
    __syncthreads();
    XcdBarrier xbar = xcd_barrier_post((unsigned*)(p.ws + WS_BAR), bst);
    if (threadIdx.x == 0) bst[2] = xbar.x;
    if (p.ws == nullptr) grid.sync();
#define TIDS int tid = threadIdx.x; asm volatile("" : "+v"(tid)); const int lane = tid & 63, wave = __builtin_amdgcn_readfirstlane(tid >> 6); (void)lane; (void)wave;
    unsigned char* ws = p.ws;
    float* rowss = (float*)(ws + WS_ROWSS);
    bf16_t* XB = (bf16_t*)(ws + WS_XB); bf16_t* AB = (bf16_t*)(ws + WS_A);

#pragma unroll 1
    for (int rep = 0; rep <= REP_P0; ++rep) {
#ifndef SKIP_P0
        { TIDS; phase0(p, lds, tid, lane, wave, rep == 0 ? 15 : P0_MASK); }
#endif
        xcd_barrier(xbar); }
#ifndef NO_GEMM
#pragma unroll 1
    for (int rg = 0; rg <= REP_G1; ++rg) {
    { pg8::Gemm g{XB, (const bf16_t*)(ws + WS_WFF), L, 2 * FF, DM}; pg8::StaticOrder S; S.init(L, 2 * FF, G, (int)blockIdx.x);
      pg8::EpiSwiGLU E{AB, FF, rowss}; pg8::gemm_phase<pg8::EpiSwiGLU, pg8::StaticOrder, true, true>(lds, g, S, E); }
    { TIDS; const int rem = ((L / 256) * (2 * FF / 256)) % G, nl = rem ? G - rem : G, li = rem ? (int)blockIdx.x - rem : (int)blockIdx.x;
      if (li >= 0) convert_tail1(p, lds, li * 8 + wave, nl * 8, lane, wave); }
    xcd_barrier(xbar);
    }
    { pg8::Gemm g{AB, (const bf16_t*)(ws + WS_WDN), L, DM, FF}; pg8::StaticOrder S; S.init(L, DM, G, (int)blockIdx.x);
      pg8::EpiResid E{p.in[0], nullptr, XB, rowss + L, 0.5f}; pg8::gemm_phase<pg8::EpiResid, pg8::StaticOrder, true, true>(lds, g, S, E); }
    xcd_barrier(xbar);
#pragma unroll 1
    for (int rg = 0; rg <= REP_G3; ++rg) {
    { pg8::Gemm g{XB, (const bf16_t*)(ws + WS_WIN), L, NING, DM}; pg8::StaticOrder S; S.init(L, NING, G, (int)blockIdx.x);
      pg8::EpiP E{(bf16_t*)(ws + WS_PHY), (bf16_t*)(ws + WS_PR), rowss + L}; pg8::gemm_phase<pg8::EpiP, pg8::StaticOrder, true, true>(lds, g, S, E); }
    { TIDS; for (int it = blockIdx.x; it < L / 32; it += G) lr_task(p, lds, it, tid, lane, wave); }
    xcd_barrier(xbar);
    }
#endif
#pragma unroll 1
    for (int rep = 0; rep <= REP_PAB; ++rep) {
#pragma unroll 1
        for (int r2 = 0; r2 <= REP_PA; ++r2) {
#ifndef SKIP_PA
            { pg8::Gemm g{(const bf16_t*)(ws + WS_W4T), (const bf16_t*)(ws + WS_HID), 2048, L, 256}; pg8::StaticOrder S; S.init(2048, L, G, (int)blockIdx.x);
              pg8::EpiFilt E{(bf16_t*)p.out, (bf16_t*)p.out + (size_t)HYW * L, (bf16_t*)p.out + (size_t)(HYW + 768) * L}; pg8::gemm_phase<pg8::EpiFilt, pg8::StaticOrder, true, true>(lds, g, S, E); }
            if (r2 == 0 || (PA_MASK & 1)) { TIDS; for (int it = blockIdx.x; it < 512; it += G) gla_kv_item(p, lds, it, tid, lane, wave); }
            if (r2 == 0 || (PA_MASK & 2)) { TIDS; const bf16_t* phy = (const bf16_t*)(ws + WS_PHY); u32x4 rw[4], rn[4];
              if ((int)blockIdx.x < 2048) convT_fetch(phy, blockIdx.x, tid, rw);
#pragma unroll 1
              for (int it = blockIdx.x; it < 2048; it += G) { const bool more = it + G < 2048; if (more) convT_fetch(phy, it + G, tid, rn);
                  convT_tile(p, lds, it, tid, rw);
                  if (more) {
#pragma unroll
                      for (int k = 0; k < 4; ++k) rw[k] = rn[k]; } } }
#endif
            xcd_barrier(xbar);
        }
#ifndef SKIP_PB
        { TIDS; gla_scan(p, tid); }
        { TIDS; for (int it = blockIdx.x; it < HYW / 2; it += G) hyena_fft_pair(p, lds, it, tid, lane, wave); }
#endif
        xcd_barrier(xbar);
    }
#pragma unroll 1
    for (int rep = 0; rep <= REP_PC; ++rep) {
#ifndef SKIP_PC
        if (rep == 0 || (PC_MASK & 1)) { TIDS; for (int it = blockIdx.x; it < 512; it += G) gla_out_item(p, lds, it, tid, lane, wave); }
        if (rep == 0 || (PC_MASK & 2)) { TIDS; for (int it = blockIdx.x; it < 1024; it += G) hynorm_tile(p, lds, it, tid); }
#endif
        xcd_barrier(xbar);
    }
#ifndef NO_GEMM
    { pg8::Gemm g{(const bf16_t*)(ws + WS_MIX), (const bf16_t*)(ws + WS_WOUT), L, DM, DM}; pg8::StaticOrder S; S.init(L, DM, G, (int)blockIdx.x);
      pg8::EpiResid E{nullptr, XB, XB, rowss + 2 * L, 1.0f}; pg8::gemm_phase<pg8::EpiResid, pg8::StaticOrder, true, true>(lds, g, S, E); }
    __syncthreads();
    { TIDS; convert_gu(p.in[28], p.in[29], p.in[27], ws, lds, blockIdx.x * 8 + wave, G * 8, lane, wave); }
    xcd_barrier(xbar);
    { pg8::Gemm g{XB, (const bf16_t*)(ws + WS_WFF), L, 2 * FF, DM}; pg8::StaticOrder S; S.init(L, 2 * FF, G, (int)blockIdx.x);
      pg8::EpiSwiGLU E{AB, FF, rowss + 2 * L}; pg8::gemm_phase<pg8::EpiSwiGLU, pg8::StaticOrder, true, true>(lds, g, S, E); }
    { TIDS; const int rem = ((L / 256) * (2 * FF / 256)) % G, nl = rem ? G - rem : G, li = rem ? (int)blockIdx.x - rem : (int)blockIdx.x;
      if (li >= 0) convert_dn(p.in[30], ws, lds, li * 8 + wave, nl * 8, lane, wave); }
    xcd_barrier(xbar);
    { pg8::Gemm g{AB, (const bf16_t*)(ws + WS_WDN), L, DM, FF}; pg8::StaticOrder S; S.init(L, DM, G, (int)blockIdx.x);
      pg8::EpiFinal E{XB, p.out, rowss + 3 * L, (unsigned*)(ws + WS_PCNT), p.in[31], 0.5f}; pg8::gemm_phase<pg8::EpiFinal, pg8::StaticOrder, true, true>(lds, g, S, E); }
#endif
}

extern "C" void kernel_launch(void* const* d_in, const int* in_sizes, int n_in, void* d_out, int out_size, void* d_ws, size_t ws_size, hipStream_t stream) {
    static int grid = 0;
    if (grid == 0) {
        if (n_in != 32 || out_size != L * DM || ws_size < WS_END) { fprintf(stderr, "kernel_launch: unexpected problem: n_in %d out %d ws %zu (need %zu)\n", n_in, out_size, ws_size, (size_t)WS_END); grid = -1; return; }
        int dev = 0, cus = 0, per_cu = 0;
        (void)hipGetDevice(&dev); (void)hipDeviceGetAttribute(&cus, hipDeviceAttributeMultiprocessorCount, dev);
        if (hipFuncSetAttribute((const void*)fwd_megakernel, hipFuncAttributeMaxDynamicSharedMemorySize, LDS_BYTES) != hipSuccess) { fprintf(stderr, "kernel_launch: hipFuncSetAttribute failed\n"); grid = -1; return; }
        if (hipOccupancyMaxActiveBlocksPerMultiprocessor(&per_cu, (const void*)fwd_megakernel, NT, LDS_BYTES) != hipSuccess || per_cu < 1) { fprintf(stderr, "kernel_launch: occupancy query gave %d\n", per_cu); per_cu = 1; }
        (void)hipGetLastError();
        grid = cus * per_cu; if (grid > 256) grid = 256;
        if (grid != 256) { fprintf(stderr, "kernel_launch: this kernel needs a 256-workgroup cooperative grid (256 CUs x 1), got %d; nothing launched\n", grid); grid = -1; return; }
        fprintf(stderr, "kernel_launch: cus %d per_cu %d grid %d\n", cus, per_cu, grid);
    }
    if (grid < 0) return;
    Params p{};
    for (int i = 0; i < 32; ++i) p.in[i] = (const float*)d_in[i];
    p.out = (float*)d_out; p.ws = (unsigned char*)d_ws;
    if (hipMemsetAsync((char*)d_ws + WS_BAR, 0, 16384 + 32 * 256, stream) != hipSuccess) { fprintf(stderr, "kernel_launch: hipMemsetAsync failed\n"); return; }
    void* args[] = {&p};
    hipError_t e = hipLaunchCooperativeKernel((const void*)fwd_megakernel, dim3(grid), dim3(NT), args, LDS_BYTES, stream);
    if (e != hipSuccess) fprintf(stderr, "kernel_launch: cooperative launch failed: %s (grid %d)\n", hipGetErrorString(e), grid);
}
```

```cpp
#include <hip/hip_runtime.h>
#include <hip/hip_cooperative_groups.h>
#include <cstdio>
#include <cstdint>
namespace cg = cooperative_groups;

namespace pg8 {
#define PG8_LAS __attribute__((address_space(3)))
typedef unsigned short bf16_t;
typedef short bf16x8 __attribute__((ext_vector_type(8)));
typedef float f32x4 __attribute__((ext_vector_type(4)));
typedef unsigned u32x4 __attribute__((ext_vector_type(4)));
constexpr int BM = 256, BK = 64, HALF = 128, HTB = HALF * BK * 2  , STAGE_BYTES = 8 * HTB, NXCD = 8, WGM = 8;

__host__ __device__ __forceinline__ int lds_byte(int r, int c) { const int st = (r >> 4) * 2 + (c >> 5), rr = r & 15, cc = c & 31, ob = rr * 64 + cc * 2; return st * 1024 + (ob ^ (((ob >> 9) & 1) << 5)); }
__host__ __device__ __forceinline__ void stage_rc(int b, int& R, int& C) { const int st = b / 1024, sb = b % 1024, swz = sb ^ (((sb >> 9) & 1) << 5); R = (st >> 1) * 16 + swz / 64; C = (st & 1) * 32 + (swz % 64) / 2; }
__host__ __device__ __forceinline__ int perm32(int rho) { const int n = rho >> 4, i = rho & 15; return 8 * (i >> 2) + 4 * n + (i & 3); }

struct Unit { int pm, pn; };
struct Gemm { const bf16_t* A; const bf16_t* Bt; int M, N, K; };

struct StaticOrder {
    int nM, nN, nwg, G, c;
    __host__ __device__ void init(int M, int N, int G_, int c_) { nM = M / BM; nN = N / BM; nwg = nM * nN; G = G_; c = c_; }
    __host__ __device__ bool next(int i, Unit& u) const {
        const long L = (long)i * G + c; if (L >= nwg) return false;
        int wgid = (int)L; { const int q = nwg / NXCD, r = nwg % NXCD, xcd = wgid % NXCD, off = wgid / NXCD; wgid = (xcd < r ? xcd * (q + 1) : r * (q + 1) + (xcd - r) * q) + off; }
        const int nig = WGM * nN, gid = wgid / nig, fm = gid * WGM, gsz = (nM - fm) < WGM ? (nM - fm) : WGM;
        u.pm = fm + ((wgid % nig) % gsz); u.pn = (wgid % nig) / gsz; return true;
    }
    __device__ __forceinline__ void a_ready(const Unit&) const {}
    __device__ __forceinline__ void done(const Unit&) const {}
};
__device__ __forceinline__ unsigned cvt_pk_bf16(float lo, float hi) { unsigned r; asm volatile("v_cvt_pk_bf16_f32 %0, %1, %2" : "=v"(r) : "v"(lo), "v"(hi)); return r; }
typedef unsigned u32x4 __attribute__((ext_vector_type(4)));
typedef unsigned u32x2 __attribute__((ext_vector_type(2)));
__device__ __forceinline__ float rstd_of(float ss) { return rsqrtf(ss * (1.0f / 2048.0f) + 1e-6f); }
__device__ __forceinline__ float silu_f(float x) { return x * __builtin_amdgcn_rcpf(1.0f + __expf(-x)); }

struct EpiSwiGLU {
    static constexpr bool PERM = true, AFTER_DRAIN = false;
    bf16_t* O; int ldc; const float* rowss;
    __device__ __forceinline__ void operator()(const f32x4 (&acc)[2][2][4][2], const Unit& u, int wr, int wc, int fr, int fq) const {
        const int row0 = u.pm * BM + wr * 64 + fr, col0 = u.pn * 128 + wc * 32 + 8 * fq;
#pragma unroll
        for (int ai = 0; ai < 2; ++ai)
#pragma unroll
            for (int m = 0; m < 4; ++m) {
                const int row = row0 + ai * HALF + m * 16; const float rs = rstd_of(rowss[row]);
                float v[8];
#pragma unroll
                for (int n = 0; n < 2; ++n)
#pragma unroll
                    for (int j = 0; j < 4; ++j) v[n * 4 + j] = silu_f(acc[ai][0][m][n][j] * rs) * (acc[ai][1][m][n][j] * rs);
                u32x4 w; w.x = cvt_pk_bf16(v[0], v[1]); w.y = cvt_pk_bf16(v[2], v[3]); w.z = cvt_pk_bf16(v[4], v[5]); w.w = cvt_pk_bf16(v[6], v[7]);
                *(u32x4*)(O + (size_t)row * ldc + col0) = w;
            }
    }
};
struct EpiResid {
    static constexpr bool PERM = false, AFTER_DRAIN = false;
    const float* base; const bf16_t* base16; bf16_t* ob; float* rowss; float scale;
    __device__ __forceinline__ void operator()(const f32x4 (&acc)[2][2][4][2], const Unit& u, int wr, int wc, int fr, int fq) const {
        const int row0 = u.pm * BM + wr * 64 + fr, col0 = u.pn * BM + wc * 32 + 4 * fq;
#pragma unroll
        for (int ai = 0; ai < 2; ++ai)
#pragma unroll
            for (int m = 0; m < 4; ++m) {
                const int row = row0 + ai * HALF + m * 16; float ss = 0.f;
#pragma unroll
                for (int bj = 0; bj < 2; ++bj)
#pragma unroll
                    for (int n = 0; n < 2; ++n) {
                        const size_t off = (size_t)row * 2048 + col0 + bj * HALF + n * 16;
                        f32x4 b;
                        if (base) b = *(const f32x4*)(base + off);
                        else { const u32x2 r = *(const u32x2*)(base16 + off); b = (f32x4){__builtin_bit_cast(float, r.x << 16), __builtin_bit_cast(float, r.x & 0xffff0000u), __builtin_bit_cast(float, r.y << 16), __builtin_bit_cast(float, r.y & 0xffff0000u)}; }
                        const f32x4 v = b + acc[ai][bj][m][n] * scale;
                        { u32x2 w; w.x = cvt_pk_bf16(v[0], v[1]); w.y = cvt_pk_bf16(v[2], v[3]); *(u32x2*)(ob + off) = w; }
                        ss += (v[0] * v[0] + v[1] * v[1]) + (v[2] * v[2] + v[3] * v[3]);
                    }
                ss += __shfl_xor(ss, 16); ss += __shfl_xor(ss, 32);
                if (rowss && fq == 0) atomicAdd(rowss + row, ss);
            }
    }
};
struct EpiP {
    static constexpr bool PERM = true, AFTER_DRAIN = false;
    bf16_t* phy; bf16_t* pr; const float* rowss;
    __device__ __forceinline__ void operator()(const f32x4 (&acc)[2][2][4][2], const Unit& u, int wr, int wc, int fr, int fq) const {
        const int row0 = u.pm * BM + wr * 64 + fr;
        bf16_t* O; int ldc, colt;
        if (u.pn < 12) { O = phy; ldc = 3072; colt = u.pn * BM; } else { O = pr; ldc = 3072; colt = (u.pn - 12) * BM; }
        const int col0 = colt + wc * 32 + 8 * fq;
#pragma unroll
        for (int ai = 0; ai < 2; ++ai)
#pragma unroll
            for (int m = 0; m < 4; ++m) {
                const int row = row0 + ai * HALF + m * 16; const float rs = rstd_of(rowss[row]);
#pragma unroll
                for (int bj = 0; bj < 2; ++bj) {
                    const f32x4 v0 = acc[ai][bj][m][0] * rs, v1 = acc[ai][bj][m][1] * rs;
                    u32x4 w; w.x = cvt_pk_bf16(v0[0], v0[1]); w.y = cvt_pk_bf16(v0[2], v0[3]); w.z = cvt_pk_bf16(v1[0], v1[1]); w.w = cvt_pk_bf16(v1[2], v1[3]);
                    *(u32x4*)(O + (size_t)row * ldc + col0 + bj * HALF) = w;
                }
            }
    }
};

struct EpiFilt {
    static constexpr bool PERM = false, AFTER_DRAIN = false;
    bf16_t* Ff; bf16_t* Fb0; bf16_t* Fb1;
    __device__ __forceinline__ void operator()(const f32x4 (&acc)[2][2][4][2], const Unit& u, int wr, int wc, int fr, int fq) const {
        const int row0 = u.pm * BM + wr * 64 + fr, col0 = u.pn * BM + wc * 32 + 4 * fq;
        const float dmin = -3.0701134573253945f, dmax = -15.350567286626973f;
#pragma unroll
        for (int ai = 0; ai < 2; ++ai)
#pragma unroll
            for (int m = 0; m < 4; ++m) {
                const int cc = row0 + ai * HALF + m * 16, c = cc & 1023;
                const float del = __builtin_fabsf(dmin + (float)c * ((dmax - dmin) / 1023.0f)) * (1.0f / 8191.0f);
                bf16_t* dst = cc < 1024 ? Ff + (size_t)c * 8192 : (c < 768 ? Fb0 + (size_t)c * 8192 : Fb1 + (size_t)(c - 768) * 8192);
#pragma unroll
                for (int bj = 0; bj < 2; ++bj)
#pragma unroll
                    for (int n = 0; n < 2; ++n) {
                        const int i = col0 + bj * HALF + n * 16; f32x4 v = acc[ai][bj][m][n];
#pragma unroll
                        for (int j = 0; j < 4; ++j) v[j] *= __expf(-(float)(i + j) * del);
                        { u32x2 w; w.x = cvt_pk_bf16(v[0], v[1]); w.y = cvt_pk_bf16(v[2], v[3]); *(u32x2*)(dst + i) = w; }
                    }
            }
    }
};

struct EpiFinal {
    static constexpr bool PERM = false, AFTER_DRAIN = false;
    const bf16_t* base16; float* out; float* rowss; unsigned* cnt; const float* g; float scale;
    __device__ __forceinline__ void operator()(f32x4 (&acc)[2][2][4][2], const Unit& u, int wr, int wc, int fr, int fq) const {
        const int row0 = u.pm * BM + wr * 64 + fr, col0 = u.pn * BM + wc * 32 + 4 * fq;
#pragma unroll
        for (int ai = 0; ai < 2; ++ai)
#pragma unroll
            for (int m = 0; m < 4; ++m) {
                const int row = row0 + ai * HALF + m * 16; float ss = 0.f;
#pragma unroll
                for (int bj = 0; bj < 2; ++bj)
#pragma unroll
                    for (int n = 0; n < 2; ++n) {
                        const size_t off = (size_t)row * 2048 + col0 + bj * HALF + n * 16;
                        const u32x2 r = *(const u32x2*)(base16 + off);
                        const f32x4 v = (f32x4){__builtin_bit_cast(float, r.x << 16), __builtin_bit_cast(float, r.x & 0xffff0000u), __builtin_bit_cast(float, r.y << 16), __builtin_bit_cast(float, r.y & 0xffff0000u)} + acc[ai][bj][m][n] * scale;
                        acc[ai][bj][m][n] = v; ss += (v[0] * v[0] + v[1] * v[1]) + (v[2] * v[2] + v[3] * v[3]);
                    }
                ss += __shfl_xor(ss, 16); ss += __shfl_xor(ss, 32);
                if (fq == 0) atomicAdd(rowss + row, ss);
            }
        asm volatile("s_waitcnt vmcnt(0)" ::: "memory");
        __syncthreads();
        if (threadIdx.x == 0) {
            unsigned* c = cnt + 64 * u.pm;
            __builtin_amdgcn_fence(__ATOMIC_RELEASE, "agent"); asm volatile("s_waitcnt vmcnt(0)" ::: "memory");
            __hip_atomic_fetch_add(c, 1u, __ATOMIC_RELAXED, __HIP_MEMORY_SCOPE_AGENT);
            unsigned spins = 0;
            while (__hip_atomic_load(c, __ATOMIC_RELAXED, __HIP_MEMORY_SCOPE_AGENT) < 8u) { __builtin_amdgcn_s_sleep(2); if (++spins > (1u << 22)) break; }
            __builtin_amdgcn_fence(__ATOMIC_ACQUIRE, "agent"); asm volatile("s_waitcnt vmcnt(0)" ::: "memory");
        }
        __syncthreads();
#pragma unroll
        for (int ai = 0; ai < 2; ++ai)
#pragma unroll
            for (int m = 0; m < 4; ++m) {
                const int row = row0 + ai * HALF + m * 16; const float rs = rstd_of(__hip_atomic_load(rowss + row, __ATOMIC_RELAXED, __HIP_MEMORY_SCOPE_AGENT));
#pragma unroll
                for (int bj = 0; bj < 2; ++bj)
#pragma unroll
                    for (int n = 0; n < 2; ++n) {
                        const int col = col0 + bj * HALF + n * 16; const f32x4 gg = *(const f32x4*)(g + col);
                        *(f32x4*)(out + (size_t)row * 2048 + col) = acc[ai][bj][m][n] * rs * gg;
                    }
            }
    }
};
template <class Epi, class Sched, bool ALIGN_EPI = false, bool SP2 = false>
__device__ __forceinline__ void gemm_phase(PG8_LAS unsigned char* lds, const Gemm g, const Sched& S, const Epi& E) {
    int tid_ = threadIdx.x; asm volatile("" : "+v"(tid_));
    const int tid = tid_, wid = __builtin_amdgcn_readfirstlane(tid >> 6), lane = tid & 63, wr = wid >> 2, wc = wid & 3, fr = lane & 15, fq = lane >> 4;
    const int K = g.K, nt = K / BK;
    unsigned voffA[2], voffB[2];
#pragma unroll
    for (int i = 0; i < 2; ++i) { int R, C; stage_rc(tid * 16 + i * 8192, R, C); const int Rb = Epi::PERM ? ((R & ~31) + perm32(R & 31)) : R;
        voffA[i] = (unsigned)(R * K + C) * 2u; voffB[i] = (unsigned)(Rb * K + C) * 2u; }
    const size_t kstep = (size_t)(BK * 2);
    const size_t hstep = (size_t)HALF * K * 2;
    const size_t tstep = 2 * hstep;
    const unsigned ldsw = (unsigned)wid * 1024u;
    const int aoff = lds_byte(wr * 64 + fr, fq * 8), boff = lds_byte(wc * 32 + fr, fq * 8);
#define PG8_SA(b, h) (((b) * 2 + (h)) * HTB)
#define PG8_SB(b, h) ((4 + (b) * 2 + (h)) * HTB)
#define PG8_STAGE(bufoff, gbase, voff) do { _Pragma("unroll") for (int _i = 0; _i < 2; ++_i) \
        __builtin_amdgcn_global_load_lds((const unsigned*)((const char*)(gbase) + (voff)[_i]), (PG8_LAS unsigned*)(lds + (bufoff) + ldsw + _i * 8192), 16, 0, 0); } while (0)
#define PG8_LDA(dst, b, h) do { _Pragma("unroll") for (int m = 0; m < 4; ++m) _Pragma("unroll") for (int k = 0; k < 2; ++k) dst[m][k] = *(const PG8_LAS bf16x8*)(lds + PG8_SA(b, h) + aoff + m * 2048 + k * 1024); } while (0)
#define PG8_LDB(dst, b, h) do { _Pragma("unroll") for (int n = 0; n < 2; ++n) _Pragma("unroll") for (int k = 0; k < 2; ++k) dst[n][k] = *(const PG8_LAS bf16x8*)(lds + PG8_SB(b, h) + boff + n * 2048 + k * 1024); } while (0)
#define PG8_MMA(ai, bj, At, Bt) do { __builtin_amdgcn_s_setprio(1); _Pragma("unroll") for (int m = 0; m < 4; ++m) _Pragma("unroll") for (int n = 0; n < 2; ++n) _Pragma("unroll") for (int k = 0; k < 2; ++k) \
        acc[ai][bj][m][n] = __builtin_amdgcn_mfma_f32_16x16x32_bf16(Bt[n][k], At[m][k], acc[ai][bj][m][n], 0, 0, 0); __builtin_amdgcn_s_setprio(0); } while (0)
#define PG8_WAIT_V(n) asm volatile("s_waitcnt vmcnt(" #n ")" ::: "memory")
#define PG8_WAIT_L(n) asm volatile("s_waitcnt lgkmcnt(" #n ")" ::: "memory")
#define PG8_BAR __builtin_amdgcn_s_barrier()
#define PG8_SCHED __builtin_amdgcn_sched_barrier(0)
    Unit cur, nxt; int ui = 0;
    if (!S.next(0, cur)) return;
    f32x4 acc[2][2][4][2];
#pragma unroll
    for (int a = 0; a < 2; ++a)
#pragma unroll
        for (int b = 0; b < 2; ++b)
#pragma unroll
            for (int m = 0; m < 4; ++m)
#pragma unroll
                for (int n = 0; n < 2; ++n) acc[a][b][m][n] = (f32x4){0.f, 0.f, 0.f, 0.f};
    bf16x8 At[4][2], B0[2][2], B1[2][2];
    const char* cA = (const char*)g.A + (size_t)cur.pm * tstep; const char* cB = (const char*)g.Bt + (size_t)cur.pn * tstep;
    S.a_ready(cur);
    if constexpr (SP2) {
        PG8_STAGE(PG8_SB(0, 0), cB, voffB); PG8_STAGE(PG8_SB(0, 1), cB + hstep, voffB); PG8_STAGE(PG8_SA(0, 0), cA, voffA); PG8_STAGE(PG8_SA(0, 1), cA + hstep, voffA);
        if (wr == 1) PG8_BAR;
        PG8_WAIT_V(2); PG8_BAR;
        PG8_STAGE(PG8_SB(1, 0), cB + kstep, voffB); PG8_STAGE(PG8_SA(1, 0), cA + kstep, voffA); PG8_STAGE(PG8_SB(1, 1), cB + hstep + kstep, voffB);
        PG8_WAIT_V(6); PG8_BAR;
    } else {
        PG8_STAGE(PG8_SB(0, 0), cB, voffB); PG8_STAGE(PG8_SA(0, 0), cA, voffA); PG8_STAGE(PG8_SB(0, 1), cB + hstep, voffB); PG8_STAGE(PG8_SA(0, 1), cA + hstep, voffA);
        if (wr == 1) PG8_BAR;
        PG8_WAIT_V(4); PG8_BAR;
        PG8_STAGE(PG8_SB(1, 0), cB + kstep, voffB); PG8_STAGE(PG8_SA(1, 0), cA + kstep, voffA); PG8_STAGE(PG8_SB(1, 1), cB + hstep + kstep, voffB);
        PG8_WAIT_V(6); PG8_BAR;
    }
    for (;;) {
        const bool has_next = S.next(ui + 1, nxt);
        const char* nA = has_next ? (const char*)g.A + (size_t)nxt.pm * tstep : cA; const char* nB = has_next ? (const char*)g.Bt + (size_t)nxt.pn * tstep : cB;
        for (int t = 0; t < nt; t += 2) {
            const bool last = (t == nt - 2);
            const char* a1 = cA + (size_t)(t + 1) * kstep;
            const char* a2 = last ? nA : cA + (size_t)(t + 2) * kstep; const char* b2 = last ? nB : cB + (size_t)(t + 2) * kstep;
            const char* a3 = a2 + kstep; const char* b3 = b2 + kstep;
            if (last && has_next) S.a_ready(nxt);
            if constexpr (SP2) {
            PG8_LDB(B0, 0, 0); PG8_LDB(B1, 0, 1); PG8_SCHED; PG8_LDA(At, 0, 0); PG8_STAGE(PG8_SA(1, 1), a1 + hstep, voffA);
            PG8_WAIT_V(8); PG8_WAIT_L(0); PG8_BAR; PG8_MMA(0, 0, At, B0); PG8_MMA(0, 1, At, B1); PG8_BAR; PG8_SCHED;
            PG8_LDA(At, 0, 1); PG8_STAGE(PG8_SB(0, 0), b2, voffB); PG8_STAGE(PG8_SB(0, 1), b2 + hstep, voffB); PG8_STAGE(PG8_SA(0, 0), a2, voffA);
            PG8_WAIT_V(8); PG8_WAIT_L(0); PG8_BAR; PG8_MMA(1, 0, At, B0); PG8_MMA(1, 1, At, B1); PG8_BAR; PG8_SCHED;
            PG8_LDB(B0, 1, 0); PG8_LDB(B1, 1, 1); PG8_SCHED; PG8_LDA(At, 1, 0); PG8_STAGE(PG8_SA(0, 1), a2 + hstep, voffA);
            PG8_WAIT_V(8); PG8_WAIT_L(0); PG8_BAR; PG8_MMA(0, 0, At, B0); PG8_MMA(0, 1, At, B1); PG8_BAR; PG8_SCHED;
            PG8_LDA(At, 1, 1); PG8_STAGE(PG8_SB(1, 0), b3, voffB); PG8_STAGE(PG8_SB(1, 1), b3 + hstep, voffB); PG8_STAGE(PG8_SA(1, 0), a3, voffA);
            PG8_WAIT_V(8); PG8_WAIT_L(0); PG8_BAR; PG8_MMA(1, 0, At, B0); PG8_MMA(1, 1, At, B1); PG8_BAR; PG8_SCHED;
            } else {
            PG8_LDB(B0, 0, 0); PG8_SCHED; PG8_LDA(At, 0, 0); PG8_STAGE(PG8_SA(1, 1), a1 + hstep, voffA);
            PG8_WAIT_L(8); PG8_BAR; PG8_WAIT_L(0); PG8_MMA(0, 0, At, B0); PG8_BAR; PG8_SCHED;
            PG8_LDB(B1, 0, 1); PG8_STAGE(PG8_SB(0, 0), b2, voffB);
            PG8_BAR; PG8_WAIT_L(0); PG8_MMA(0, 1, At, B1); PG8_BAR;
            PG8_LDA(At, 0, 1); PG8_STAGE(PG8_SA(0, 0), a2, voffA);
            PG8_BAR; PG8_WAIT_L(0); PG8_MMA(1, 0, At, B0); PG8_BAR; PG8_SCHED;
            PG8_STAGE(PG8_SB(0, 1), b2 + hstep, voffB);
            PG8_WAIT_V(6); PG8_BAR; PG8_MMA(1, 1, At, B1); PG8_BAR;
            PG8_LDB(B0, 1, 0); PG8_SCHED; PG8_LDA(At, 1, 0); PG8_STAGE(PG8_SA(0, 1), a2 + hstep, voffA);
            PG8_WAIT_L(8); PG8_BAR; PG8_WAIT_L(0); PG8_MMA(0, 0, At, B0); PG8_BAR; PG8_SCHED;
            PG8_LDB(B1, 1, 1); PG8_STAGE(PG8_SB(1, 0), b3, voffB);
            PG8_BAR; PG8_WAIT_L(0); PG8_MMA(0, 1, At, B1); PG8_BAR;
            PG8_LDA(At, 1, 1); PG8_STAGE(PG8_SA(1, 0), a3, voffA);
            PG8_BAR; PG8_WAIT_L(0); PG8_MMA(1, 0, At, B0); PG8_BAR; PG8_SCHED;
            PG8_STAGE(PG8_SB(1, 1), b3 + hstep, voffB);
            PG8_WAIT_V(6); PG8_BAR; PG8_MMA(1, 1, At, B1); PG8_BAR;
            }
        }
        if constexpr (ALIGN_EPI) { if (wr == 0) PG8_BAR; }
        if constexpr (!Epi::AFTER_DRAIN) { E(acc, cur, wr, wc, fr, fq); S.done(cur); }
        if (!has_next) break;
#pragma unroll
        for (int a = 0; a < 2; ++a)
#pragma unroll
            for (int b = 0; b < 2; ++b)
#pragma unroll
                for (int m = 0; m < 4; ++m)
#pragma unroll
                    for (int n = 0; n < 2; ++n) acc[a][b][m][n] = (f32x4){0.f, 0.f, 0.f, 0.f};
        cur = nxt; cA = nA; cB = nB; ++ui;
        if constexpr (ALIGN_EPI) { if (wr == 1) PG8_BAR; }
    }
    PG8_WAIT_V(0);
    if constexpr (!ALIGN_EPI) { if (wr == 0) PG8_BAR; }
    PG8_BAR;
    if constexpr (Epi::AFTER_DRAIN) { E.fused(acc, cur, wr, wc, fr, fq, lds, wid, lane); S.done(cur); }
#undef PG8_SA
#undef PG8_SB
#undef PG8_STAGE
#undef PG8_LDA
#undef PG8_LDB
#undef PG8_MMA
#undef PG8_WAIT_V
#undef PG8_WAIT_L
#undef PG8_BAR
#undef PG8_SCHED
}
}
using pg8::silu_f;

constexpr int L = 8192, DM = 2048, FF = 5632, NIN = 6176, NING = 6144, HYW = 1024;
constexpr int PHY_LD = 3072, PR_LD = 3072;
constexpr int PR_Q = 0, PR_K = 512, PR_V = 1024, PR_R = 2048;
constexpr int NT = 512;
constexpr int LDS_BYTES = 147456;
constexpr int FN = 16384;

constexpr size_t MiB = 1u << 20;
constexpr size_t WS_ROWSS = 0;
constexpr size_t WS_DEC = 128 * 1024;
constexpr size_t WS_PCNT = 640 * 1024 + 16384;
constexpr size_t WS_BAR = 640 * 1024;
constexpr size_t WS_W4T = 1 * MiB;
constexpr size_t WS_HID = 2 * MiB;
constexpr size_t WS_SK = 6 * MiB;
constexpr size_t SK_STRIDE = 8448;
constexpr size_t WS_WFF = 39 * MiB;
constexpr size_t WS_WDN = WS_WFF + 44 * MiB;
constexpr size_t WS_ST = WS_WFF;
constexpr size_t WS_WIN = 105 * MiB;
constexpr size_t WS_WOUT = 130 * MiB;
constexpr size_t WS_XB = 138 * MiB;
constexpr size_t WS_A = 170 * MiB;
constexpr size_t WS_ZT = WS_A;
constexpr size_t WS_X0T = WS_A + 32 * MiB;
constexpr size_t WS_PHY = 258 * MiB;
constexpr size_t WS_MIX = WS_PHY;
constexpr size_t WS_PR = 306 * MiB;
constexpr size_t WS_LR = WS_PR + 48 * MiB;
constexpr size_t WS_T0 = WS_PR + 49 * MiB;
constexpr size_t WS_END = 358 * MiB;

typedef unsigned short bf16_t;
typedef short bf16x8 __attribute__((ext_vector_type(8)));
typedef float f32x4 __attribute__((ext_vector_type(4)));
typedef unsigned u32x4 __attribute__((ext_vector_type(4)));
typedef unsigned u32x2 __attribute__((ext_vector_type(2)));
#define LAS __attribute__((address_space(3)))
typedef float c2 __attribute__((ext_vector_type(2)));
__device__ __forceinline__ c2 mk2(float a, float b) { return (c2){a, b}; }
#define LDS_WAIT() asm volatile("s_waitcnt lgkmcnt(0)" ::: "memory")

__device__ __forceinline__ unsigned f2bf(float f) { unsigned u = __builtin_bit_cast(unsigned, f); return (u + 0x7fffu + ((u >> 16) & 1u)) >> 16; }
__device__ __forceinline__ unsigned pk2(float lo, float hi) { return f2bf(lo) | (f2bf(hi) << 16); }
__device__ __forceinline__ float bf2f(unsigned h) { return __builtin_bit_cast(float, h << 16); }
__device__ __forceinline__ float wave_sum(float v) {
#pragma unroll
    for (int o = 1; o < 64; o <<= 1) v += __shfl_xor(v, o);
    return v;
}

struct Params {
    const float* in[32];
    float* out;
    unsigned char* ws;
};

__device__ __forceinline__ void transpose_item(const float* __restrict__ W, int K, int N, bf16_t* __restrict__ WT, int mode, const float* __restrict__ gain, LAS float* scr, int item, int lane) {
    const int nblk = N / 32, kb = item / nblk, nb = item % nblk, k0 = 64 * kb, n0 = 32 * nb;
    const int drow0 = mode == 0 ? n0 : (256 * (n0 >> 7) + (n0 & 127) + (mode == 2 ? 128 : 0));
    const int c = lane & 7;
    f32x4 g0 = (f32x4){1.f, 1.f, 1.f, 1.f}, g1 = g0;
    if (gain) { g0 = *(const f32x4*)(gain + k0 + 8 * c); g1 = *(const f32x4*)(gain + k0 + 8 * c + 4); }
    float v[32];
    const float* wp = W + (size_t)(k0 + (lane >> 5)) * N + n0 + (lane & 31);
#pragma unroll
    for (int i = 0; i < 32; ++i) v[i] = __builtin_nontemporal_load(wp + (size_t)(2 * i) * N);
#pragma unroll
    for (int i = 0; i < 32; ++i) scr[(2 * i + (lane >> 5)) * 33 + (lane & 31)] = v[i];
    LDS_WAIT(); asm volatile("" ::: "memory");
#pragma unroll
    for (int j = 0; j < 4; ++j) { const int n = (lane >> 3) + 8 * j; const LAS float* s = scr + (8 * c) * 33 + n;
        u32x4 o; o.x = pk2(s[0 * 33] * g0[0], s[1 * 33] * g0[1]); o.y = pk2(s[2 * 33] * g0[2], s[3 * 33] * g0[3]); o.z = pk2(s[4 * 33] * g1[0], s[5 * 33] * g1[1]); o.w = pk2(s[6 * 33] * g1[2], s[7 * 33] * g1[3]);
        *(u32x4*)(WT + (size_t)(drow0 + n) * K + k0 + 8 * c) = o; }
    LDS_WAIT(); asm volatile("" ::: "memory");
}
constexpr int IT_FF = (DM / 64) * (FF / 32);
__device__ __forceinline__ void convert_gu(const float* wg, const float* wu, const float* gain, unsigned char* ws, LAS unsigned char* lds, int gw, int ngw, int lane, int wave) {
    LAS float* scr = (LAS float*)(lds + wave * 8448); bf16_t* WGU = (bf16_t*)(ws + WS_WFF);
#pragma unroll 1
    for (int it = gw; it < 2 * IT_FF; it += ngw) { if (it < IT_FF) transpose_item(wg, DM, FF, WGU, 1, gain, scr, it, lane); else transpose_item(wu, DM, FF, WGU, 2, gain, scr, it - IT_FF, lane); }
}
__device__ __forceinline__ void convert_dn(const float* wd, unsigned char* ws, LAS unsigned char* lds, int gw, int ngw, int lane, int wave) {
    LAS float* scr = (LAS float*)(lds + wave * 8448); bf16_t* WDN = (bf16_t*)(ws + WS_WDN);
#pragma unroll 1
    for (int it = gw; it < IT_FF; it += ngw) transpose_item(wd, FF, DM, WDN, 0, nullptr, scr, it, lane);
}
__device__ __forceinline__ void convert_tail1(const Params& p, LAS unsigned char* lds, int gw, int ngw, int lane, int wave) {
    LAS float* scr = (LAS float*)(lds + wave * 8448); unsigned char* ws = p.ws;
    constexpr int IT_IN = (DM / 64) * (NIN / 32), IT_OUT = (DM / 64) * (DM / 32);
#pragma unroll 1
    for (int it = gw; it < IT_FF + IT_IN + IT_OUT; it += ngw) {
        if (it < IT_FF) transpose_item(p.in[4], FF, DM, (bf16_t*)(ws + WS_WDN), 0, nullptr, scr, it, lane);
        else if (it < IT_FF + IT_IN) transpose_item(p.in[6], DM, NIN, (bf16_t*)(ws + WS_WIN), 0, p.in[5], scr, it - IT_FF, lane);
        else transpose_item(p.in[26], DM, DM, (bf16_t*)(ws + WS_WOUT), 0, nullptr, scr, it - IT_FF - IT_IN, lane);
    }
}
__device__ __forceinline__ void hid_pass(const Params& p, LAS float* sm, const LAS float* WL, int pos0, int tid) {
    const float* b1 = p.in[10]; const float* f1 = p.in[11]; const float* b2 = p.in[13]; const float* f2 = p.in[14]; const float* b3 = p.in[16]; const float* f3 = p.in[17];
    bf16_t* hidx = (bf16_t*)(p.ws + WS_HID);
    const int pp = tid >> 6, j = tid & 63, pos = pos0 + pp;
    LAS float* Z = sm; LAS float* H1 = sm + 512; LAS float* H2 = sm + 1024;
    const LAS float* w1 = WL; const LAS float* w2 = WL + 33 * 64; const LAS float* w3 = w2 + 64 * 64;
    if (j < 33) {
        float z;
        if (j == 0) z = (float)pos / 8191.0f;
        else {
            const int b = (j - 1) & 15; const float fj = 1e-4f + (float)b * ((15.0f - 1e-4f) / 15.0f);
            const double r = (double)pos * (double)fj * (1.0 / 8192.0); const float fr = (float)(r - floor(r));
            float s, c; sincospif(2.0f * fr, &s, &c);
            z = (j <= 16) ? c : -s;
        }
        Z[pp * 40 + j] = z;
    }
    __syncthreads();
    float a, a0 = b1[j] + Z[pp * 40 + 32] * w1[32 * 64 + j], a1 = 0.f, a2 = 0.f, a3 = 0.f;
#pragma unroll
    for (int k4 = 0; k4 < 8; ++k4) { const f32x4 h = *(const LAS f32x4*)(Z + pp * 40 + 4 * k4);
        a0 += h[0] * w1[(4 * k4 + 0) * 64 + j]; a1 += h[1] * w1[(4 * k4 + 1) * 64 + j]; a2 += h[2] * w1[(4 * k4 + 2) * 64 + j]; a3 += h[3] * w1[(4 * k4 + 3) * 64 + j]; }
    a = (a0 + a1) + (a2 + a3);
    H1[pp * 64 + j] = sinf(f1[j] * a);
    __syncthreads();
    a0 = b2[j]; a1 = 0.f; a2 = 0.f; a3 = 0.f;
#pragma unroll
    for (int k4 = 0; k4 < 16; ++k4) { const f32x4 h = *(const LAS f32x4*)(H1 + pp * 64 + 4 * k4);
        a0 += h[0] * w2[(4 * k4 + 0) * 64 + j]; a1 += h[1] * w2[(4 * k4 + 1) * 64 + j]; a2 += h[2] * w2[(4 * k4 + 2) * 64 + j]; a3 += h[3] * w2[(4 * k4 + 3) * 64 + j]; }
    a = (a0 + a1) + (a2 + a3);
    H2[pp * 64 + j] = sinf(f2[j] * a);
    __syncthreads();
    a0 = b3[j]; a1 = 0.f; a2 = 0.f; a3 = 0.f;
#pragma unroll
    for (int k4 = 0; k4 < 16; ++k4) { const f32x4 h = *(const LAS f32x4*)(H2 + pp * 64 + 4 * k4);
        a0 += h[0] * w3[(4 * k4 + 0) * 64 + j]; a1 += h[1] * w3[(4 * k4 + 1) * 64 + j]; a2 += h[2] * w3[(4 * k4 + 2) * 64 + j]; a3 += h[3] * w3[(4 * k4 + 3) * 64 + j]; }
    a = (a0 + a1) + (a2 + a3);
    { const float h3 = sinf(f3[j] * a); const unsigned hi = f2bf(h3); bf16_t* hr = hidx + (size_t)pos * 256 + j; hr[0] = (bf16_t)hi; hr[64] = (bf16_t)f2bf(h3 - bf2f(hi)); hr[128] = (bf16_t)hi; hr[192] = 0; }
}
__device__ __forceinline__ void phase0(const Params& p, LAS unsigned char* lds, int tid, int lane, int wave, int mask) {
    const int G = gridDim.x, gw = blockIdx.x * 8 + wave, ngw = G * 8;
    unsigned char* ws = p.ws;
    if (mask & 1) convert_gu(p.in[2], p.in[3], p.in[1], ws, lds, gw, ngw, lane, wave);
    const int gt = blockIdx.x * NT + tid, ngt = G * NT;
    {
      float* rs = (float*)(ws + WS_ROWSS) + L; for (int i = gt; i < 3 * L; i += ngt) rs[i] = 0.f; }
    { const float* w4 = p.in[18]; bf16_t* tx = (bf16_t*)(ws + WS_W4T);
      for (int i = gt; i < 2048 * 64; i += ngt) { const int c = i >> 6, k = i & 63; const float v = w4[k * 2048 + c]; const unsigned hi = f2bf(v); bf16_t* tr = tx + (size_t)c * 256 + k; tr[0] = (bf16_t)hi; tr[64] = (bf16_t)hi; tr[128] = (bf16_t)f2bf(v - bf2f(hi)); tr[192] = 0; } }
    if (mask & 4) {
        const float* x = p.in[0]; bf16_t* xb = (bf16_t*)(ws + WS_XB); float* rs = (float*)(ws + WS_ROWSS);
#pragma unroll 1
        for (int m = gw; m < L; m += ngw) {
            const f32x4* xr = (const f32x4*)(x + (size_t)m * DM) + lane; u32x2* o = (u32x2*)(xb + (size_t)m * DM) + lane; float s = 0.f;
#pragma unroll
            for (int j = 0; j < 8; ++j) { const f32x4 v = __builtin_nontemporal_load(xr + 64 * j); s += (v[0] * v[0] + v[1] * v[1]) + (v[2] * v[2] + v[3] * v[3]);
                u32x2 w; w.x = pk2(v[0], v[1]); w.y = pk2(v[2], v[3]); o[64 * j] = w; }
            s = wave_sum(s); if (lane == 0) rs[m] = s;
        }
    }
    __syncthreads();
    if (mask & 8) { LAS float* WL = (LAS float*)lds + 2048;
      for (int i = tid; i < 33 * 64; i += NT) WL[i] = p.in[9][i];
      for (int i = tid; i < 64 * 64; i += NT) { WL[33 * 64 + i] = p.in[12][i]; WL[33 * 64 + 64 * 64 + i] = p.in[15][i]; }
      __syncthreads();
#pragma unroll 1
      for (int ps = blockIdx.x; ps < L / 8; ps += G) { hid_pass(p, (LAS float*)lds, WL, ps * 8, tid); __syncthreads(); } }
}

__device__ __forceinline__ void convT_fetch(const bf16_t* phy, int tile, int tid, u32x4 (&rw)[4]) {
    const int t0 = (tile >> 4) * 64, c0 = (tile & 15) * 64;
#pragma unroll
    for (int k = 0; k < 4; ++k) { const int idx = tid + NT * k; rw[k] = (u32x4){0u, 0u, 0u, 0u};
        if (idx < 3 * 66 * 8) { const int s = idx / 528, r = (idx % 528) >> 3, c8 = (idx & 7) * 8, tt = t0 - 1 + r;
            if (tt >= 0 && tt < L) rw[k] = *(const u32x4*)(phy + (size_t)tt * PHY_LD + s * HYW + c0 + c8); } }
}
__device__ __forceinline__ void convT_tile(const Params& p, LAS unsigned char* lds, int tile, int tid, const u32x4 (&rw)[4]) {
    bf16_t* zT = (bf16_t*)(p.ws + WS_ZT); bf16_t* x0T = (bf16_t*)(p.ws + WS_X0T);
    const float* cw = p.in[7]; const float* cb = p.in[8];
    LAS float* zt = (LAS float*)lds; LAS float* xt = zt + 64 * 65;
    LAS bf16_t* raw = (LAS bf16_t*)(lds + 33280);
    const int t0 = (tile >> 4) * 64, c0 = (tile & 15) * 64;
#pragma unroll
    for (int k = 0; k < 4; ++k) { const int idx = tid + NT * k; if (idx < 3 * 66 * 8) { const int s = idx / 528, r = (idx % 528) >> 3, c8 = (idx & 7) * 8; *(LAS u32x4*)(raw + (s * 66 + r) * 64 + c8) = rw[k]; } }
    const int c = tid & 63, tg = tid >> 6;
    float w[3][3], b[3];
#pragma unroll
    for (int s = 0; s < 3; ++s) { const int col = s * HYW + c0 + c; b[s] = cb[col];
#pragma unroll
        for (int tap = 0; tap < 3; ++tap) w[s][tap] = cw[tap * 3 * HYW + col]; }
    __syncthreads();
#pragma unroll
    for (int i = 0; i < 8; ++i) {
        const int tl = tg * 8 + i; float u[3];
#pragma unroll
        for (int s = 0; s < 3; ++s) { float a = b[s];
#pragma unroll
            for (int tap = 0; tap < 3; ++tap) a += w[s][tap] * bf2f(raw[(s * 66 + tl + tap) * 64 + c]);
            u[s] = a; }
        zt[c * 65 + tl] = u[2] * u[1]; xt[c * 65 + tl] = u[0];
    }
    __syncthreads();
    { const int t = tid & 63, cg8 = tid >> 6;
#pragma unroll
      for (int i = 0; i < 8; ++i) { const int cc = cg8 * 8 + i; zT[(size_t)(c0 + cc) * L + t0 + t] = (bf16_t)f2bf(zt[cc * 65 + t]); x0T[(size_t)(c0 + cc) * L + t0 + t] = (bf16_t)f2bf(xt[cc * 65 + t]); } }
    __syncthreads();
}

__device__ __forceinline__ float logsig16(float x) { return (fminf(x, 0.f) - __logf(1.0f + __expf(-fabsf(x)))) * (1.0f / 16.0f); }
__device__ __forceinline__ bf16x8 ldfrag(const LAS bf16_t* base, int ld, int row0, int k0, int lane) { return *(const LAS bf16x8*)(base + (row0 + (lane & 15)) * ld + k0 + 8 * (lane >> 4)); }

__device__ __forceinline__ void gla_stage(const bf16_t* pr, const float* lr, int t0, int h, LAS float* lrs, LAS bf16_t* vT, int tid) {
    *(LAS f32x4*)(lrs + tid * 4) = *(const f32x4*)(lr + (size_t)t0 * 32 + tid * 4);
    { const int c = tid & 255, tb = tid >> 8; const bf16_t* vp = pr + (size_t)t0 * PR_LD + PR_V + h * 256 + c;
#pragma unroll
      for (int i = 0; i < 4; ++i) { const int tk = (tb * 4 + i) * 8; unsigned short e[8];
#pragma unroll
          for (int j = 0; j < 8; ++j) e[j] = vp[(size_t)(tk + j) * PR_LD];
          u32x4 w; w.x = e[0] | ((unsigned)e[1] << 16); w.y = e[2] | ((unsigned)e[3] << 16); w.z = e[4] | ((unsigned)e[5] << 16); w.w = e[6] | ((unsigned)e[7] << 16);
          *(LAS u32x4*)(vT + c * 72 + tk) = w; } }
}
struct GateW { float w[16]; float b; };
__device__ __forceinline__ void gate_load(const Params& p, int dir, int h, int d, GateW& g) {
    const float* wa = dir ? p.in[23] : p.in[21]; const float* ba = dir ? p.in[24] : p.in[22];
#pragma unroll
    for (int r = 0; r < 16; ++r) g.w[r] = wa[r * 512 + h * 128 + d];
    g.b = ba[h * 128 + d];
}
__device__ __forceinline__ float gate_eval(const GateW& g, const LAS float* lr) {
    const LAS f32x4* l4 = (const LAS f32x4*)lr; const f32x4 a = l4[0], b = l4[1], c = l4[2], d = l4[3];
    float x0 = g.b, x1 = 0.f, x2 = 0.f, x3 = 0.f;
#pragma unroll
    for (int r = 0; r < 4; ++r) { x0 += a[r] * g.w[r]; x1 += b[r] * g.w[4 + r]; x2 += c[r] * g.w[8 + r]; x3 += d[r] * g.w[12 + r]; }
    return logsig16((x0 + x1) + (x2 + x3));
}

__device__ __forceinline__ void gla_kv_item(const Params& p, LAS unsigned char* lds, int item, int tid, int lane, int wave) {
    const int h = item & 3, n = item >> 2, t0 = n * 64;
    const bf16_t* pr = (const bf16_t*)(p.ws + WS_PR); bf16_t* ST = (bf16_t*)(p.ws + WS_ST); float* dec = (float*)(p.ws + WS_DEC);
    LAS bf16_t* vT = (LAS bf16_t*)lds; LAS bf16_t* kstT = (LAS bf16_t*)(lds + 36864);
    LAS float* lrs = (LAS float*)(lds + 73728); LAS float* tot = (LAS float*)(lds + 81920);
    gla_stage(pr, (const float*)(p.ws + WS_LR), t0, h, lrs, vT, tid);
    const int d = tid & 127, dir = (tid >> 7) & 1, half = tid >> 8;
    GateW gw; gate_load(p, dir, h, d, gw);
    const bf16_t* kp = pr + (size_t)t0 * PR_LD + PR_K + h * 128 + d;
    unsigned short kr[8];
#pragma unroll
    for (int u = 0; u < 8; ++u) { const int q = half * 32 + u, t = dir ? 63 - q : q; kr[u] = kp[(size_t)t * PR_LD]; }
    __syncthreads();
    {
        float b = 0.f;
#pragma unroll 1
        for (int sg = 0; sg < 4; ++sg) {
            unsigned short kn[8];
#pragma unroll
            for (int u = 0; u < 8; ++u) { const int q = half * 32 + ((sg * 8 + 8 + u) & 31), t = dir ? 63 - q : q; kn[u] = kp[(size_t)t * PR_LD]; }
            unsigned ke[8];
#pragma unroll
            for (int u = 0; u < 8; ++u) { const int q = half * 32 + sg * 8 + u, t = dir ? 63 - q : q; b += gate_eval(gw, lrs + t * 32 + dir * 16);
                ke[dir ? 7 - u : u] = f2bf(bf2f(kr[u]) * __expf(-b)); }
            { const int q0 = half * 32 + sg * 8, tlo = dir ? 63 - q0 - 7 : q0; u32x4 w; w.x = ke[0] | (ke[1] << 16); w.y = ke[2] | (ke[3] << 16); w.z = ke[4] | (ke[5] << 16); w.w = ke[6] | (ke[7] << 16);
              *(LAS u32x4*)(kstT + (dir * 128 + d) * 72 + tlo) = w; }
#pragma unroll
            for (int u = 0; u < 8; ++u) kr[u] = kn[u];
        }
        tot[(dir * 2 + half) * 128 + d] = b;
    }
    __syncthreads();
    if (half == 0) { const float T0 = tot[(dir * 2 + 0) * 128 + d]; const size_t ti = ((size_t)(dir * 128 + n) * 4 + h) * 128 + d;
        dec[ti] = __expf(T0 + tot[(dir * 2 + 1) * 128 + d]); ((float*)(p.ws + WS_T0))[ti] = T0; }
    const int q4 = lane >> 4, v0 = wave * 32;
#pragma unroll 1
    for (int dr = 0; dr < 2; ++dr) {
        f32x4 acc[8][2];
#pragma unroll
        for (int mt = 0; mt < 8; ++mt) { acc[mt][0] = (f32x4){0.f, 0.f, 0.f, 0.f}; acc[mt][1] = (f32x4){0.f, 0.f, 0.f, 0.f}; }
#pragma unroll
        for (int ks = 0; ks < 2; ++ks) {
            const bf16x8 b0 = ldfrag(vT, 72, v0, 32 * ks, lane), b1 = ldfrag(vT, 72, v0 + 16, 32 * ks, lane);
#pragma unroll
            for (int mt = 0; mt < 8; ++mt) { const bf16x8 a = ldfrag(kstT + dr * 128 * 72, 72, 16 * mt, 32 * ks, lane);
                acc[mt][0] = __builtin_amdgcn_mfma_f32_16x16x32_bf16(a, b0, acc[mt][0], 0, 0, 0);
                acc[mt][1] = __builtin_amdgcn_mfma_f32_16x16x32_bf16(a, b1, acc[mt][1], 0, 0, 0); }
            if (ks == 0) {
#pragma unroll
                for (int mt = 0; mt < 8; ++mt) { const f32x4 T0 = *(const LAS f32x4*)(tot + (dr * 2 + 0) * 128 + 16 * mt + 4 * q4);
                    f32x4 rt;
#pragma unroll
                    for (int r = 0; r < 4; ++r) rt[r] = __expf(dr ? -T0[r] : T0[r]);
                    acc[mt][0] *= rt; acc[mt][1] *= rt; }
            }
        }
        bf16_t* S = ST + ((size_t)(dr * 4 + h) * 128 + n) * 32768;
#pragma unroll
        for (int mt = 0; mt < 8; ++mt) {
            const f32x4 T0 = *(const LAS f32x4*)(tot + (dr * 2 + 0) * 128 + 16 * mt + 4 * q4), T1 = *(const LAS f32x4*)(tot + (dr * 2 + 1) * 128 + 16 * mt + 4 * q4);
            f32x4 s1;
#pragma unroll
            for (int r = 0; r < 4; ++r) s1[r] = __expf(dr ? T0[r] + T1[r] : T1[r]);
#pragma unroll
            for (int nt = 0; nt < 2; ++nt) { const f32x4 v = acc[mt][nt] * s1; u32x2 w; w.x = pk2(v[0], v[1]); w.y = pk2(v[2], v[3]);
                *(u32x2*)(S + (size_t)(v0 + 16 * nt + (lane & 15)) * 128 + 16 * mt + 4 * q4) = w; }
        }
    }
    __syncthreads();
}

#ifndef REP_FA
#define REP_FA 0
#endif
#ifndef REP_FB
#define REP_FB 0
#endif
__device__ __forceinline__ void lr_task(const Params& p, LAS unsigned char* lds, int task, int tid, int lane, int wave) {
    const bf16_t* xb = (const bf16_t*)(p.ws + WS_XB); const bf16_t* wt = (const bf16_t*)(p.ws + WS_WIN) + (size_t)NING * DM;
    const float* rowss1 = (const float*)(p.ws + WS_ROWSS) + L; float* lr = (float*)(p.ws + WS_LR);
    const int mt = wave >> 2, nt = (wave >> 1) & 1, kh = wave & 1, fr = lane & 15, q4 = lane >> 4, t0 = task * 32;
    const bf16_t* ap = xb + (size_t)(t0 + 16 * mt + fr) * DM + kh * 1024 + 8 * q4; const bf16_t* bp = wt + (size_t)(16 * nt + fr) * DM + kh * 1024 + 8 * q4;
    f32x4 acc = (f32x4){0.f, 0.f, 0.f, 0.f};
#pragma unroll 1
    for (int kb = 0; kb < 2; ++kb) { bf16x8 a[16], b[16];
#pragma unroll
        for (int u = 0; u < 16; ++u) { a[u] = *(const bf16x8*)(ap + (kb * 16 + u) * 32); b[u] = *(const bf16x8*)(bp + (kb * 16 + u) * 32); }
#pragma unroll
        for (int u = 0; u < 16; ++u) acc = __builtin_amdgcn_mfma_f32_16x16x32_bf16(a[u], b[u], acc, 0, 0, 0); }
    LAS f32x4* ex = (LAS f32x4*)lds;
    if (kh) ex[(wave >> 1) * 64 + lane] = acc;
    __syncthreads();
    if (!kh) { const f32x4 o = ex[(wave >> 1) * 64 + lane];
#pragma unroll
        for (int r = 0; r < 4; ++r) { const int t = t0 + 16 * mt + 4 * q4 + r; lr[(size_t)t * 32 + 16 * nt + fr] = (acc[r] + o[r]) * pg8::rstd_of(rowss1[t]); } }
    __syncthreads();
}
__device__ __forceinline__ c2 cmul(c2 a, c2 b) { return mk2(a.x * b.x - a.y * b.y, a.x * b.y + a.y * b.x); }
__device__ __forceinline__ c2 twid(int m) { const float r = (float)m * (1.0f / 16384.0f); return mk2(__builtin_amdgcn_cosf(r), -__builtin_amdgcn_sinf(r)); }
__device__ __forceinline__ c2 cmulc(c2 a, c2 b) { return mk2(a.x * b.x + a.y * b.y, a.y * b.x - a.x * b.y); }
#define XI(i) ((i) + ((i) >> 5))
constexpr int XPAD_BYTES = (FN + FN / 32) * 8;
__constant__ const float C16c[8] = {1.f, 0.9238795325112867f, 0.7071067811865476f, 0.3826834323650898f, 0.f, -0.3826834323650898f, -0.7071067811865476f, -0.9238795325112867f};
__constant__ const float C16s[8] = {0.f, 0.3826834323650898f, 0.7071067811865476f, 0.9238795325112867f, 1.f, 0.9238795325112867f, 0.7071067811865476f, 0.3826834323650898f};
template <int R, bool INV, int UNR> __device__ __forceinline__ void fft_pass(LAS c2* X, int lo, int tid) {
    constexpr int RAD = 1 << R;
    const int stride = 1 << lo, ls = lo + R - 1;
    int tt = tid; asm volatile("" : "+v"(tt));
#pragma unroll 1
    for (int g = tt; g < FN / RAD; g += NT) {
        const int j0 = g & (stride - 1), i = ((g - j0) << R) + j0;
        c2 e[RAD];
#pragma unroll
        for (int q = 0; q < RAD; ++q) e[q] = X[XI(i + q * stride)];
#pragma unroll
        for (int t = 0; t < R; ++t) {
            const int Hq = INV ? (1 << t) : (RAD >> (t + 1));
            const c2 base = twid(j0 << (INV ? (13 - lo - t) : (13 - ls + t)));
#pragma unroll
            for (int bf = 0; bf < RAD / 2; ++bf) {
                const int qm = bf & (Hq - 1), q = ((bf - qm) << 1) + qm, k16 = qm * (8 / Hq);
                const c2 w = (k16 == 0) ? base : cmul(base, mk2(C16c[k16], -C16s[k16]));
                if (!INV) { const c2 a = e[q], b = e[q + Hq]; e[q] = a + b; e[q + Hq] = cmul(a - b, w); }
                else { const c2 a = e[q], b = cmulc(e[q + Hq], w); e[q] = a + b; e[q + Hq] = a - b; }
            }
        }
#pragma unroll
        for (int q = 0; q < RAD; ++q) X[XI(i + q * stride)] = e[q];
    }
    __syncthreads();
}
__device__ __forceinline__ void fft_dif(LAS c2* X, int tid) { fft_pass<4, false, 2>(X, 10, tid); fft_pass<4, false, 2>(X, 6, tid); fft_pass<4, false, 2>(X, 2, tid); fft_pass<2, false, 4>(X, 0, tid); }
__device__ __forceinline__ void fft_dit_inv(LAS c2* X, int tid) { fft_pass<2, true, 4>(X, 0, tid); fft_pass<4, true, 2>(X, 2, tid); fft_pass<4, true, 2>(X, 6, tid); fft_pass<4, true, 2>(X, 10, tid); }
__device__ __forceinline__ int br14(int x) { return (int)(__brev((unsigned)x) >> 18); }
__device__ __forceinline__ float block_sum(float v, LAS float* red, int tid, int lane, int wave) {
    v = wave_sum(v); __syncthreads(); if (lane == 0) red[wave] = v; __syncthreads();
    float s = 0.f;
#pragma unroll
    for (int i = 0; i < 8; ++i) s += red[i];
    return s;
}
__device__ __forceinline__ void hyena_fft_pair(const Params& p, LAS unsigned char* lds, int pair, int tid, int lane, int wave) {
    const int c = pair * 2;
    const float* skip = p.in[19];
    bf16_t* zT = (bf16_t*)(p.ws + WS_ZT); const bf16_t* x0T = (const bf16_t*)(p.ws + WS_X0T);
    f32x4* SK = (f32x4*)(p.ws + WS_SK) + (size_t)blockIdx.x * SK_STRIDE;
    LAS c2* X = (LAS c2*)lds; LAS float* red = (LAS float*)(lds + XPAD_BYTES);
    const float dmin = -3.0701134573253945f, dmax = -15.350567286626973f;
    const float del0 = fabsf(dmin + (float)c * ((dmax - dmin) / 1023.0f)), del1 = fabsf(dmin + (float)(c + 1) * ((dmax - dmin) / 1023.0f));
    float n0 = 0.f, n1 = 0.f, inv0 = 0.f, inv1 = 0.f;
#pragma unroll 1
    for (int rb = 0; rb <= REP_FB; ++rb) {
    n0 = 0.f; n1 = 0.f;
    {
        const bf16_t* ff = (const bf16_t*)p.out + (size_t)c * L; const bf16_t* fb = (const bf16_t*)p.out + (size_t)(HYW + c) * L;
#pragma unroll 1
        for (int ub = 0; ub < 2; ++ub) { float f0[8], f1[8], g0[8], g1[8];
#pragma unroll
            for (int u = 0; u < 8; ++u) { const int i = tid + NT * (ub * 8 + u); f0[u] = bf2f(ff[i]); f1[u] = bf2f(ff[L + i]); g0[u] = bf2f(fb[i]); g1[u] = bf2f(fb[L + i]); }
#pragma unroll
            for (int u = 0; u < 8; ++u) { const int i = tid + NT * (ub * 8 + u);
                X[XI(i)] = mk2(f0[u], f1[u]); n0 += fabsf(f0[u]); n1 += fabsf(f1[u]);
                if (i >= 1) { X[XI(FN - i)] = mk2(g0[u], g1[u]); n0 += fabsf(g0[u]); n1 += fabsf(g1[u]); } } }
    }
    if (tid == 0) X[XI(L)] = mk2(0.f, 0.f);
    inv0 = 1.0f / block_sum(n0, red, tid, lane, wave); inv1 = 1.0f / block_sum(n1, red, tid, lane, wave);
    __syncthreads();
    fft_dif(X, tid);
#pragma unroll 2
    for (int m = tid; m < FN / 2; m += NT) { const int pp = 2 * m, k = br14(pp), pm = br14((FN - k) & (FN - 1)); const c2 F = X[XI(pp)], Fm = X[XI(pm)];
        SK[m] = (f32x4){0.5f * (F.x + Fm.x), 0.5f * (F.y - Fm.y), 0.5f * (F.y + Fm.y), -0.5f * (F.x - Fm.x)}; }
    if (tid == 0) { const c2 F = X[XI(1)]; SK[FN / 2] = (f32x4){F.x, 0.f, F.y, 0.f}; }
    __syncthreads();
    }
    { float za[16], zb[16];
#pragma unroll
      for (int u = 0; u < 16; ++u) { za[u] = bf2f(zT[(size_t)c * L + tid + NT * u]); zb[u] = bf2f(zT[(size_t)(c + 1) * L + tid + NT * u]); }
#pragma unroll
      for (int u = 0; u < 16; ++u) { X[XI(tid + NT * u)] = mk2(za[u], zb[u]); X[XI(L + tid + NT * u)] = mk2(0.f, 0.f); } }
    __syncthreads();
    fft_dif(X, tid);
#pragma unroll 2
    for (int m = tid; m < FN / 2; m += NT) {
        const int pp = 2 * m, k = br14(pp); const f32x4 kk = SK[m]; const c2 K1 = mk2(kk[0], kk[1]), K2 = mk2(kk[2], kk[3]);
        if (k == 0) { const c2 F = X[XI(0)]; X[XI(0)] = mk2(F.x * K1.x, F.y * K2.x);
            const f32x4 kh = SK[FN / 2]; const c2 F1 = X[XI(1)]; X[XI(1)] = mk2(F1.x * kh[0], F1.y * kh[2]); }
        else { const int pm = br14(FN - k); const c2 F = X[XI(pp)], Fm = X[XI(pm)];
            const c2 Z1 = mk2(0.5f * (F.x + Fm.x), 0.5f * (F.y - Fm.y)), Z2 = mk2(0.5f * (F.y + Fm.y), -0.5f * (F.x - Fm.x));
            const c2 A = cmul(Z1, K1), B = cmul(Z2, K2);
            X[XI(pp)] = mk2(A.x - B.y, A.y + B.x); X[XI(pm)] = mk2(A.x + B.y, -A.y + B.x); }
    }
    __syncthreads();
    fft_dit_inv(X, tid);
    const float sk0 = skip[c], sk1 = skip[c + 1], sc = 1.0f / (float)FN;
#pragma unroll 1
    for (int ub = 0; ub < 2; ++ub) { float z0[8], z1[8], x0[8], x1[8];
#pragma unroll
        for (int u = 0; u < 8; ++u) { const int i = tid + NT * (ub * 8 + u); const size_t o0 = (size_t)c * L + i, o1 = (size_t)(c + 1) * L + i; z0[u] = bf2f(zT[o0]); z1[u] = bf2f(zT[o1]); x0[u] = bf2f(x0T[o0]); x1[u] = bf2f(x0T[o1]); }
#pragma unroll
        for (int u = 0; u < 8; ++u) { const int i = tid + NT * (ub * 8 + u); const size_t o0 = (size_t)c * L + i, o1 = (size_t)(c + 1) * L + i; const c2 y = X[XI(i)];
            zT[o0] = (bf16_t)f2bf((y.x * sc * inv0 + sk0 * z0[u]) * x0[u]); zT[o1] = (bf16_t)f2bf((y.y * sc * inv1 + sk1 * z1[u]) * x1[u]); } }
    __syncthreads();
}
__device__ __forceinline__ void gla_scan(const Params& p, int tid) {
    unsigned* ST = (unsigned*)(p.ws + WS_ST); const float* dec = (const float*)(p.ws + WS_DEC);
    const int gt = blockIdx.x * NT + tid, ngt = gridDim.x * NT;
#pragma unroll 1
    for (int e = gt; e < 8 * 16384; e += ngt) {
        const int dh = e >> 14, idx = e & 16383, dir = dh >> 2, h = dh & 3, d = (2 * idx) & 127;
        unsigned* base = ST + (size_t)dh * 128 * 16384 + idx;
        const float* db = dec + ((size_t)dir * 128 * 4 + h) * 128 + d;
        float s0 = 0.f, s1 = 0.f;
#pragma unroll 1
        for (int nb = 0; nb < 128; nb += 16) {
            unsigned kv[16]; c2 dc[16];
#pragma unroll
            for (int u = 0; u < 16; ++u) { const int n = dir ? 127 - (nb + u) : nb + u; kv[u] = base[(size_t)n * 16384]; dc[u] = *(const c2*)(db + (size_t)n * 512); }
#pragma unroll
            for (int u = 0; u < 16; ++u) { const int n = dir ? 127 - (nb + u) : nb + u; base[(size_t)n * 16384] = pk2(s0, s1);
                s0 = dc[u].x * s0 + bf2f(kv[u] & 0xffffu); s1 = dc[u].y * s1 + bf2f(kv[u] >> 16); }
        }
    }
}

__device__ __forceinline__ void gla_out_item(const Params& p, LAS unsigned char* lds, int item, int tid, int lane, int wave) {
    const int h = item & 3, n = item >> 2, t0 = n * 64;
    const bf16_t* pr = (const bf16_t*)(p.ws + WS_PR); const bf16_t* ST = (const bf16_t*)(p.ws + WS_ST); bf16_t* mix = (bf16_t*)(p.ws + WS_MIX);
    const float* og = p.in[25];
    LAS bf16_t* qin = (LAS bf16_t*)lds;
    LAS bf16_t* kin = (LAS bf16_t*)(lds + 34816);
    LAS bf16_t* vT = (LAS bf16_t*)(lds + 69632);
    LAS bf16_t* P = (LAS bf16_t*)(lds + 106496);
    LAS float* lrs = (LAS float*)(lds + 115712); LAS float* tot = (LAS float*)(lds + 123904); LAS float* red = (LAS float*)(lds + 125952);
    gla_stage(pr, (const float*)(p.ws + WS_LR), t0, h, lrs, vT, tid);
    const int d = tid & 127, dir = (tid >> 7) & 1, half = tid >> 8;
    GateW gw; gate_load(p, dir, h, d, gw);
    const bf16_t* qp = pr + (size_t)t0 * PR_LD + PR_Q + h * 128 + d;
    unsigned short kr[8], qr[8];
#pragma unroll
    for (int u = 0; u < 8; ++u) { const int q = half * 32 + u, t = dir ? 63 - q : q; qr[u] = qp[(size_t)t * PR_LD]; kr[u] = qp[(size_t)t * PR_LD + (PR_K - PR_Q)]; }
    const float bpre = half ? ((const float*)(p.ws + WS_T0))[((size_t)(dir * 128 + n) * 4 + h) * 128 + d] : 0.f;
    __syncthreads();
    {
        float b = bpre;
#pragma unroll 1
        for (int sg = 0; sg < 4; ++sg) {
            unsigned short kn[8], qn[8];
#pragma unroll
            for (int u = 0; u < 8; ++u) { const int q = half * 32 + ((sg * 8 + 8 + u) & 31), t = dir ? 63 - q : q; qn[u] = qp[(size_t)t * PR_LD]; kn[u] = qp[(size_t)t * PR_LD + (PR_K - PR_Q)]; }
#pragma unroll
            for (int u = 0; u < 8; ++u) { const int q = half * 32 + sg * 8 + u, t = dir ? 63 - q : q; b += gate_eval(gw, lrs + t * 32 + dir * 16);
                const float qv = bf2f(qr[u]) * 0.08838834764831845f, kv = bf2f(kr[u]);
                qin[(dir * 64 + t) * 136 + d] = (bf16_t)f2bf(qv * __expf(b)); kin[(dir * 64 + t) * 136 + d] = (bf16_t)f2bf(kv * __expf(-b)); }
#pragma unroll
            for (int u = 0; u < 8; ++u) { kr[u] = kn[u]; qr[u] = qn[u]; }
        }
    }
    __syncthreads();
    const int q4 = lane >> 4, fr = lane & 15;
#pragma unroll 1
    for (int ti = 0; ti < 2; ++ti) {
        const int id = wave * 2 + ti, tt = id >> 2, st = id & 3;
        f32x4 af = (f32x4){0.f, 0.f, 0.f, 0.f}, ab = (f32x4){0.f, 0.f, 0.f, 0.f};
        if (tt >= st) {
#pragma unroll
            for (int ks = 0; ks < 4; ++ks) af = __builtin_amdgcn_mfma_f32_16x16x32_bf16(ldfrag(qin, 136, 16 * tt, 32 * ks, lane), ldfrag(kin, 136, 16 * st, 32 * ks, lane), af, 0, 0, 0); }
        if (tt <= st) {
#pragma unroll
            for (int ks = 0; ks < 4; ++ks) ab = __builtin_amdgcn_mfma_f32_16x16x32_bf16(ldfrag(qin + 64 * 136, 136, 16 * tt, 32 * ks, lane), ldfrag(kin + 64 * 136, 136, 16 * st, 32 * ks, lane), ab, 0, 0, 0); }
#pragma unroll
        for (int r = 0; r < 4; ++r) { const int t = 16 * tt + 4 * q4 + r, s = 16 * st + fr; P[t * 72 + s] = (bf16_t)f2bf(t >= s ? af[r] : ab[r]); }
    }
    __syncthreads();
    f32x4 acc[2][4];
#pragma unroll
    for (int mt = 0; mt < 2; ++mt)
#pragma unroll
        for (int nt = 0; nt < 4; ++nt) acc[mt][nt] = (f32x4){0.f, 0.f, 0.f, 0.f};
    const int v0 = wave * 32;
#pragma unroll
    for (int ks = 0; ks < 2; ++ks) {
        const bf16x8 a0 = ldfrag(vT, 72, v0, 32 * ks, lane), a1 = ldfrag(vT, 72, v0 + 16, 32 * ks, lane);
#pragma unroll
        for (int nt = 0; nt < 4; ++nt) { const bf16x8 b = ldfrag(P, 72, 16 * nt, 32 * ks, lane);
            acc[0][nt] = __builtin_amdgcn_mfma_f32_16x16x32_bf16(a0, b, acc[0][nt], 0, 0, 0); acc[1][nt] = __builtin_amdgcn_mfma_f32_16x16x32_bf16(a1, b, acc[1][nt], 0, 0, 0); }
    }
#pragma unroll 1
    for (int dr = 0; dr < 2; ++dr) {
        const bf16_t* S = ST + ((size_t)(dr * 4 + h) * 128 + n) * 32768;
        bf16x8 sa[4][2];
#pragma unroll
        for (int ks = 0; ks < 4; ++ks) { sa[ks][0] = *(const bf16x8*)(S + (size_t)(v0 + fr) * 128 + 32 * ks + 8 * q4); sa[ks][1] = *(const bf16x8*)(S + (size_t)(v0 + 16 + fr) * 128 + 32 * ks + 8 * q4); }
#pragma unroll
        for (int ks = 0; ks < 4; ++ks)
#pragma unroll
            for (int nt = 0; nt < 4; ++nt) { const bf16x8 b = ldfrag(qin + dr * 64 * 136, 136, 16 * nt, 32 * ks, lane);
                acc[0][nt] = __builtin_amdgcn_mfma_f32_16x16x32_bf16(sa[ks][0], b, acc[0][nt], 0, 0, 0); acc[1][nt] = __builtin_amdgcn_mfma_f32_16x16x32_bf16(sa[ks][1], b, acc[1][nt], 0, 0, 0); }
    }
#pragma unroll
    for (int nt = 0; nt < 4; ++nt) { float ss = 0.f;
#pragma unroll
        for (int mt = 0; mt < 2; ++mt) ss += (acc[mt][nt][0] * acc[mt][nt][0] + acc[mt][nt][1] * acc[mt][nt][1]) + (acc[mt][nt][2] * acc[mt][nt][2] + acc[mt][nt][3] * acc[mt][nt][3]);
        ss += __shfl_xor(ss, 16); ss += __shfl_xor(ss, 32);
        if (q4 == 0) red[wave * 64 + 16 * nt + fr] = ss; }
    __syncthreads();
#pragma unroll
    for (int nt = 0; nt < 4; ++nt) { const int t = 16 * nt + fr; float ss = 0.f;
#pragma unroll
        for (int w = 0; w < 8; ++w) ss += red[w * 64 + t];
        const float rs = rsqrtf(ss * (1.0f / 256.0f) + 1e-6f);
#pragma unroll
        for (int mt = 0; mt < 2; ++mt) { const int v = v0 + 16 * mt + 4 * q4; const f32x4 g = *(const f32x4*)(og + h * 256 + v);
            const u32x2 rw = *(const u32x2*)(pr + (size_t)(t0 + t) * PR_LD + PR_R + h * 256 + v);
            const float r0 = bf2f(rw.x & 0xffffu), r1 = bf2f(rw.x >> 16), r2 = bf2f(rw.y & 0xffffu), r3 = bf2f(rw.y >> 16);
            u32x2 w; w.x = pk2(acc[mt][nt][0] * rs * g[0] * silu_f(r0), acc[mt][nt][1] * rs * g[1] * silu_f(r1));
            w.y = pk2(acc[mt][nt][2] * rs * g[2] * silu_f(r2), acc[mt][nt][3] * rs * g[3] * silu_f(r3));
            *(u32x2*)(mix + (size_t)(t0 + t) * DM + HYW + h * 256 + v) = w; }
    }
    __syncthreads();
}
__device__ __forceinline__ void hynorm_tile(const Params& p, LAS unsigned char* lds, int tile, int tid) {
    const bf16_t* yT = (const bf16_t*)(p.ws + WS_ZT); bf16_t* mix = (bf16_t*)(p.ws + WS_MIX); const float* og = p.in[20];
    LAS float* yt = (LAS float*)lds; LAS float* red = yt + 128 * 65;
    const int g = tile & 7, t0 = (tile >> 3) * 64, c0 = g * 128;
    { const int t = tid & 63, cg8 = tid >> 6; float ss = 0.f;
#pragma unroll
      for (int i = 0; i < 16; ++i) { const int cc = cg8 * 16 + i; const float v = bf2f(yT[(size_t)(c0 + cc) * L + t0 + t]); yt[cc * 65 + t] = v; ss += v * v; }
      red[cg8 * 64 + t] = ss; }
    __syncthreads();
    { const int c2 = (tid & 63) * 2, tg = tid >> 6; const float g0 = og[c0 + c2], g1 = og[c0 + c2 + 1];
#pragma unroll
      for (int i = 0; i < 8; ++i) { const int t = tg * 8 + i; float ss = 0.f;
#pragma unroll
          for (int w = 0; w < 8; ++w) ss += red[w * 64 + t];
          const float rs = rsqrtf(ss * (1.0f / 128.0f) + 1e-6f);
          *(unsigned*)(mix + (size_t)(t0 + t) * DM + c0 + c2) = pk2(yt[c2 * 65 + t] * rs * g0, yt[(c2 + 1) * 65 + t] * rs * g1); } }
    __syncthreads();
}

#define XB_TMO      128
#define XB_XCNT(j)  (256  + 64 * (j))
#define XB_XSUB(j)  (1280 + 64 * (j))
#define XB_XGEN(j)  (2304 + 64 * (j))
#define XB_TOP      3328
#define XB_TOPGEN   3392
#define XCD_BAR_WORDS 3456
#define XB_SPIN_CAP (1u << 18)

__device__ __forceinline__ unsigned xb_ld(unsigned* p)              { return __hip_atomic_load(p, __ATOMIC_RELAXED, __HIP_MEMORY_SCOPE_AGENT); }
__device__ __forceinline__ unsigned xb_add(unsigned* p, unsigned v) { return __hip_atomic_fetch_add(p, v, __ATOMIC_RELAXED, __HIP_MEMORY_SCOPE_AGENT); }
__device__ __forceinline__ unsigned xb_xcc_id() { return (unsigned)__builtin_amdgcn_s_getreg((3 << 11) | 20) & 0xFu; }
#define XB_SPIN(cond, bar) do { unsigned _sp = 0; while (cond) { __builtin_amdgcn_s_sleep(1); \
    if ((++_sp & 255u) == 0u) { if (xb_ld(&(bar)[XB_TMO])) break; if (_sp > XB_SPIN_CAP) { atomicAdd(&(bar)[XB_TMO], 1u); break; } } } } while (0)

struct XcdBarrier {
    unsigned* bar; unsigned x;
    volatile LAS unsigned* st;
};

__device__ __forceinline__ XcdBarrier xcd_barrier_post(unsigned* bar, volatile LAS unsigned* st) {
    XcdBarrier b; b.bar = bar; b.x = xb_xcc_id(); b.st = st;
    if (threadIdx.x == 0) (void)xb_add(&bar[XB_XCNT(b.x)], 1u);
    return b;
}
__device__ __forceinline__ void xcd_barrier_complete(unsigned* bar, unsigned x, unsigned& nloc, unsigned& nx) {
    const unsigned G = gridDim.x * gridDim.y * gridDim.z;
    unsigned sum, cnt, mine, sp = 0u;
    for (;;) {
        sum = 0u; cnt = 0u; mine = 0u;
#pragma unroll
        for (unsigned j = 0; j < 16; ++j) { const unsigned c = xb_ld(&bar[XB_XCNT(j)]); sum += c; cnt += (c > 0u) ? 1u : 0u; mine = (j == x) ? c : mine; }
        if (sum == G) break;
        __builtin_amdgcn_s_sleep(1);
        if ((++sp & 255u) == 0u) { if (xb_ld(&bar[XB_TMO])) break; if (sp > XB_SPIN_CAP) { atomicAdd(&bar[XB_TMO], 1u); break; } }
    }
    nloc = mine > 0u ? mine : 1u; nx = cnt > 0u ? cnt : 1u;
}

__device__ __forceinline__ void xcd_barrier(const XcdBarrier& b) {
    asm volatile("s_waitcnt vmcnt(0)" ::: "memory");
    __syncthreads();
    if (threadIdx.x == 0) {
        unsigned* bar = b.bar;
        __builtin_amdgcn_s_waitcnt(0);
        unsigned nloc = b.st[0], nx = b.st[1]; const unsigned bx = b.st[2];
        if (nloc == 0u) { xcd_barrier_complete(bar, bx, nloc, nx); b.st[0] = nloc; b.st[1] = nx; }
        const unsigned old = xb_add(&bar[XB_XSUB(bx)], 1u);
        const unsigned gen = old / nloc;
        if (old + 1u == (gen + 1u) * nloc) {
            __builtin_amdgcn_fence(__ATOMIC_RELEASE, "agent");
            asm volatile("s_waitcnt vmcnt(0)" ::: "memory");
            const unsigned og = xb_add(&bar[XB_TOP], 1u);
            const unsigned tg = og / nx;
            if (og + 1u == (tg + 1u) * nx) xb_add(&bar[XB_TOPGEN], 1u);
            else XB_SPIN(xb_ld(&bar[XB_TOPGEN]) == tg, bar);
            __builtin_amdgcn_fence(__ATOMIC_ACQUIRE, "agent");
            xb_add(&bar[XB_XGEN(bx)], 1u);
            asm volatile("s_waitcnt vmcnt(0)" ::: "memory");
        } else {
            XB_SPIN(xb_ld(&bar[XB_XGEN(bx)]) == gen, bar);
            __builtin_amdgcn_fence(__ATOMIC_ACQUIRE, "agent");
            asm volatile("s_waitcnt vmcnt(0)" ::: "memory");
        }
    }
    __syncthreads();
}

#ifndef REP_P0
#define REP_P0 0
#endif
#ifndef PA_MASK
#define PA_MASK 3
#endif
#ifndef PC_MASK
#define PC_MASK 3
#endif
#ifndef REP_G1
#define REP_G1 0
#endif
#ifndef REP_G3
#define REP_G3 0
#endif
#ifndef P0_MASK
#define P0_MASK 15
#endif
#ifndef REP_PA
#define REP_PA 0
#endif
#ifndef REP_PAB
#define REP_PAB 0
#endif
#ifndef REP_PC
#define REP_PC 0
#endif
__global__ void __launch_bounds__(NT, 2) fwd_megakernel(Params p) {
    extern __shared__ __attribute__((aligned(16))) unsigned char smem[];
    LAS unsigned char* lds = (LAS unsigned char*)smem;
    cg::grid_group grid = cg::this_grid();
    const int G = gridDim.x;
    volatile LAS unsigned* bst = (volatile LAS unsigned*)(lds + LDS_BYTES - 64);
    if (threadIdx.x < 2) bst[threadIdx.x] = 0u;
    __syncthreads();
    XcdBarrier xbar = xcd_barrier_post((unsigned*)(p.ws + WS_BAR), bst);
    if (threadIdx.x == 0) bst[2] = xbar.x;
    if (p.ws == nullptr) grid.sync();
#define TIDS int tid = threadIdx.x; asm volatile("" : "+v"(tid)); const int lane = tid & 63, wave = __builtin_amdgcn_readfirstlane(tid >> 6); (void)lane; (void)wave;
    unsigned char* ws = p.ws;
    float* rowss = (float*)(ws + WS_ROWSS);
    bf16_t* XB = (bf16_t*)(ws + WS_XB); bf16_t* AB = (bf16_t*)(ws + WS_A);

#pragma unroll 1
    for (int rep = 0; rep <= REP_P0; ++rep) {
#ifndef SKIP_P0
        { TIDS; phase0(p, lds, tid, lane, wave, rep == 0 ? 15 : P0_MASK); }
#endif
        xcd_barrier(xbar); }
#ifndef NO_GEMM
#pragma unroll 1
    for (int rg = 0; rg <= REP_G1; ++rg) {
    { pg8::Gemm g{XB, (const bf16_t*)(ws + WS_WFF), L, 2 * FF, DM}; pg8::StaticOrder S; S.init(L, 2 * FF, G, (int)blockIdx.x);
      pg8::EpiSwiGLU E{AB, FF, rowss}; pg8::gemm_phase<pg8::EpiSwiGLU, pg8::StaticOrder, true, true>(lds, g, S, E); }
    { TIDS; const int rem = ((L / 256) * (2 * FF / 256)) % G, nl = rem ? G - rem : G, li = rem ? (int)blockIdx.x - rem : (int)blockIdx.x;
      if (li >= 0) convert_tail1(p, lds, li * 8 + wave, nl * 8, lane, wave); }
    xcd_barrier(xbar);
    }
    { pg8::Gemm g{AB, (const bf16_t*)(ws + WS_WDN), L, DM, FF}; pg8::StaticOrder S; S.init(L, DM, G, (int)blockIdx.x);
      pg8::EpiResid E{p.in[0], nullptr, XB, rowss + L, 0.5f}; pg8::gemm_phase<pg8::EpiResid, pg8::StaticOrder, true, true>(lds, g, S, E); }
    xcd_barrier(xbar);
#pragma unroll 1
    for (int rg = 0; rg <= REP_G3; ++rg) {
    { pg8::Gemm g{XB, (const bf16_t*)(ws + WS_WIN), L, NING, DM}; pg8::StaticOrder S; S.init(L, NING, G, (int)blockIdx.x);
      pg8::EpiP E{(bf16_t*)(ws + WS_PHY), (bf16_t*)(ws + WS_PR), rowss + L}; pg8::gemm_phase<pg8::EpiP, pg8::StaticOrder, true, true>(lds, g, S, E); }
    { TIDS; for (int it = blockIdx.x; it < L / 32; it += G) lr_task(p, lds, it, tid, lane, wave); }
    xcd_barrier(xbar);
    }
#endif
#pragma unroll 1
    for (int rep = 0; rep <= REP_PAB; ++rep) {
#pragma unroll 1
        for (int r2 = 0; r2 <= REP_PA; ++r2) {
#ifndef SKIP_PA
            { pg8::Gemm g{(const bf16_t*)(ws + WS_W4T), (const bf16_t*)(ws + WS_HID), 2048, L, 256}; pg8::StaticOrder S; S.init(2048, L, G, (int)blockIdx.x);
              pg8::EpiFilt E{(bf16_t*)p.out, (bf16_t*)p.out + (size_t)HYW * L, (bf16_t*)p.out + (size_t)(HYW + 768) * L}; pg8::gemm_phase<pg8::EpiFilt, pg8::StaticOrder, true, true>(lds, g, S, E); }
            if (r2 == 0 || (PA_MASK & 1)) { TIDS; for (int it = blockIdx.x; it < 512; it += G) gla_kv_item(p, lds, it, tid, lane, wave); }
            if (r2 == 0 || (PA_MASK & 2)) { TIDS; const bf16_t* phy = (const bf16_t*)(ws + WS_PHY); u32x4 rw[4], rn[4];
              if ((int)blockIdx.x < 2048) convT_fetch(phy, blockIdx.x, tid, rw);
#pragma unroll 1
              for (int it = blockIdx.x; it < 2048; it += G) { const bool more = it + G < 2048; if (more) convT_fetch(phy, it + G, tid, rn);
                  convT_tile(p, lds, it, tid, rw);
                  if (more) {
#pragma unroll
                      for (int k = 0; k < 4; ++k) rw[k] = rn[k]; } } }
#endif
            xcd_barrier(xbar);
        }
#ifndef SKIP_PB
        { TIDS; gla_scan(p, tid); }
        { TIDS; for (int it = blockIdx.x; it < HYW / 2; it += G) hyena_fft_pair(p, lds, it, tid, lane, wave); }
#endif
        xcd_barrier(xbar);
    }
#pragma unroll 1
    for (int rep = 0; rep <= REP_PC; ++rep) {
#ifndef SKIP_PC
        if (rep == 0 || (PC_MASK & 1)) { TIDS; for (int it = blockIdx.x; it < 512; it += G) gla_out_item(p, lds, it, tid, lane, wave); }
        if (rep == 0 || (PC_MASK & 2)) { TIDS; for (int it = blockIdx.x; it < 1024; it += G) hynorm_tile(p, lds, it, tid); }
#endif
        xcd_barrier(xbar);
    }
#ifndef NO_GEMM
    { pg8::Gemm g{(const bf16_t*)(ws + WS_MIX), (const bf16_t*)(ws + WS_WOUT), L, DM, DM}; pg8::StaticOrder S; S.init(L, DM, G, (int)blockIdx.x);
      pg8::EpiResid E{nullptr, XB, XB, rowss + 2 * L, 1.0f}; pg8::gemm_phase<pg8::EpiResid, pg8::StaticOrder, true, true>(lds, g, S, E); }
    __syncthreads();
    { TIDS; convert_gu(p.in[28], p.in[29], p.in[27], ws, lds, blockIdx.x * 8 + wave, G * 8, lane, wave); }
    xcd_barrier(xbar);
    { pg8::Gemm g{XB, (const bf16_t*)(ws + WS_WFF), L, 2 * FF, DM}; pg8::StaticOrder S; S.init(L, 2 * FF, G, (int)blockIdx.x);
      pg8::EpiSwiGLU E{AB, FF, rowss + 2 * L}; pg8::gemm_phase<pg8::EpiSwiGLU, pg8::StaticOrder, true, true>(lds, g, S, E); }
    { TIDS; const int rem = ((L / 256) * (2 * FF / 256)) % G, nl = rem ? G - rem : G, li = rem ? (int)blockIdx.x - rem : (int)blockIdx.x;
      if (li >= 0) convert_dn(p.in[30], ws, lds, li * 8 + wave, nl * 8, lane, wave); }
    xcd_barrier(xbar);
    { pg8::Gemm g{AB, (const bf16_t*)(ws + WS_WDN), L, DM, FF}; pg8::StaticOrder S; S.init(L, DM, G, (int)blockIdx.x);
      pg8::EpiFinal E{XB, p.out, rowss + 3 * L, (unsigned*)(ws + WS_PCNT), p.in[31], 0.5f}; pg8::gemm_phase<pg8::EpiFinal, pg8::StaticOrder, true, true>(lds, g, S, E); }
#endif
}

extern "C" void kernel_launch(void* const* d_in, const int* in_sizes, int n_in, void* d_out, int out_size, void* d_ws, size_t ws_size, hipStream_t stream) {
    static int grid = 0;
    if (grid == 0) {
        if (n_in != 32 || out_size != L * DM || ws_size < WS_END) { fprintf(stderr, "kernel_launch: unexpected problem: n_in %d out %d ws %zu (need %zu)\n", n_in, out_size, ws_size, (size_t)WS_END); grid = -1; return; }
        int dev = 0, cus = 0, per_cu = 0;
        (void)hipGetDevice(&dev); (void)hipDeviceGetAttribute(&cus, hipDeviceAttributeMultiprocessorCount, dev);
        if (hipFuncSetAttribute((const void*)fwd_megakernel, hipFuncAttributeMaxDynamicSharedMemorySize, LDS_BYTES) != hipSuccess) { fprintf(stderr, "kernel_launch: hipFuncSetAttribute failed\n"); grid = -1; return; }
        if (hipOccupancyMaxActiveBlocksPerMultiprocessor(&per_cu, (const void*)fwd_megakernel, NT, LDS_BYTES) != hipSuccess || per_cu < 1) { fprintf(stderr, "kernel_launch: occupancy query gave %d\n", per_cu); per_cu = 1; }
        (void)hipGetLastError();
        grid = cus * per_cu; if (grid > 256) grid = 256;
        if (grid != 256) { fprintf(stderr, "kernel_launch: this kernel needs a 256-workgroup cooperative grid (256 CUs x 1), got %d; nothing launched\n", grid); grid = -1; return; }
        fprintf(stderr, "kernel_launch: cus %d per_cu %d grid %d\n", cus, per_cu, grid);
    }
    if (grid < 0) return;
    Params p{};
    for (int i = 0; i < 32; ++i) p.in[i] = (const float*)d_in[i];
    p.out = (float*)d_out; p.ws = (unsigned char*)d_ws;
    if (hipMemsetAsync((char*)d_ws + WS_BAR, 0, 16384 + 32 * 256, stream) != hipSuccess) { fprintf(stderr, "kernel_launch: hipMemsetAsync failed\n"); return; }
    void* args[] = {&p};
    hipError_t e = hipLaunchCooperativeKernel((const void*)fwd_megakernel, dim3(grid), dim3(NT), args, LDS_BYTES, stream);
    if (e != hipSuccess) fprintf(stderr, "kernel_launch: cooperative launch failed: %s (grid %d)\n", hipGetErrorString(e), grid);
}
```

```cpp
#include <hip/hip_runtime.h>
#include <hip/hip_cooperative_groups.h>
#include <cstdio>
#include <cstdint>
namespace cg = cooperative_groups;

namespace pg8 {
#define PG8_LAS __attribute__((address_space(3)))
typedef unsigned short bf16_t;
typedef short bf16x8 __attribute__((ext_vector_type(8)));
typedef float f32x4 __attribute__((ext_vector_type(4)));
typedef unsigned u32x4 __attribute__((ext_vector_type(4)));
constexpr int BM = 256, BK = 64, HALF = 128, HTB = HALF * BK * 2  , STAGE_BYTES = 8 * HTB, NXCD = 8, WGM = 8;

__host__ __device__ __forceinline__ int lds_byte(int r, int c) { const int st = (r >> 4) * 2 + (c >> 5), rr = r & 15, cc = c & 31, ob = rr * 64 + cc * 2; return st * 1024 + (ob ^ (((ob >> 9) & 1) << 5)); }
__host__ __device__ __forceinline__ void stage_rc(int b, int& R, int& C) { const int st = b / 1024, sb = b % 1024, swz = sb ^ (((sb >> 9) & 1) << 5); R = (st >> 1) * 16 + swz / 64; C = (st & 1) * 32 + (swz % 64) / 2; }
__host__ __device__ __forceinline__ int perm32(int rho) { const int n = rho >> 4, i = rho & 15; return 8 * (i >> 2) + 4 * n + (i & 3); }

struct Unit { int pm, pn; };
struct Gemm { const bf16_t* A; const bf16_t* Bt; int M, N, K; };

struct StaticOrder {
    int nM, nN, nwg, G, c;
    __host__ __device__ void init(int M, int N, int G_, int c_) { nM = M / BM; nN = N / BM; nwg = nM * nN; G = G_; c = c_; }
    __host__ __device__ bool next(int i, Unit& u) const {
        const long L = (long)i * G + c; if (L >= nwg) return false;
        int wgid = (int)L; { const int q = nwg / NXCD, r = nwg % NXCD, xcd = wgid % NXCD, off = wgid / NXCD; wgid = (xcd < r ? xcd * (q + 1) : r * (q + 1) + (xcd - r) * q) + off; }
        const int nig = WGM * nN, gid = wgid / nig, fm = gid * WGM, gsz = (nM - fm) < WGM ? (nM - fm) : WGM;
        u.pm = fm + ((wgid % nig) % gsz); u.pn = (wgid % nig) / gsz; return true;
    }
    __device__ __forceinline__ void a_ready(const Unit&) const {}
    __device__ __forceinline__ void done(const Unit&) const {}
};
__device__ __forceinline__ unsigned cvt_pk_bf16(float lo, float hi) { unsigned r; asm volatile("v_cvt_pk_bf16_f32 %0, %1, %2" : "=v"(r) : "v"(lo), "v"(hi)); return r; }
typedef unsigned u32x4 __attribute__((ext_vector_type(4)));
typedef unsigned u32x2 __attribute__((ext_vector_type(2)));
__device__ __forceinline__ float rstd_of(float ss) { return rsqrtf(ss * (1.0f / 2048.0f) + 1e-6f); }
__device__ __forceinline__ float silu_f(float x) { return x * __builtin_amdgcn_rcpf(1.0f + __expf(-x)); }

struct EpiSwiGLU {
    static constexpr bool PERM = true, AFTER_DRAIN = false;
    bf16_t* O; int ldc; const float* rowss;
    __device__ __forceinline__ void operator()(const f32x4 (&acc)[2][2][4][2], const Unit& u, int wr, int wc, int fr, int fq) const {
        const int row0 = u.pm * BM + wr * 64 + fr, col0 = u.pn * 128 + wc * 32 + 8 * fq;
#pragma unroll
        for (int ai = 0; ai < 2; ++ai)
#pragma unroll
            for (int m = 0; m < 4; ++m) {
                const int row = row0 + ai * HALF + m * 16; const float rs = rstd_of(rowss[row]);
                float v[8];
#pragma unroll
                for (int n = 0; n < 2; ++n)
#pragma unroll
                    for (int j = 0; j < 4; ++j) v[n * 4 + j] = silu_f(acc[ai][0][m][n][j] * rs) * (acc[ai][1][m][n][j] * rs);
                u32x4 w; w.x = cvt_pk_bf16(v[0], v[1]); w.y = cvt_pk_bf16(v[2], v[3]); w.z = cvt_pk_bf16(v[4], v[5]); w.w = cvt_pk_bf16(v[6], v[7]);
                *(u32x4*)(O + (size_t)row * ldc + col0) = w;
            }
    }
};
struct EpiResid {
    static constexpr bool PERM = false, AFTER_DRAIN = false;
    const float* base; const bf16_t* base16; bf16_t* ob; float* rowss; float scale;
    __device__ __forceinline__ void operator()(const f32x4 (&acc)[2][2][4][2], const Unit& u, int wr, int wc, int fr, int fq) const {
        const int row0 = u.pm * BM + wr * 64 + fr, col0 = u.pn * BM + wc * 32 + 4 * fq;
#pragma unroll
        for (int ai = 0; ai < 2; ++ai)
#pragma unroll
            for (int m = 0; m < 4; ++m) {
                const int row = row0 + ai * HALF + m * 16; float ss = 0.f;
#pragma unroll
                for (int bj = 0; bj < 2; ++bj)
#pragma unroll
                    for (int n = 0; n < 2; ++n) {
                        const size_t off = (size_t)row * 2048 + col0 + bj * HALF + n * 16;
                        f32x4 b;
                        if (base) b = *(const f32x4*)(base + off);
                        else { const u32x2 r = *(const u32x2*)(base16 + off); b = (f32x4){__builtin_bit_cast(float, r.x << 16), __builtin_bit_cast(float, r.x & 0xffff0000u), __builtin_bit_cast(float, r.y << 16), __builtin_bit_cast(float, r.y & 0xffff0000u)}; }
                        const f32x4 v = b + acc[ai][bj][m][n] * scale;
                        { u32x2 w; w.x = cvt_pk_bf16(v[0], v[1]); w.y = cvt_pk_bf16(v[2], v[3]); *(u32x2*)(ob + off) = w; }
                        ss += (v[0] * v[0] + v[1] * v[1]) + (v[2] * v[2] + v[3] * v[3]);
                    }
                ss += __shfl_xor(ss, 16); ss += __shfl_xor(ss, 32);
                if (rowss && fq == 0) atomicAdd(rowss + row, ss);
            }
    }
};
struct EpiP {
    static constexpr bool PERM = true, AFTER_DRAIN = false;
    bf16_t* phy; bf16_t* pr; const float* rowss;
    __device__ __forceinline__ void operator()(const f32x4 (&acc)[2][2][4][2], const Unit& u, int wr, int wc, int fr, int fq) const {
        const int row0 = u.pm * BM + wr * 64 + fr;
        bf16_t* O; int ldc, colt;
        if (u.pn < 12) { O = phy; ldc = 3072; colt = u.pn * BM; } else { O = pr; ldc = 3072; colt = (u.pn - 12) * BM; }
        const int col0 = colt + wc * 32 + 8 * fq;
#pragma unroll
        for (int ai = 0; ai < 2; ++ai)
#pragma unroll
            for (int m = 0; m < 4; ++m) {
                const int row = row0 + ai * HALF + m * 16; const float rs = rstd_of(rowss[row]);
#pragma unroll
                for (int bj = 0; bj < 2; ++bj) {
                    const f32x4 v0 = acc[ai][bj][m][0] * rs, v1 = acc[ai][bj][m][1] * rs;
                    u32x4 w; w.x = cvt_pk_bf16(v0[0], v0[1]); w.y = cvt_pk_bf16(v0[2], v0[3]); w.z = cvt_pk_bf16(v1[0], v1[1]); w.w = cvt_pk_bf16(v1[2], v1[3]);
                    *(u32x4*)(O + (size_t)row * ldc + col0 + bj * HALF) = w;
                }
            }
    }
};

struct EpiFilt {
    static constexpr bool PERM = false, AFTER_DRAIN = false;
    bf16_t* Ff; bf16_t* Fb0; bf16_t* Fb1;
    __device__ __forceinline__ void operator()(const f32x4 (&acc)[2][2][4][2], const Unit& u, int wr, int wc, int fr, int fq) const {
        const int row0 = u.pm * BM + wr * 64 + fr, col0 = u.pn * BM + wc * 32 + 4 * fq;
        const float dmin = -3.0701134573253945f, dmax = -15.350567286626973f;
#pragma unroll
        for (int ai = 0; ai < 2; ++ai)
#pragma unroll
            for (int m = 0; m < 4; ++m) {
                const int cc = row0 + ai * HALF + m * 16, c = cc & 1023;
                const float del = __builtin_fabsf(dmin + (float)c * ((dmax - dmin) / 1023.0f)) * (1.0f / 8191.0f);
                bf16_t* dst = cc < 1024 ? Ff + (size_t)c * 8192 : (c < 768 ? Fb0 + (size_t)c * 8192 : Fb1 + (size_t)(c - 768) * 8192);
#pragma unroll
                for (int bj = 0; bj < 2; ++bj)
#pragma unroll
                    for (int n = 0; n < 2; ++n) {
                        const int i = col0 + bj * HALF + n * 16; f32x4 v = acc[ai][bj][m][n];
#pragma unroll
                        for (int j = 0; j < 4; ++j) v[j] *= __expf(-(float)(i + j) * del);
                        { u32x2 w; w.x = cvt_pk_bf16(v[0], v[1]); w.y = cvt_pk_bf16(v[2], v[3]); *(u32x2*)(dst + i) = w; }
                    }
            }
    }
};

struct EpiFinal {
    static constexpr bool PERM = false, AFTER_DRAIN = false;
    const bf16_t* base16; float* out; float* rowss; unsigned* cnt; const float* g; float scale;
    __device__ __forceinline__ void operator()(f32x4 (&acc)[2][2][4][2], const Unit& u, int wr, int wc, int fr, int fq) const {
        const int row0 = u.pm * BM + wr * 64 + fr, col0 = u.pn * BM + wc * 32 + 4 * fq;
#pragma unroll
        for (int ai = 0; ai < 2; ++ai)
#pragma unroll
            for (int m = 0; m < 4; ++m) {
                const int row = row0 + ai * HALF + m * 16; float ss = 0.f;
#pragma unroll
                for (int bj = 0; bj < 2; ++bj)
#pragma unroll
                    for (int n = 0; n < 2; ++n) {
                        const size_t off = (size_t)row * 2048 + col0 + bj * HALF + n * 16;
                        const u32x2 r = *(const u32x2*)(base16 + off);
                        const f32x4 v = (f32x4){__builtin_bit_cast(float, r.x << 16), __builtin_bit_cast(float, r.x & 0xffff0000u), __builtin_bit_cast(float, r.y << 16), __builtin_bit_cast(float, r.y & 0xffff0000u)} + acc[ai][bj][m][n] * scale;
                        acc[ai][bj][m][n] = v; ss += (v[0] * v[0] + v[1] * v[1]) + (v[2] * v[2] + v[3] * v[3]);
                    }
                ss += __shfl_xor(ss, 16); ss += __shfl_xor(ss, 32);
                if (fq == 0) atomicAdd(rowss + row, ss);
            }
        asm volatile("s_waitcnt vmcnt(0)" ::: "memory");
        __syncthreads();
        if (threadIdx.x == 0) {
            unsigned* c = cnt + 64 * u.pm;
            __builtin_amdgcn_fence(__ATOMIC_RELEASE, "agent"); asm volatile("s_waitcnt vmcnt(0)" ::: "memory");
            __hip_atomic_fetch_add(c, 1u, __ATOMIC_RELAXED, __HIP_MEMORY_SCOPE_AGENT);
            unsigned spins = 0;
            while (__hip_atomic_load(c, __ATOMIC_RELAXED, __HIP_MEMORY_SCOPE_AGENT) < 8u) { __builtin_amdgcn_s_sleep(2); if (++spins > (1u << 22)) break; }
            __builtin_amdgcn_fence(__ATOMIC_ACQUIRE, "agent"); asm volatile("s_waitcnt vmcnt(0)" ::: "memory");
        }
        __syncthreads();
#pragma unroll
        for (int ai = 0; ai < 2; ++ai)
#pragma unroll
            for (int m = 0; m < 4; ++m) {
                const int row = row0 + ai * HALF + m * 16; const float rs = rstd_of(__hip_atomic_load(rowss + row, __ATOMIC_RELAXED, __HIP_MEMORY_SCOPE_AGENT));
#pragma unroll
                for (int bj = 0; bj < 2; ++bj)
#pragma unroll
                    for (int n = 0; n < 2; ++n) {
                        const int col = col0 + bj * HALF + n * 16; const f32x4 gg = *(const f32x4*)(g + col);
                        *(f32x4*)(out + (size_t)row * 2048 + col) = acc[ai][bj][m][n] * rs * gg;
                    }
            }
    }
};
template <class Epi, class Sched, bool ALIGN_EPI = false, bool SP2 = false>
__device__ __forceinline__ void gemm_phase(PG8_LAS unsigned char* lds, const Gemm g, const Sched& S, const Epi& E) {
    int tid_ = threadIdx.x; asm volatile("" : "+v"(tid_));
    const int tid = tid_, wid = __builtin_amdgcn_readfirstlane(tid >> 6), lane = tid & 63, wr = wid >> 2, wc = wid & 3, fr = lane & 15, fq = lane >> 4;
    const int K = g.K, nt = K / BK;
    unsigned voffA[2], voffB[2];
#pragma unroll
    for (int i = 0; i < 2; ++i) { int R, C; stage_rc(tid * 16 + i * 8192, R, C); const int Rb = Epi::PERM ? ((R & ~31) + perm32(R & 31)) : R;
        voffA[i] = (unsigned)(R * K + C) * 2u; voffB[i] = (unsigned)(Rb * K + C) * 2u; }
    const size_t kstep = (size_t)(BK * 2);
    const size_t hstep = (size_t)HALF * K * 2;
    const size_t tstep = 2 * hstep;
    const unsigned ldsw = (unsigned)wid * 1024u;
    const int aoff = lds_byte(wr * 64 + fr, fq * 8), boff = lds_byte(wc * 32 + fr, fq * 8);
#define PG8_SA(b, h) (((b) * 2 + (h)) * HTB)
#define PG8_SB(b, h) ((4 + (b) * 2 + (h)) * HTB)
#define PG8_STAGE(bufoff, gbase, voff) do { _Pragma("unroll") for (int _i = 0; _i < 2; ++_i) \
        __builtin_amdgcn_global_load_lds((const unsigned*)((const char*)(gbase) + (voff)[_i]), (PG8_LAS unsigned*)(lds + (bufoff) + ldsw + _i * 8192), 16, 0, 0); } while (0)
#define PG8_LDA(dst, b, h) do { _Pragma("unroll") for (int m = 0; m < 4; ++m) _Pragma("unroll") for (int k = 0; k < 2; ++k) dst[m][k] = *(const PG8_LAS bf16x8*)(lds + PG8_SA(b, h) + aoff + m * 2048 + k * 1024); } while (0)
#define PG8_LDB(dst, b, h) do { _Pragma("unroll") for (int n = 0; n < 2; ++n) _Pragma("unroll") for (int k = 0; k < 2; ++k) dst[n][k] = *(const PG8_LAS bf16x8*)(lds + PG8_SB(b, h) + boff + n * 2048 + k * 1024); } while (0)
#define PG8_MMA(ai, bj, At, Bt) do { __builtin_amdgcn_s_setprio(1); _Pragma("unroll") for (int m = 0; m < 4; ++m) _Pragma("unroll") for (int n = 0; n < 2; ++n) _Pragma("unroll") for (int k = 0; k < 2; ++k) \
        acc[ai][bj][m][n] = __builtin_amdgcn_mfma_f32_16x16x32_bf16(Bt[n][k], At[m][k], acc[ai][bj][m][n], 0, 0, 0); __builtin_amdgcn_s_setprio(0); } while (0)
#define PG8_WAIT_V(n) asm volatile("s_waitcnt vmcnt(" #n ")" ::: "memory")
#define PG8_WAIT_L(n) asm volatile("s_waitcnt lgkmcnt(" #n ")" ::: "memory")
#define PG8_BAR __builtin_amdgcn_s_barrier()
#define PG8_SCHED __builtin_amdgcn_sched_barrier(0)
    Unit cur, nxt; int ui = 0;
    if (!S.next(0, cur)) return;
    f32x4 acc[2][2][4][2];
#pragma unroll
    for (int a = 0; a < 2; ++a)
#pragma unroll
        for (int b = 0; b < 2; ++b)
#pragma unroll
            for (int m = 0; m < 4; ++m)
#pragma unroll
                for (int n = 0; n < 2; ++n) acc[a][b][m][n] = (f32x4){0.f, 0.f, 0.f, 0.f};
    bf16x8 At[4][2], B0[2][2], B1[2][2];
    const char* cA = (const char*)g.A + (size_t)cur.pm * tstep; const char* cB = (const char*)g.Bt + (size_t)cur.pn * tstep;
    S.a_ready(cur);
    if constexpr (SP2) {
        PG8_STAGE(PG8_SB(0, 0), cB, voffB); PG8_STAGE(PG8_SB(0, 1), cB + hstep, voffB); PG8_STAGE(PG8_SA(0, 0), cA, voffA); PG8_STAGE(PG8_SA(0, 1), cA + hstep, voffA);
        if (wr == 1) PG8_BAR;
        PG8_WAIT_V(2); PG8_BAR;
        PG8_STAGE(PG8_SB(1, 0), cB + kstep, voffB); PG8_STAGE(PG8_SA(1, 0), cA + kstep, voffA); PG8_STAGE(PG8_SB(1, 1), cB + hstep + kstep, voffB);
        PG8_WAIT_V(6); PG8_BAR;
    } else {
        PG8_STAGE(PG8_SB(0, 0), cB, voffB); PG8_STAGE(PG8_SA(0, 0), cA, voffA); PG8_STAGE(PG8_SB(0, 1), cB + hstep, voffB); PG8_STAGE(PG8_SA(0, 1), cA + hstep, voffA);
        if (wr == 1) PG8_BAR;
        PG8_WAIT_V(4); PG8_BAR;
        PG8_STAGE(PG8_SB(1, 0), cB + kstep, voffB); PG8_STAGE(PG8_SA(1, 0), cA + kstep, voffA); PG8_STAGE(PG8_SB(1, 1), cB + hstep + kstep, voffB);
        PG8_WAIT_V(6); PG8_BAR;
    }
    for (;;) {
        const bool has_next = S.next(ui + 1, nxt);
        const char* nA = has_next ? (const char*)g.A + (size_t)nxt.pm * tstep : cA; const char* nB = has_next ? (const char*)g.Bt + (size_t)nxt.pn * tstep : cB;
        for (int t = 0; t < nt; t += 2) {
            const bool last = (t == nt - 2);
            const char* a1 = cA + (size_t)(t + 1) * kstep;
            const char* a2 = last ? nA : cA + (size_t)(t + 2) * kstep; const char* b2 = last ? nB : cB + (size_t)(t + 2) * kstep;
            const char* a3 = a2 + kstep; const char* b3 = b2 + kstep;
            if (last && has_next) S.a_ready(nxt);
            if constexpr (SP2) {
            PG8_LDB(B0, 0, 0); PG8_LDB(B1, 0, 1); PG8_SCHED; PG8_LDA(At, 0, 0); PG8_STAGE(PG8_SA(1, 1), a1 + hstep, voffA);
            PG8_WAIT_V(8); PG8_WAIT_L(0); PG8_BAR; PG8_MMA(0, 0, At, B0); PG8_MMA(0, 1, At, B1); PG8_BAR; PG8_SCHED;
            PG8_LDA(At, 0, 1); PG8_STAGE(PG8_SB(0, 0), b2, voffB); PG8_STAGE(PG8_SB(0, 1), b2 + hstep, voffB); PG8_STAGE(PG8_SA(0, 0), a2, voffA);
            PG8_WAIT_V(8); PG8_WAIT_L(0); PG8_BAR; PG8_MMA(1, 0, At, B0); PG8_MMA(1, 1, At, B1); PG8_BAR; PG8_SCHED;
            PG8_LDB(B0, 1, 0); PG8_LDB(B1, 1, 1); PG8_SCHED; PG8_LDA(At, 1, 0); PG8_STAGE(PG8_SA(0, 1), a2 + hstep, voffA);
            PG8_WAIT_V(8); PG8_WAIT_L(0); PG8_BAR; PG8_MMA(0, 0, At, B0); PG8_MMA(0, 1, At, B1); PG8_BAR; PG8_SCHED;
            PG8_LDA(At, 1, 1); PG8_STAGE(PG8_SB(1, 0), b3, voffB); PG8_STAGE(PG8_SB(1, 1), b3 + hstep, voffB); PG8_STAGE(PG8_SA(1, 0), a3, voffA);
            PG8_WAIT_V(8); PG8_WAIT_L(0); PG8_BAR; PG8_MMA(1, 0, At, B0); PG8_MMA(1, 1, At, B1); PG8_BAR; PG8_SCHED;
            } else {
            PG8_LDB(B0, 0, 0); PG8_SCHED; PG8_LDA(At, 0, 0); PG8_STAGE(PG8_SA(1, 1), a1 + hstep, voffA);
            PG8_WAIT_L(8); PG8_BAR; PG8_WAIT_L(0); PG8_MMA(0, 0, At, B0); PG8_BAR; PG8_SCHED;
            PG8_LDB(B1, 0, 1); PG8_STAGE(PG8_SB(0, 0), b2, voffB);
            PG8_BAR; PG8_WAIT_L(0); PG8_MMA(0, 1, At, B1); PG8_BAR;
            PG8_LDA(At, 0, 1); PG8_STAGE(PG8_SA(0, 0), a2, voffA);
            PG8_BAR; PG8_WAIT_L(0); PG8_MMA(1, 0, At, B0); PG8_BAR; PG8_SCHED;
            PG8_STAGE(PG8_SB(0, 1), b2 + hstep, voffB);
            PG8_WAIT_V(6); PG8_BAR; PG8_MMA(1, 1, At, B1); PG8_BAR;
            PG8_LDB(B0, 1, 0); PG8_SCHED; PG8_LDA(At, 1, 0); PG8_STAGE(PG8_SA(0, 1), a2 + hstep, voffA);
            PG8_WAIT_L(8); PG8_BAR; PG8_WAIT_L(0); PG8_MMA(0, 0, At, B0); PG8_BAR; PG8_SCHED;
            PG8_LDB(B1, 1, 1); PG8_STAGE(PG8_SB(1, 0), b3, voffB);
            PG8_BAR; PG8_WAIT_L(0); PG8_MMA(0, 1, At, B1); PG8_BAR;
            PG8_LDA(At, 1, 1); PG8_STAGE(PG8_SA(1, 0), a3, voffA);
            PG8_BAR; PG8_WAIT_L(0); PG8_MMA(1, 0, At, B0); PG8_BAR; PG8_SCHED;
            PG8_STAGE(PG8_SB(1, 1), b3 + hstep, voffB);
            PG8_WAIT_V(6); PG8_BAR; PG8_MMA(1, 1, At, B1); PG8_BAR;
            }
        }
        if constexpr (ALIGN_EPI) { if (wr == 0) PG8_BAR; }
        if constexpr (!Epi::AFTER_DRAIN) { E(acc, cur, wr, wc, fr, fq); S.done(cur); }
        if (!has_next) break;
#pragma unroll
        for (int a = 0; a < 2; ++a)
#pragma unroll
            for (int b = 0; b < 2; ++b)
#pragma unroll
                for (int m = 0; m < 4; ++m)
#pragma unroll
                    for (int n = 0; n < 2; ++n) acc[a][b][m][n] = (f32x4){0.f, 0.f, 0.f, 0.f};
        cur = nxt; cA = nA; cB = nB; ++ui;
        if constexpr (ALIGN_EPI) { if (wr == 1) PG8_BAR; }
    }
    PG8_WAIT_V(0);
    if constexpr (!ALIGN_EPI) { if (wr == 0) PG8_BAR; }
    PG8_BAR;
    if constexpr (Epi::AFTER_DRAIN) { E.fused(acc, cur, wr, wc, fr, fq, lds, wid, lane); S.done(cur); }
#undef PG8_SA
#undef PG8_SB
#undef PG8_STAGE
#undef PG8_LDA
#undef PG8_LDB
#undef PG8_MMA
#undef PG8_WAIT_V
#undef PG8_WAIT_L
#undef PG8_BAR
#undef PG8_SCHED
}
}
using pg8::silu_f;

constexpr int L = 8192, DM = 2048, FF = 5632, NIN = 6176, NING = 6144, HYW = 1024;
constexpr int PHY_LD = 3072, PR_LD = 3072;
constexpr int PR_Q = 0, PR_K = 512, PR_V = 1024, PR_R = 2048;
constexpr int NT = 512;
constexpr int LDS_BYTES = 147456;
constexpr int FN = 16384;

constexpr size_t MiB = 1u << 20;
constexpr size_t WS_ROWSS = 0;
constexpr size_t WS_DEC = 128 * 1024;
constexpr size_t WS_PCNT = 640 * 1024 + 16384;
constexpr size_t WS_BAR = 640 * 1024;
constexpr size_t WS_W4T = 1 * MiB;
constexpr size_t WS_HID = 2 * MiB;
constexpr size_t WS_SK = 6 * MiB;
constexpr size_t SK_STRIDE = 8448;
constexpr size_t WS_WFF = 39 * MiB;
constexpr size_t WS_WDN = WS_WFF + 44 * MiB;
constexpr size_t WS_ST = WS_WFF;
constexpr size_t WS_WIN = 105 * MiB;
constexpr size_t WS_WOUT = 130 * MiB;
constexpr size_t WS_XB = 138 * MiB;
constexpr size_t WS_A = 170 * MiB;
constexpr size_t WS_ZT = WS_A;
constexpr size_t WS_X0T = WS_A + 32 * MiB;
constexpr size_t WS_PHY = 258 * MiB;
constexpr size_t WS_MIX = WS_PHY;
constexpr size_t WS_PR = 306 * MiB;
constexpr size_t WS_LR = WS_PR + 48 * MiB;
constexpr size_t WS_T0 = WS_PR + 49 * MiB;
constexpr size_t WS_END = 358 * MiB;

typedef unsigned short bf16_t;
typedef short bf16x8 __attribute__((ext_vector_type(8)));
typedef float f32x4 __attribute__((ext_vector_type(4)));
typedef unsigned u32x4 __attribute__((ext_vector_type(4)));
typedef unsigned u32x2 __attribute__((ext_vector_type(2)));
#define LAS __attribute__((address_space(3)))
typedef float c2 __attribute__((ext_vector_type(2)));
__device__ __forceinline__ c2 mk2(float a, float b) { return (c2){a, b}; }
#define LDS_WAIT() asm volatile("s_waitcnt lgkmcnt(0)" ::: "memory")

__device__ __forceinline__ unsigned f2bf(float f) { unsigned u = __builtin_bit_cast(unsigned, f); return (u + 0x7fffu + ((u >> 16) & 1u)) >> 16; }
__device__ __forceinline__ unsigned pk2(float lo, float hi) { return f2bf(lo) | (f2bf(hi) << 16); }
__device__ __forceinline__ float bf2f(unsigned h) { return __builtin_bit_cast(float, h << 16); }
__device__ __forceinline__ float wave_sum(float v) {
#pragma unroll
    for (int o = 1; o < 64; o <<= 1) v += __shfl_xor(v, o);
    return v;
}

struct Params {
    const float* in[32];
    float* out;
    unsigned char* ws;
};

__device__ __forceinline__ void transpose_item(const float* __restrict__ W, int K, int N, bf16_t* __restrict__ WT, int mode, const float* __restrict__ gain, LAS float* scr, int item, int lane) {
    const int nblk = N / 32, kb = item / nblk, nb = item % nblk, k0 = 64 * kb, n0 = 32 * nb;
    const int drow0 = mode == 0 ? n0 : (256 * (n0 >> 7) + (n0 & 127) + (mode == 2 ? 128 : 0));
    const int c = lane & 7;
    f32x4 g0 = (f32x4){1.f, 1.f, 1.f, 1.f}, g1 = g0;
    if (gain) { g0 = *(const f32x4*)(gain + k0 + 8 * c); g1 = *(const f32x4*)(gain + k0 + 8 * c + 4); }
    float v[32];
    const float* wp = W + (size_t)(k0 + (lane >> 5)) * N + n0 + (lane & 31);
#pragma unroll
    for (int i = 0; i < 32; ++i) v[i] = __builtin_nontemporal_load(wp + (size_t)(2 * i) * N);
#pragma unroll
    for (int i = 0; i < 32; ++i) scr[(2 * i + (lane >> 5)) * 33 + (lane & 31)] = v[i];
    LDS_WAIT(); asm volatile("" ::: "memory");
#pragma unroll
    for (int j = 0; j < 4; ++j) { const int n = (lane >> 3) + 8 * j; const LAS float* s = scr + (8 * c) * 33 + n;
        u32x4 o; o.x = pk2(s[0 * 33] * g0[0], s[1 * 33] * g0[1]); o.y = pk2(s[2 * 33] * g0[2], s[3 * 33] * g0[3]); o.z = pk2(s[4 * 33] * g1[0], s[5 * 33] * g1[1]); o.w = pk2(s[6 * 33] * g1[2], s[7 * 33] * g1[3]);
        *(u32x4*)(WT + (size_t)(drow0 + n) * K + k0 + 8 * c) = o; }
    LDS_WAIT(); asm volatile("" ::: "memory");
}
constexpr int IT_FF = (DM / 64) * (FF / 32);
__device__ __forceinline__ void convert_gu(const float* wg, const float* wu, const float* gain, unsigned char* ws, LAS unsigned char* lds, int gw, int ngw, int lane, int wave) {
    LAS float* scr = (LAS float*)(lds + wave * 8448); bf16_t* WGU = (bf16_t*)(ws + WS_WFF);
#pragma unroll 1
    for (int it = gw; it < 2 * IT_FF; it += ngw) { if (it < IT_FF) transpose_item(wg, DM, FF, WGU, 1, gain, scr, it, lane); else transpose_item(wu, DM, FF, WGU, 2, gain, scr, it - IT_FF, lane); }
}
__device__ __forceinline__ void convert_dn(const float* wd, unsigned char* ws, LAS unsigned char* lds, int gw, int ngw, int lane, int wave) {
    LAS float* scr = (LAS float*)(lds + wave * 8448); bf16_t* WDN = (bf16_t*)(ws + WS_WDN);
#pragma unroll 1
    for (int it = gw; it < IT_FF; it += ngw) transpose_item(wd, FF, DM, WDN, 0, nullptr, scr, it, lane);
}
__device__ __forceinline__ void convert_tail1(const Params& p, LAS unsigned char* lds, int gw, int ngw, int lane, int wave) {
    LAS float* scr = (LAS float*)(lds + wave * 8448); unsigned char* ws = p.ws;
    constexpr int IT_IN = (DM / 64) * (NIN / 32), IT_OUT = (DM / 64) * (DM / 32);
#pragma unroll 1
    for (int it = gw; it < IT_FF + IT_IN + IT_OUT; it += ngw) {
        if (it < IT_FF) transpose_item(p.in[4], FF, DM, (bf16_t*)(ws + WS_WDN), 0, nullptr, scr, it, lane);
        else if (it < IT_FF + IT_IN) transpose_item(p.in[6], DM, NIN, (bf16_t*)(ws + WS_WIN), 0, p.in[5], scr, it - IT_FF, lane);
        else transpose_item(p.in[26], DM, DM, (bf16_t*)(ws + WS_WOUT), 0, nullptr, scr, it - IT_FF - IT_IN, lane);
    }
}
__device__ __forceinline__ void hid_pass(const Params& p, LAS float* sm, const LAS float* WL, int pos0, int tid) {
    const float* b1 = p.in[10]; const float* f1 = p.in[11]; const float* b2 = p.in[13]; const float* f2 = p.in[14]; const float* b3 = p.in[16]; const float* f3 = p.in[17];
    bf16_t* hidx = (bf16_t*)(p.ws + WS_HID);
    const int pp = tid >> 6, j = tid & 63, pos = pos0 + pp;
    LAS float* Z = sm; LAS float* H1 = sm + 512; LAS float* H2 = sm + 1024;
    const LAS float* w1 = WL; const LAS float* w2 = WL + 33 * 64; const LAS float* w3 = w2 + 64 * 64;
    if (j < 33) {
        float z;
        if (j == 0) z = (float)pos / 8191.0f;
        else {
            const int b = (j - 1) & 15; const float fj = 1e-4f + (float)b * ((15.0f - 1e-4f) / 15.0f);
            const double r = (double)pos * (double)fj * (1.0 / 8192.0); const float fr = (float)(r - floor(r));
            float s, c; sincospif(2.0f * fr, &s, &c);
            z = (j <= 16) ? c : -s;
        }
        Z[pp * 40 + j] = z;
    }
    __syncthreads();
    float a, a0 = b1[j] + Z[pp * 40 + 32] * w1[32 * 64 + j], a1 = 0.f, a2 = 0.f, a3 = 0.f;
#pragma unroll
    for (int k4 = 0; k4 < 8; ++k4) { const f32x4 h = *(const LAS f32x4*)(Z + pp * 40 + 4 * k4);
        a0 += h[0] * w1[(4 * k4 + 0) * 64 + j]; a1 += h[1] * w1[(4 * k4 + 1) * 64 + j]; a2 += h[2] * w1[(4 * k4 + 2) * 64 + j]; a3 += h[3] * w1[(4 * k4 + 3) * 64 + j]; }
    a = (a0 + a1) + (a2 + a3);
    H1[pp * 64 + j] = sinf(f1[j] * a);
    __syncthreads();
    a0 = b2[j]; a1 = 0.f; a2 = 0.f; a3 = 0.f;
#pragma unroll
    for (int k4 = 0; k4 < 16; ++k4) { const f32x4 h = *(const LAS f32x4*)(H1 + pp * 64 + 4 * k4);
        a0 += h[0] * w2[(4 * k4 + 0) * 64 + j]; a1 += h[1] * w2[(4 * k4 + 1) * 64 + j]; a2 += h[2] * w2[(4 * k4 + 2) * 64 + j]; a3 += h[3] * w2[(4 * k4 + 3) * 64 + j]; }
    a = (a0 + a1) + (a2 + a3);
    H2[pp * 64 + j] = sinf(f2[j] * a);
    __syncthreads();
    a0 = b3[j]; a1 = 0.f; a2 = 0.f; a3 = 0.f;
#pragma unroll
    for (int k4 = 0; k4 < 16; ++k4) { const f32x4 h = *(const LAS f32x4*)(H2 + pp * 64 + 4 * k4);
        a0 += h[0] * w3[(4 * k4 + 0) * 64 + j]; a1 += h[1] * w3[(4 * k4 + 1) * 64 + j]; a2 += h[2] * w3[(4 * k4 + 2) * 64 + j]; a3 += h[3] * w3[(4 * k4 + 3) * 64 + j]; }
    a = (a0 + a1) + (a2 + a3);
    { const float h3 = sinf(f3[j] * a); const unsigned hi = f2bf(h3); bf16_t* hr = hidx + (size_t)pos * 256 + j; hr[0] = (bf16_t)hi; hr[64] = (bf16_t)f2bf(h3 - bf2f(hi)); hr[128] = (bf16_t)hi; hr[192] = 0; }
}
__device__ __forceinline__ void phase0(const Params& p, LAS unsigned char* lds, int tid, int lane, int wave, int mask) {
    const int G = gridDim.x, gw = blockIdx.x * 8 + wave, ngw = G * 8;
    unsigned char* ws = p.ws;
    if (mask & 1) convert_gu(p.in[2], p.in[3], p.in[1], ws, lds, gw, ngw, lane, wave);
    const int gt = blockIdx.x * NT + tid, ngt = G * NT;
    {
      float* rs = (float*)(ws + WS_ROWSS) + L; for (int i = gt; i < 3 * L; i += ngt) rs[i] = 0.f; }
    { const float* w4 = p.in[18]; bf16_t* tx = (bf16_t*)(ws + WS_W4T);
      for (int i = gt; i < 2048 * 64; i += ngt) { const int c = i >> 6, k = i & 63; const float v = w4[k * 2048 + c]; const unsigned hi = f2bf(v); bf16_t* tr = tx + (size_t)c * 256 + k; tr[0] = (bf16_t)hi; tr[64] = (bf16_t)hi; tr[128] = (bf16_t)f2bf(v - bf2f(hi)); tr[192] = 0; } }
    if (mask & 4) {
        const float* x = p.in[0]; bf16_t* xb = (bf16_t*)(ws + WS_XB); float* rs = (float*)(ws + WS_ROWSS);
#pragma unroll 1
        for (int m = gw; m < L; m += ngw) {
            const f32x4* xr = (const f32x4*)(x + (size_t)m * DM) + lane; u32x2* o = (u32x2*)(xb + (size_t)m * DM) + lane; float s = 0.f;
#pragma unroll
            for (int j = 0; j < 8; ++j) { const f32x4 v = __builtin_nontemporal_load(xr + 64 * j); s += (v[0] * v[0] + v[1] * v[1]) + (v[2] * v[2] + v[3] * v[3]);
                u32x2 w; w.x = pk2(v[0], v[1]); w.y = pk2(v[2], v[3]); o[64 * j] = w; }
            s = wave_sum(s); if (lane == 0) rs[m] = s;
        }
    }
    __syncthreads();
    if (mask & 8) { LAS float* WL = (LAS float*)lds + 2048;
      for (int i = tid; i < 33 * 64; i += NT) WL[i] = p.in[9][i];
      for (int i = tid; i < 64 * 64; i += NT) { WL[33 * 64 + i] = p.in[12][i]; WL[33 * 64 + 64 * 64 + i] = p.in[15][i]; }
      __syncthreads();
#pragma unroll 1
      for (int ps = blockIdx.x; ps < L / 8; ps += G) { hid_pass(p, (LAS float*)lds, WL, ps * 8, tid); __syncthreads(); } }
}

__device__ __forceinline__ void convT_fetch(const bf16_t* phy, int tile, int tid, u32x4 (&rw)[4]) {
    const int t0 = (tile >> 4) * 64, c0 = (tile & 15) * 64;
#pragma unroll
    for (int k = 0; k < 4; ++k) { const int idx = tid + NT * k; rw[k] = (u32x4){0u, 0u, 0u, 0u};
        if (idx < 3 * 66 * 8) { const int s = idx / 528, r = (idx % 528) >> 3, c8 = (idx & 7) * 8, tt = t0 - 1 + r;
            if (tt >= 0 && tt < L) rw[k] = *(const u32x4*)(phy + (size_t)tt * PHY_LD + s * HYW + c0 + c8); } }
}
__device__ __forceinline__ void convT_tile(const Params& p, LAS unsigned char* lds, int tile, int tid, const u32x4 (&rw)[4]) {
    bf16_t* zT = (bf16_t*)(p.ws + WS_ZT); bf16_t* x0T = (bf16_t*)(p.ws + WS_X0T);
    const float* cw = p.in[7]; const float* cb = p.in[8];
    LAS float* zt = (LAS float*)lds; LAS float* xt = zt + 64 * 65;
    LAS bf16_t* raw = (LAS bf16_t*)(lds + 33280);
    const int t0 = (tile >> 4) * 64, c0 = (tile & 15) * 64;
#pragma unroll
    for (int k = 0; k < 4; ++k) { const int idx = tid + NT * k; if (idx < 3 * 66 * 8) { const int s = idx / 528, r = (idx % 528) >> 3, c8 = (idx & 7) * 8; *(LAS u32x4*)(raw + (s * 66 + r) * 64 + c8) = rw[k]; } }
    const int c = tid & 63, tg = tid >> 6;
    float w[3][3], b[3];
#pragma unroll
    for (int s = 0; s < 3; ++s) { const int col = s * HYW + c0 + c; b[s] = cb[col];
#pragma unroll
        for (int tap = 0; tap < 3; ++tap) w[s][tap] = cw[tap * 3 * HYW + col]; }
    __syncthreads();
#pragma unroll
    for (int i = 0; i < 8; ++i) {
        const int tl = tg * 8 + i; float u[3];
#pragma unroll
        for (int s = 0; s < 3; ++s) { float a = b[s];
#pragma unroll
            for (int tap = 0; tap < 3; ++tap) a += w[s][tap] * bf2f(raw[(s * 66 + tl + tap) * 64 + c]);
            u[s] = a; }
        zt[c * 65 + tl] = u[2] * u[1]; xt[c * 65 + tl] = u[0];
    }
    __syncthreads();
    { const int t = tid & 63, cg8 = tid >> 6;
#pragma unroll
      for (int i = 0; i < 8; ++i) { const int cc = cg8 * 8 + i; zT[(size_t)(c0 + cc) * L + t0 + t] = (bf16_t)f2bf(zt[cc * 65 + t]); x0T[(size_t)(c0 + cc) * L + t0 + t] = (bf16_t)f2bf(xt[cc * 65 + t]); } }
    __syncthreads();
}

__device__ __forceinline__ float logsig16(float x) { return (fminf(x, 0.f) - __logf(1.0f + __expf(-fabsf(x)))) * (1.0f / 16.0f); }
__device__ __forceinline__ bf16x8 ldfrag(const LAS bf16_t* base, int ld, int row0, int k0, int lane) { return *(const LAS bf16x8*)(base + (row0 + (lane & 15)) * ld + k0 + 8 * (lane >> 4)); }

__device__ __forceinline__ void gla_stage(const bf16_t* pr, const float* lr, int t0, int h, LAS float* lrs, LAS bf16_t* vT, int tid) {
    *(LAS f32x4*)(lrs + tid * 4) = *(const f32x4*)(lr + (size_t)t0 * 32 + tid * 4);
    { const int c = tid & 255, tb = tid >> 8; const bf16_t* vp = pr + (size_t)t0 * PR_LD + PR_V + h * 256 + c;
#pragma unroll
      for (int i = 0; i < 4; ++i) { const int tk = (tb * 4 + i) * 8; unsigned short e[8];
#pragma unroll
          for (int j = 0; j < 8; ++j) e[j] = vp[(size_t)(tk + j) * PR_LD];
          u32x4 w; w.x = e[0] | ((unsigned)e[1] << 16); w.y = e[2] | ((unsigned)e[3] << 16); w.z = e[4] | ((unsigned)e[5] << 16); w.w = e[6] | ((unsigned)e[7] << 16);
          *(LAS u32x4*)(vT + c * 72 + tk) = w; } }
}
struct GateW { float w[16]; float b; };
__device__ __forceinline__ void gate_load(const Params& p, int dir, int h, int d, GateW& g) {
    const float* wa = dir ? p.in[23] : p.in[21]; const float* ba = dir ? p.in[24] : p.in[22];
#pragma unroll
    for (int r = 0; r < 16; ++r) g.w[r] = wa[r * 512 + h * 128 + d];
    g.b = ba[h * 128 + d];
}
__device__ __forceinline__ float gate_eval(const GateW& g, const LAS float* lr) {
    const LAS f32x4* l4 = (const LAS f32x4*)lr; const f32x4 a = l4[0], b = l4[1], c = l4[2], d = l4[3];
    float x0 = g.b, x1 = 0.f, x2 = 0.f, x3 = 0.f;
#pragma unroll
    for (int r = 0; r < 4; ++r) { x0 += a[r] * g.w[r]; x1 += b[r] * g.w[4 + r]; x2 += c[r] * g.w[8 + r]; x3 += d[r] * g.w[12 + r]; }
    return logsig16((x0 + x1) + (x2 + x3));
}

__device__ __forceinline__ void gla_kv_item(const Params& p, LAS unsigned char* lds, int item, int tid, int lane, int wave) {
    const int h = item & 3, n = item >> 2, t0 = n * 64;
    const bf16_t* pr = (const bf16_t*)(p.ws + WS_PR); bf16_t* ST = (bf16_t*)(p.ws + WS_ST); float* dec = (float*)(p.ws + WS_DEC);
    LAS bf16_t* vT = (LAS bf16_t*)lds; LAS bf16_t* kstT = (LAS bf16_t*)(lds + 36864);
    LAS float* lrs = (LAS float*)(lds + 73728); LAS float* tot = (LAS float*)(lds + 81920);
    gla_stage(pr, (const float*)(p.ws + WS_LR), t0, h, lrs, vT, tid);
    const int d = tid & 127, dir = (tid >> 7) & 1, half = tid >> 8;
    GateW gw; gate_load(p, dir, h, d, gw);
    const bf16_t* kp = pr + (size_t)t0 * PR_LD + PR_K + h * 128 + d;
    unsigned short kr[8];
#pragma unroll
    for (int u = 0; u < 8; ++u) { const int q = half * 32 + u, t = dir ? 63 - q : q; kr[u] = kp[(size_t)t * PR_LD]; }
    __syncthreads();
    {
        float b = 0.f;
#pragma unroll 1
        for (int sg = 0; sg < 4; ++sg) {
            unsigned short kn[8];
#pragma unroll
            for (int u = 0; u < 8; ++u) { const int q = half * 32 + ((sg * 8 + 8 + u) & 31), t = dir ? 63 - q : q; kn[u] = kp[(size_t)t * PR_LD]; }
            unsigned ke[8];
#pragma unroll
            for (int u = 0; u < 8; ++u) { const int q = half * 32 + sg * 8 + u, t = dir ? 63 - q : q; b += gate_eval(gw, lrs + t * 32 + dir * 16);
                ke[dir ? 7 - u : u] = f2bf(bf2f(kr[u]) * __expf(-b)); }
            { const int q0 = half * 32 + sg * 8, tlo = dir ? 63 - q0 - 7 : q0; u32x4 w; w.x = ke[0] | (ke[1] << 16); w.y = ke[2] | (ke[3] << 16); w.z = ke[4] | (ke[5] << 16); w.w = ke[6] | (ke[7] << 16);
              *(LAS u32x4*)(kstT + (dir * 128 + d) * 72 + tlo) = w; }
#pragma unroll
            for (int u = 0; u < 8; ++u) kr[u] = kn[u];
        }
        tot[(dir * 2 + half) * 128 + d] = b;
    }
    __syncthreads();
    if (half == 0) { const float T0 = tot[(dir * 2 + 0) * 128 + d]; const size_t ti = ((size_t)(dir * 128 + n) * 4 + h) * 128 + d;
        dec[ti] = __expf(T0 + tot[(dir * 2 + 1) * 128 + d]); ((float*)(p.ws + WS_T0))[ti] = T0; }
    const int q4 = lane >> 4, v0 = wave * 32;
#pragma unroll 1
    for (int dr = 0; dr < 2; ++dr) {
        f32x4 acc[8][2];
#pragma unroll
        for (int mt = 0; mt < 8; ++mt) { acc[mt][0] = (f32x4){0.f, 0.f, 0.f, 0.f}; acc[mt][1] = (f32x4){0.f, 0.f, 0.f, 0.f}; }
#pragma unroll
        for (int ks = 0; ks < 2; ++ks) {
            const bf16x8 b0 = ldfrag(vT, 72, v0, 32 * ks, lane), b1 = ldfrag(vT, 72, v0 + 16, 32 * ks, lane);
#pragma unroll
            for (int mt = 0; mt < 8; ++mt) { const bf16x8 a = ldfrag(kstT + dr * 128 * 72, 72, 16 * mt, 32 * ks, lane);
                acc[mt][0] = __builtin_amdgcn_mfma_f32_16x16x32_bf16(a, b0, acc[mt][0], 0, 0, 0);
                acc[mt][1] = __builtin_amdgcn_mfma_f32_16x16x32_bf16(a, b1, acc[mt][1], 0, 0, 0); }
            if (ks == 0) {
#pragma unroll
                for (int mt = 0; mt < 8; ++mt) { const f32x4 T0 = *(const LAS f32x4*)(tot + (dr * 2 + 0) * 128 + 16 * mt + 4 * q4);
                    f32x4 rt;
#pragma unroll
                    for (int r = 0; r < 4; ++r) rt[r] = __expf(dr ? -T0[r] : T0[r]);
                    acc[mt][0] *= rt; acc[mt][1] *= rt; }
            }
        }
        bf16_t* S = ST + ((size_t)(dr * 4 + h) * 128 + n) * 32768;
#pragma unroll
        for (int mt = 0; mt < 8; ++mt) {
            const f32x4 T0 = *(const LAS f32x4*)(tot + (dr * 2 + 0) * 128 + 16 * mt + 4 * q4), T1 = *(const LAS f32x4*)(tot + (dr * 2 + 1) * 128 + 16 * mt + 4 * q4);
            f32x4 s1;
#pragma unroll
            for (int r = 0; r < 4; ++r) s1[r] = __expf(dr ? T0[r] + T1[r] : T1[r]);
#pragma unroll
            for (int nt = 0; nt < 2; ++nt) { const f32x4 v = acc[mt][nt] * s1; u32x2 w; w.x = pk2(v[0], v[1]); w.y = pk2(v[2], v[3]);
                *(u32x2*)(S + (size_t)(v0 + 16 * nt + (lane & 15)) * 128 + 16 * mt + 4 * q4) = w; }
        }
    }
    __syncthreads();
}

#ifndef REP_FA
#define REP_FA 0
#endif
#ifndef REP_FB
#define REP_FB 0
#endif
__device__ __forceinline__ void lr_task(const Params& p, LAS unsigned char* lds, int task, int tid, int lane, int wave) {
    const bf16_t* xb = (const bf16_t*)(p.ws + WS_XB); const bf16_t* wt = (const bf16_t*)(p.ws + WS_WIN) + (size_t)NING * DM;
    const float* rowss1 = (const float*)(p.ws + WS_ROWSS) + L; float* lr = (float*)(p.ws + WS_LR);
    const int mt = wave >> 2, nt = (wave >> 1) & 1, kh = wave & 1, fr = lane & 15, q4 = lane >> 4, t0 = task * 32;
    const bf16_t* ap = xb + (size_t)(t0 + 16 * mt + fr) * DM + kh * 1024 + 8 * q4; const bf16_t* bp = wt + (size_t)(16 * nt + fr) * DM + kh * 1024 + 8 * q4;
    f32x4 acc = (f32x4){0.f, 0.f, 0.f, 0.f};
#pragma unroll 1
    for (int kb = 0; kb < 2; ++kb) { bf16x8 a[16], b[16];
#pragma unroll
        for (int u = 0; u < 16; ++u) { a[u] = *(const bf16x8*)(ap + (kb * 16 + u) * 32); b[u] = *(const bf16x8*)(bp + (kb * 16 + u) * 32); }
#pragma unroll
        for (int u = 0; u < 16; ++u) acc = __builtin_amdgcn_mfma_f32_16x16x32_bf16(a[u], b[u], acc, 0, 0, 0); }
    LAS f32x4* ex = (LAS f32x4*)lds;
    if (kh) ex[(wave >> 1) * 64 + lane] = acc;
    __syncthreads();
    if (!kh) { const f32x4 o = ex[(wave >> 1) * 64 + lane];
#pragma unroll
        for (int r = 0; r < 4; ++r) { const int t = t0 + 16 * mt + 4 * q4 + r; lr[(size_t)t * 32 + 16 * nt + fr] = (acc[r] + o[r]) * pg8::rstd_of(rowss1[t]); } }
    __syncthreads();
}
__device__ __forceinline__ c2 cmul(c2 a, c2 b) { return mk2(a.x * b.x - a.y * b.y, a.x * b.y + a.y * b.x); }
__device__ __forceinline__ c2 twid(int m) { const float r = (float)m * (1.0f / 16384.0f); return mk2(__builtin_amdgcn_cosf(r), -__builtin_amdgcn_sinf(r)); }
__device__ __forceinline__ c2 cmulc(c2 a, c2 b) { return mk2(a.x * b.x + a.y * b.y, a.y * b.x - a.x * b.y); }
#define XI(i) ((i) + ((i) >> 5))
constexpr int XPAD_BYTES = (FN + FN / 32) * 8;
__constant__ const float C16c[8] = {1.f, 0.9238795325112867f, 0.7071067811865476f, 0.3826834323650898f, 0.f, -0.3826834323650898f, -0.7071067811865476f, -0.9238795325112867f};
__constant__ const float C16s[8] = {0.f, 0.3826834323650898f, 0.7071067811865476f, 0.9238795325112867f, 1.f, 0.9238795325112867f, 0.7071067811865476f, 0.3826834323650898f};
template <int R, bool INV, int UNR> __device__ __forceinline__ void fft_pass(LAS c2* X, int lo, int tid) {
    constexpr int RAD = 1 << R;
    const int stride = 1 << lo, ls = lo + R - 1;
    int tt = tid; asm volatile("" : "+v"(tt));
#pragma unroll 1
    for (int g = tt; g < FN / RAD; g += NT) {
        const int j0 = g & (stride - 1), i = ((g - j0) << R) + j0;
        c2 e[RAD];
#pragma unroll
        for (int q = 0; q < RAD; ++q) e[q] = X[XI(i + q * stride)];
#pragma unroll
        for (int t = 0; t < R; ++t) {
            const int Hq = INV ? (1 << t) : (RAD >> (t + 1));
            const c2 base = twid(j0 << (INV ? (13 - lo - t) : (13 - ls + t)));
#pragma unroll
            for (int bf = 0; bf < RAD / 2; ++bf) {
                const int qm = bf & (Hq - 1), q = ((bf - qm) << 1) + qm, k16 = qm * (8 / Hq);
                const c2 w = (k16 == 0) ? base : cmul(base, mk2(C16c[k16], -C16s[k16]));
                if (!INV) { const c2 a = e[q], b = e[q + Hq]; e[q] = a + b; e[q + Hq] = cmul(a - b, w); }
                else { const c2 a = e[q], b = cmulc(e[q + Hq], w); e[q] = a + b; e[q + Hq] = a - b; }
            }
        }
#pragma unroll
        for (int q = 0; q < RAD; ++q) X[XI(i + q * stride)] = e[q];
    }
    __syncthreads();
}
__device__ __forceinline__ void fft_dif(LAS c2* X, int tid) { fft_pass<4, false, 2>(X, 10, tid); fft_pass<4, false, 2>(X, 6, tid); fft_pass<4, false, 2>(X, 2, tid); fft_pass<2, false, 4>(X, 0, tid); }
__device__ __forceinline__ void fft_dit_inv(LAS c2* X, int tid) { fft_pass<2, true, 4>(X, 0, tid); fft_pass<4, true, 2>(X, 2, tid); fft_pass<4, true, 2>(X, 6, tid); fft_pass<4, true, 2>(X, 10, tid); }
__device__ __forceinline__ int br14(int x) { return (int)(__brev((unsigned)x) >> 18); }
__device__ __forceinline__ float block_sum(float v, LAS float* red, int tid, int lane, int wave) {
    v = wave_sum(v); __syncthreads(); if (lane == 0) red[wave] = v; __syncthreads();
    float s = 0.f;
#pragma unroll
    for (int i = 0; i < 8; ++i) s += red[i];
    return s;
}
__device__ __forceinline__ void hyena_fft_pair(const Params& p, LAS unsigned char* lds, int pair, int tid, int lane, int wave) {
    const int c = pair * 2;
    const float* skip = p.in[19];
    bf16_t* zT = (bf16_t*)(p.ws + WS_ZT); const bf16_t* x0T = (const bf16_t*)(p.ws + WS_X0T);
    f32x4* SK = (f32x4*)(p.ws + WS_SK) + (size_t)blockIdx.x * SK_STRIDE;
    LAS c2* X = (LAS c2*)lds; LAS float* red = (LAS float*)(lds + XPAD_BYTES);
    const float dmin = -3.0701134573253945f, dmax = -15.350567286626973f;
    const float del0 = fabsf(dmin + (float)c * ((dmax - dmin) / 1023.0f)), del1 = fabsf(dmin + (float)(c + 1) * ((dmax - dmin) / 1023.0f));
    float n0 = 0.f, n1 = 0.f, inv0 = 0.f, inv1 = 0.f;
#pragma unroll 1
    for (int rb = 0; rb <= REP_FB; ++rb) {
    n0 = 0.f; n1 = 0.f;
    {
        const bf16_t* ff = (const bf16_t*)p.out + (size_t)c * L; const bf16_t* fb = (const bf16_t*)p.out + (size_t)(HYW + c) * L;
#pragma unroll 1
        for (int ub = 0; ub < 2; ++ub) { float f0[8], f1[8], g0[8], g1[8];
#pragma unroll
            for (int u = 0; u < 8; ++u) { const int i = tid + NT * (ub * 8 + u); f0[u] = bf2f(ff[i]); f1[u] = bf2f(ff[L + i]); g0[u] = bf2f(fb[i]); g1[u] = bf2f(fb[L + i]); }
#pragma unroll
            for (int u = 0; u < 8; ++u) { const int i = tid + NT * (ub * 8 + u);
                X[XI(i)] = mk2(f0[u], f1[u]); n0 += fabsf(f0[u]); n1 += fabsf(f1[u]);
                if (i >= 1) { X[XI(FN - i)] = mk2(g0[u], g1[u]); n0 += fabsf(g0[u]); n1 += fabsf(g1[u]); } } }
    }
    if (tid == 0) X[XI(L)] = mk2(0.f, 0.f);
    inv0 = 1.0f / block_sum(n0, red, tid, lane, wave); inv1 = 1.0f / block_sum(n1, red, tid, lane, wave);
    __syncthreads();
    fft_dif(X, tid);
#pragma unroll 2
    for (int m = tid; m < FN / 2; m += NT) { const int pp = 2 * m, k = br14(pp), pm = br14((FN - k) & (FN - 1)); const c2 F = X[XI(pp)], Fm = X[XI(pm)];
        SK[m] = (f32x4){0.5f * (F.x + Fm.x), 0.5f * (F.y - Fm.y), 0.5f * (F.y + Fm.y), -0.5f * (F.x - Fm.x)}; }
    if (tid == 0) { const c2 F = X[XI(1)]; SK[FN / 2] = (f32x4){F.x, 0.f, F.y, 0.f}; }
    __syncthreads();
    }
    { float za[16], zb[16];
#pragma unroll
      for (int u = 0; u < 16; ++u) { za[u] = bf2f(zT[(size_t)c * L + tid + NT * u]); zb[u] = bf2f(zT[(size_t)(c + 1) * L + tid + NT * u]); }
#pragma unroll
      for (int u = 0; u < 16; ++u) { X[XI(tid + NT * u)] = mk2(za[u], zb[u]); X[XI(L + tid + NT * u)] = mk2(0.f, 0.f); } }
    __syncthreads();
    fft_dif(X, tid);
#pragma unroll 2
    for (int m = tid; m < FN / 2; m += NT) {
        const int pp = 2 * m, k = br14(pp); const f32x4 kk = SK[m]; const c2 K1 = mk2(kk[0], kk[1]), K2 = mk2(kk[2], kk[3]);
        if (k == 0) { const c2 F = X[XI(0)]; X[XI(0)] = mk2(F.x * K1.x, F.y * K2.x);
            const f32x4 kh = SK[FN / 2]; const c2 F1 = X[XI(1)]; X[XI(1)] = mk2(F1.x * kh[0], F1.y * kh[2]); }
        else { const int pm = br14(FN - k); const c2 F = X[XI(pp)], Fm = X[XI(pm)];
            const c2 Z1 = mk2(0.5f * (F.x + Fm.x), 0.5f * (F.y - Fm.y)), Z2 = mk2(0.5f * (F.y + Fm.y), -0.5f * (F.x - Fm.x));
            const c2 A = cmul(Z1, K1), B = cmul(Z2, K2);
            X[XI(pp)] = mk2(A.x - B.y, A.y + B.x); X[XI(pm)] = mk2(A.x + B.y, -A.y + B.x); }
    }
    __syncthreads();
    fft_dit_inv(X, tid);
    const float sk0 = skip[c], sk1 = skip[c + 1], sc = 1.0f / (float)FN;
#pragma unroll 1
    for (int ub = 0; ub < 2; ++ub) { float z0[8], z1[8], x0[8], x1[8];
#pragma unroll
        for (int u = 0; u < 8; ++u) { const int i = tid + NT * (ub * 8 + u); const size_t o0 = (size_t)c * L + i, o1 = (size_t)(c + 1) * L + i; z0[u] = bf2f(zT[o0]); z1[u] = bf2f(zT[o1]); x0[u] = bf2f(x0T[o0]); x1[u] = bf2f(x0T[o1]); }
#pragma unroll
        for (int u = 0; u < 8; ++u) { const int i = tid + NT * (ub * 8 + u); const size_t o0 = (size_t)c * L + i, o1 = (size_t)(c + 1) * L + i; const c2 y = X[XI(i)];
            zT[o0] = (bf16_t)f2bf((y.x * sc * inv0 + sk0 * z0[u]) * x0[u]); zT[o1] = (bf16_t)f2bf((y.y * sc * inv1 + sk1 * z1[u]) * x1[u]); } }
    __syncthreads();
}
__device__ __forceinline__ void gla_scan(const Params& p, int tid) {
    unsigned* ST = (unsigned*)(p.ws + WS_ST); const float* dec = (const float*)(p.ws + WS_DEC);
    const int gt = blockIdx.x * NT + tid, ngt = gridDim.x * NT;
#pragma unroll 1
    for (int e = gt; e < 8 * 16384; e += ngt) {
        const int dh = e >> 14, idx = e & 16383, dir = dh >> 2, h = dh & 3, d = (2 * idx) & 127;
        unsigned* base = ST + (size_t)dh * 128 * 16384 + idx;
        const float* db = dec + ((size_t)dir * 128 * 4 + h) * 128 + d;
        float s0 = 0.f, s1 = 0.f;
#pragma unroll 1
        for (int nb = 0; nb < 128; nb += 16) {
            unsigned kv[16]; c2 dc[16];
#pragma unroll
            for (int u = 0; u < 16; ++u) { const int n = dir ? 127 - (nb + u) : nb + u; kv[u] = base[(size_t)n * 16384]; dc[u] = *(const c2*)(db + (size_t)n * 512); }
#pragma unroll
            for (int u = 0; u < 16; ++u) { const int n = dir ? 127 - (nb + u) : nb + u; base[(size_t)n * 16384] = pk2(s0, s1);
                s0 = dc[u].x * s0 + bf2f(kv[u] & 0xffffu); s1 = dc[u].y * s1 + bf2f(kv[u] >> 16); }
        }
    }
}

__device__ __forceinline__ void gla_out_item(const Params& p, LAS unsigned char* lds, int item, int tid, int lane, int wave) {
    const int h = item & 3, n = item >> 2, t0 = n * 64;
    const bf16_t* pr = (const bf16_t*)(p.ws + WS_PR); const bf16_t* ST = (const bf16_t*)(p.ws + WS_ST); bf16_t* mix = (bf16_t*)(p.ws + WS_MIX);
    const float* og = p.in[25];
    LAS bf16_t* qin = (LAS bf16_t*)lds;
    LAS bf16_t* kin = (LAS bf16_t*)(lds + 34816);
    LAS bf16_t* vT = (LAS bf16_t*)(lds + 69632);
    LAS bf16_t* P = (LAS bf16_t*)(lds + 106496);
    LAS float* lrs = (LAS float*)(lds + 115712); LAS float* tot = (LAS float*)(lds + 123904); LAS float* red = (LAS float*)(lds + 125952);
    gla_stage(pr, (const float*)(p.ws + WS_LR), t0, h, lrs, vT, tid);
    const int d = tid & 127, dir = (tid >> 7) & 1, half = tid >> 8;
    GateW gw; gate_load(p, dir, h, d, gw);
    const bf16_t* qp = pr + (size_t)t0 * PR_LD + PR_Q + h * 128 + d;
    unsigned short kr[8], qr[8];
#pragma unroll
    for (int u = 0; u < 8; ++u) { const int q = half * 32 + u, t = dir ? 63 - q : q; qr[u] = qp[(size_t)t * PR_LD]; kr[u] = qp[(size_t)t * PR_LD + (PR_K - PR_Q)]; }
    const float bpre = half ? ((const float*)(p.ws + WS_T0))[((size_t)(dir * 128 + n) * 4 + h) * 128 + d] : 0.f;
    __syncthreads();
    {
        float b = bpre;
#pragma unroll 1
        for (int sg = 0; sg < 4; ++sg) {
            unsigned short kn[8], qn[8];
#pragma unroll
            for (int u = 0; u < 8; ++u) { const int q = half * 32 + ((sg * 8 + 8 + u) & 31), t = dir ? 63 - q : q; qn[u] = qp[(size_t)t * PR_LD]; kn[u] = qp[(size_t)t * PR_LD + (PR_K - PR_Q)]; }
#pragma unroll
            for (int u = 0; u < 8; ++u) { const int q = half * 32 + sg * 8 + u, t = dir ? 63 - q : q; b += gate_eval(gw, lrs + t * 32 + dir * 16);
                const float qv = bf2f(qr[u]) * 0.08838834764831845f, kv = bf2f(kr[u]);
                qin[(dir * 64 + t) * 136 + d] = (bf16_t)f2bf(qv * __expf(b)); kin[(dir * 64 + t) * 136 + d] = (bf16_t)f2bf(kv * __expf(-b)); }
#pragma unroll
            for (int u = 0; u < 8; ++u) { kr[u] = kn[u]; qr[u] = qn[u]; }
        }
    }
    __syncthreads();
    const int q4 = lane >> 4, fr = lane & 15;
#pragma unroll 1
    for (int ti = 0; ti < 2; ++ti) {
        const int id = wave * 2 + ti, tt = id >> 2, st = id & 3;
        f32x4 af = (f32x4){0.f, 0.f, 0.f, 0.f}, ab = (f32x4){0.f, 0.f, 0.f, 0.f};
        if (tt >= st) {
#pragma unroll
            for (int ks = 0; ks < 4; ++ks) af = __builtin_amdgcn_mfma_f32_16x16x32_bf16(ldfrag(qin, 136, 16 * tt, 32 * ks, lane), ldfrag(kin, 136, 16 * st, 32 * ks, lane), af, 0, 0, 0); }
        if (tt <= st) {
#pragma unroll
            for (int ks = 0; ks < 4; ++ks) ab = __builtin_amdgcn_mfma_f32_16x16x32_bf16(ldfrag(qin + 64 * 136, 136, 16 * tt, 32 * ks, lane), ldfrag(kin + 64 * 136, 136, 16 * st, 32 * ks, lane), ab, 0, 0, 0); }
#pragma unroll
        for (int r = 0; r < 4; ++r) { const int t = 16 * tt + 4 * q4 + r, s = 16 * st + fr; P[t * 72 + s] = (bf16_t)f2bf(t >= s ? af[r] : ab[r]); }
    }
    __syncthreads();
    f32x4 acc[2][4];
#pragma unroll
    for (int mt = 0; mt < 2; ++mt)
#pragma unroll
        for (int nt = 0; nt < 4; ++nt) acc[mt][nt] = (f32x4){0.f, 0.f, 0.f, 0.f};
    const int v0 = wave * 32;
#pragma unroll
    for (int ks = 0; ks < 2; ++ks) {
        const bf16x8 a0 = ldfrag(vT, 72, v0, 32 * ks, lane), a1 = ldfrag(vT, 72, v0 + 16, 32 * ks, lane);
#pragma unroll
        for (int nt = 0; nt < 4; ++nt) { const bf16x8 b = ldfrag(P, 72, 16 * nt, 32 * ks, lane);
            acc[0][nt] = __builtin_amdgcn_mfma_f32_16x16x32_bf16(a0, b, acc[0][nt], 0, 0, 0); acc[1][nt] = __builtin_amdgcn_mfma_f32_16x16x32_bf16(a1, b, acc[1][nt], 0, 0, 0); }
    }
#pragma unroll 1
    for (int dr = 0; dr < 2; ++dr) {
        const bf16_t* S = ST + ((size_t)(dr * 4 + h) * 128 + n) * 32768;
        bf16x8 sa[4][2];
#pragma unroll
        for (int ks = 0; ks < 4; ++ks) { sa[ks][0] = *(const bf16x8*)(S + (size_t)(v0 + fr) * 128 + 32 * ks + 8 * q4); sa[ks][1] = *(const bf16x8*)(S + (size_t)(v0 + 16 + fr) * 128 + 32 * ks + 8 * q4); }
#pragma unroll
        for (int ks = 0; ks < 4; ++ks)
#pragma unroll
            for (int nt = 0; nt < 4; ++nt) { const bf16x8 b = ldfrag(qin + dr * 64 * 136, 136, 16 * nt, 32 * ks, lane);
                acc[0][nt] = __builtin_amdgcn_mfma_f32_16x16x32_bf16(sa[ks][0], b, acc[0][nt], 0, 0, 0); acc[1][nt] = __builtin_amdgcn_mfma_f32_16x16x32_bf16(sa[ks][1], b, acc[1][nt], 0, 0, 0); }
    }
#pragma unroll
    for (int nt = 0; nt < 4; ++nt) { float ss = 0.f;
#pragma unroll
        for (int mt = 0; mt < 2; ++mt) ss += (acc[mt][nt][0] * acc[mt][nt][0] + acc[mt][nt][1] * acc[mt][nt][1]) + (acc[mt][nt][2] * acc[mt][nt][2] + acc[mt][nt][3] * acc[mt][nt][3]);
        ss += __shfl_xor(ss, 16); ss += __shfl_xor(ss, 32);
        if (q4 == 0) red[wave * 64 + 16 * nt + fr] = ss; }
    __syncthreads();
#pragma unroll
    for (int nt = 0; nt < 4; ++nt) { const int t = 16 * nt + fr; float ss = 0.f;
#pragma unroll
        for (int w = 0; w < 8; ++w) ss += red[w * 64 + t];
        const float rs = rsqrtf(ss * (1.0f / 256.0f) + 1e-6f);
#pragma unroll
        for (int mt = 0; mt < 2; ++mt) { const int v = v0 + 16 * mt + 4 * q4; const f32x4 g = *(const f32x4*)(og + h * 256 + v);
            const u32x2 rw = *(const u32x2*)(pr + (size_t)(t0 + t) * PR_LD + PR_R + h * 256 + v);
            const float r0 = bf2f(rw.x & 0xffffu), r1 = bf2f(rw.x >> 16), r2 = bf2f(rw.y & 0xffffu), r3 = bf2f(rw.y >> 16);
            u32x2 w; w.x = pk2(acc[mt][nt][0] * rs * g[0] * silu_f(r0), acc[mt][nt][1] * rs * g[1] * silu_f(r1));
            w.y = pk2(acc[mt][nt][2] * rs * g[2] * silu_f(r2), acc[mt][nt][3] * rs * g[3] * silu_f(r3));
            *(u32x2*)(mix + (size_t)(t0 + t) * DM + HYW + h * 256 + v) = w; }
    }
    __syncthreads();
}
__device__ __forceinline__ void hynorm_tile(const Params& p, LAS unsigned char* lds, int tile, int tid) {
    const bf16_t* yT = (const bf16_t*)(p.ws + WS_ZT); bf16_t* mix = (bf16_t*)(p.ws + WS_MIX); const float* og = p.in[20];
    LAS float* yt = (LAS float*)lds; LAS float* red = yt + 128 * 65;
    const int g = tile & 7, t0 = (tile >> 3) * 64, c0 = g * 128;
    { const int t = tid & 63, cg8 = tid >> 6; float ss = 0.f;
#pragma unroll
      for (int i = 0; i < 16; ++i) { const int cc = cg8 * 16 + i; const float v = bf2f(yT[(size_t)(c0 + cc) * L + t0 + t]); yt[cc * 65 + t] = v; ss += v * v; }
      red[cg8 * 64 + t] = ss; }
    __syncthreads();
    { const int c2 = (tid & 63) * 2, tg = tid >> 6; const float g0 = og[c0 + c2], g1 = og[c0 + c2 + 1];
#pragma unroll
      for (int i = 0; i < 8; ++i) { const int t = tg * 8 + i; float ss = 0.f;
#pragma unroll
          for (int w = 0; w < 8; ++w) ss += red[w * 64 + t];
          const float rs = rsqrtf(ss * (1.0f / 128.0f) + 1e-6f);
          *(unsigned*)(mix + (size_t)(t0 + t) * DM + c0 + c2) = pk2(yt[c2 * 65 + t] * rs * g0, yt[(c2 + 1) * 65 + t] * rs * g1); } }
    __syncthreads();
}

#define XB_TMO      128
#define XB_XCNT(j)  (256  + 64 * (j))
#define XB_XSUB(j)  (1280 + 64 * (j))
#define XB_XGEN(j)  (2304 + 64 * (j))
#define XB_TOP      3328
#define XB_TOPGEN   3392
#define XCD_BAR_WORDS 3456
#define XB_SPIN_CAP (1u << 18)

__device__ __forceinline__ unsigned xb_ld(unsigned* p)              { return __hip_atomic_load(p, __ATOMIC_RELAXED, __HIP_MEMORY_SCOPE_AGENT); }
__device__ __forceinline__ unsigned xb_add(unsigned* p, unsigned v) { return __hip_atomic_fetch_add(p, v, __ATOMIC_RELAXED, __HIP_MEMORY_SCOPE_AGENT); }
__device__ __forceinline__ unsigned xb_xcc_id() { return (unsigned)__builtin_amdgcn_s_getreg((3 << 11) | 20) & 0xFu; }
#define XB_SPIN(cond, bar) do { unsigned _sp = 0; while (cond) { __builtin_amdgcn_s_sleep(1); \
    if ((++_sp & 255u) == 0u) { if (xb_ld(&(bar)[XB_TMO])) break; if (_sp > XB_SPIN_CAP) { atomicAdd(&(bar)[XB_TMO], 1u); break; } } } } while (0)

struct XcdBarrier {
    unsigned* bar; unsigned x;
    volatile LAS unsigned* st;
};

__device__ __forceinline__ XcdBarrier xcd_barrier_post(unsigned* bar, volatile LAS unsigned* st) {
    XcdBarrier b; b.bar = bar; b.x = xb_xcc_id(); b.st = st;
    if (threadIdx.x == 0) (void)xb_add(&bar[XB_XCNT(b.x)], 1u);
    return b;
}
__device__ __forceinline__ void xcd_barrier_complete(unsigned* bar, unsigned x, unsigned& nloc, unsigned& nx) {
    const unsigned G = gridDim.x * gridDim.y * gridDim.z;
    unsigned sum, cnt, mine, sp = 0u;
    for (;;) {
        sum = 0u; cnt = 0u; mine = 0u;
#pragma unroll
        for (unsigned j = 0; j < 16; ++j) { const unsigned c = xb_ld(&bar[XB_XCNT(j)]); sum += c; cnt += (c > 0u) ? 1u : 0u; mine = (j == x) ? c : mine; }
        if (sum == G) break;
        __builtin_amdgcn_s_sleep(1);
        if ((++sp & 255u) == 0u) { if (xb_ld(&bar[XB_TMO])) break; if (sp > XB_SPIN_CAP) { atomicAdd(&bar[XB_TMO], 1u); break; } }
    }
    nloc = mine > 0u ? mine : 1u; nx = cnt > 0u ? cnt : 1u;
}

__device__ __forceinline__ void xcd_barrier(const XcdBarrier& b) {
    asm volatile("s_waitcnt vmcnt(0)" ::: "memory");
    __syncthreads();
    if (threadIdx.x == 0) {
        unsigned* bar = b.bar;
        __builtin_amdgcn_s_waitcnt(0);
        unsigned nloc = b.st[0], nx = b.st[1]; const unsigned bx = b.st[2];
        if (nloc == 0u) { xcd_barrier_complete(bar, bx, nloc, nx); b.st[0] = nloc; b.st[1] = nx; }
        const unsigned old = xb_add(&bar[XB_XSUB(bx)], 1u);
        const unsigned gen = old / nloc;
        if (old + 1u == (gen + 1u) * nloc) {
            __builtin_amdgcn_fence(__ATOMIC_RELEASE, "agent");
            asm volatile("s_waitcnt vmcnt(0)" ::: "memory");
            const unsigned og = xb_add(&bar[XB_TOP], 1u);
            const unsigned tg = og / nx;
            if (og + 1u == (tg + 1u) * nx) xb_add(&bar[XB_TOPGEN], 1u);
            else XB_SPIN(xb_ld(&bar[XB_TOPGEN]) == tg, bar);
            __builtin_amdgcn_fence(__ATOMIC_ACQUIRE, "agent");
            xb_add(&bar[XB_XGEN(bx)], 1u);
            asm volatile("s_waitcnt vmcnt(0)" ::: "memory");
        } else {
            XB_SPIN(xb_ld(&bar[XB_XGEN(bx)]) == gen, bar);
            __builtin_amdgcn_fence(__ATOMIC_ACQUIRE, "agent");
            asm volatile("s_waitcnt vmcnt(0)" ::: "memory");
        }
    }
    __syncthreads();
}

#ifndef REP_P0
#define REP_P0 0
#endif
#ifndef PA_MASK
#define PA_MASK 3
#endif
#ifndef PC_MASK
#define PC_MASK 3
#endif
#ifndef REP_G1
#define REP_G1 0
#endif
#ifndef REP_G3
#define REP_G3 0
#endif
#ifndef P0_MASK
#define P0_MASK 15
#endif
#ifndef REP_PA
#define REP_PA 0
#endif
#ifndef REP_PAB
#define REP_PAB 0
#endif
#ifndef REP_PC
#define REP_PC 0
#endif
__global__ void __launch_bounds__(NT, 2) fwd_megakernel(Params p) {
    extern __shared__ __attribute__((aligned(16))) unsigned char smem[];
    LAS unsigned char* lds = (LAS unsigned char*)smem;
    cg::grid_group grid = cg::this_grid();
    const int G = gridDim.x;
    volatile LAS unsigned* bst = (volatile LAS unsigned*)(lds + LDS_BYTES - 64);
    if (threadIdx.x < 2) bst[threadIdx.x] = 0u;
    __syncthreads();
    XcdBarrier xbar = xcd_barrier_post((unsigned*)(p.ws + WS_BAR), bst);
    if (threadIdx.x == 0) bst[2] = xbar.x;
    if (p.ws == nullptr) grid.sync();
#define TIDS int tid = threadIdx.x; asm volatile("" : "+v"(tid)); const int lane = tid & 63, wave = __builtin_amdgcn_readfirstlane(tid >> 6); (void)lane; (void)wave;
    unsigned char* ws = p.ws;
    float* rowss = (float*)(ws + WS_ROWSS);
    bf16_t* XB = (bf16_t*)(ws + WS_XB); bf16_t* AB = (bf16_t*)(ws + WS_A);

#pragma unroll 1
    for (int rep = 0; rep <= REP_P0; ++rep) {
#ifndef SKIP_P0
        { TIDS; phase0(p, lds, tid, lane, wave, rep == 0 ? 15 : P0_MASK); }
#endif
        xcd_barrier(xbar); }
#ifndef NO_GEMM
#pragma unroll 1
    for (int rg = 0; rg <= REP_G1; ++rg) {
    { pg8::Gemm g{XB, (const bf16_t*)(ws + WS_WFF), L, 2 * FF, DM}; pg8::StaticOrder S; S.init(L, 2 * FF, G, (int)blockIdx.x);
      pg8::EpiSwiGLU E{AB, FF, rowss}; pg8::gemm_phase<pg8::EpiSwiGLU, pg8::StaticOrder, true, true>(lds, g, S, E); }
    { TIDS; const int rem = ((L / 256) * (2 * FF / 256)) % G, nl = rem ? G - rem : G, li = rem ? (int)blockIdx.x - rem : (int)blockIdx.x;
      if (li >= 0) convert_tail1(p, lds, li * 8 + wave, nl * 8, lane, wave); }
    xcd_barrier(xbar);
    }
    { pg8::Gemm g{AB, (const bf16_t*)(ws + WS_WDN), L, DM, FF}; pg8::StaticOrder S; S.init(L, DM, G, (int)blockIdx.x);
      pg8::EpiResid E{p.in[0], nullptr, XB, rowss + L, 0.5f}; pg8::gemm_phase<pg8::EpiResid, pg8::StaticOrder, true, true>(lds, g, S, E); }
    xcd_barrier(xbar);
#pragma unroll 1
    for (int rg = 0; rg <= REP_G3; ++rg) {
    { pg8::Gemm g{XB, (const bf16_t*)(ws + WS_WIN), L, NING, DM}; pg8::StaticOrder S; S.init(L, NING, G, (int)blockIdx.x);
      pg8::EpiP E{(bf16_t*)(ws + WS_PHY), (bf16_t*)(ws + WS_PR), rowss + L}; pg8::gemm_phase<pg8::EpiP, pg8::StaticOrder, true, true>(lds, g, S, E); }
    { TIDS; for (int it = blockIdx.x; it < L / 32; it += G) lr_task(p, lds, it, tid, lane, wave); }
    xcd_barrier(xbar);
    }
#endif
#pragma unroll 1
    for (int rep = 0; rep <= REP_PAB; ++rep) {
#pragma unroll 1
        for (int r2 = 0; r2 <= REP_PA; ++r2) {
#ifndef SKIP_PA
            { pg8::Gemm g{(const bf16_t*)(ws + WS_W4T), (const bf16_t*)(ws + WS_HID), 2048, L, 256}; pg8::StaticOrder S; S.init(2048, L, G, (int)blockIdx.x);
              pg8::EpiFilt E{(bf16_t*)p.out, (bf16_t*)p.out + (size_t)HYW * L, (bf16_t*)p.out + (size_t)(HYW + 768) * L}; pg8::gemm_phase<pg8::EpiFilt, pg8::StaticOrder, true, true>(lds, g, S, E); }
            if (r2 == 0 || (PA_MASK & 1)) { TIDS; for (int it = blockIdx.x; it < 512; it += G) gla_kv_item(p, lds, it, tid, lane, wave); }
            if (r2 == 0 || (PA_MASK & 2)) { TIDS; const bf16_t* phy = (const bf16_t*)(ws + WS_PHY); u32x4 rw[4], rn[4];
              if ((int)blockIdx.x < 2048) convT_fetch(phy, blockIdx.x, tid, rw);
#pragma unroll 1
              for (int it = blockIdx.x; it < 2048; it += G) { const bool more = it + G < 2048; if (more) convT_fetch(phy, it + G, tid, rn);
                  convT_tile(p, lds, it, tid, rw);
                  if (more) {
#pragma unroll
                      for (int k = 0; k < 4; ++k) rw[k] = rn[k]; } } }
#endif
            xcd_barrier(xbar);
        }
#ifndef SKIP_PB
#pragma unroll 1
        for (int step = 0; step < 2; ++step) {
            if ((step == 0) == (((blockIdx.x >> 3) & 1) == 0)) { TIDS; gla_scan(p, tid); }
            else { TIDS; for (int it = blockIdx.x; it < HYW / 2; it += G) hyena_fft_pair(p, lds, it, tid, lane, wave); }
        }
#endif
        xcd_barrier(xbar);
    }
#pragma unroll 1
    for (int rep = 0; rep <= REP_PC; ++rep) {
#ifndef SKIP_PC
        if (rep == 0 || (PC_MASK & 1)) { TIDS; for (int it = blockIdx.x; it < 512; it += G) gla_out_item(p, lds, it, tid, lane, wave); }
        if (rep == 0 || (PC_MASK & 2)) { TIDS; for (int it = blockIdx.x; it < 1024; it += G) hynorm_tile(p, lds, it, tid); }
#endif
        xcd_barrier(xbar);
    }
#ifndef NO_GEMM
    { pg8::Gemm g{(const bf16_t*)(ws + WS_MIX), (const bf16_t*)(ws + WS_WOUT), L, DM, DM}; pg8::StaticOrder S; S.init(L, DM, G, (int)blockIdx.x);
      pg8::EpiResid E{nullptr, XB, XB, rowss + 2 * L, 1.0f}; pg8::gemm_phase<pg8::EpiResid, pg8::StaticOrder, true, true>(lds, g, S, E); }
    __syncthreads();
    { TIDS; convert_gu(p.in[28], p.in[29], p.in[27], ws, lds, blockIdx.x * 8 + wave, G * 8, lane, wave); }
    xcd_barrier(xbar);
    { pg8::Gemm g{XB, (const bf16_t*)(ws + WS_WFF), L, 2 * FF, DM}; pg8::StaticOrder S; S.init(L, 2 * FF, G, (int)blockIdx.x);
      pg8::EpiSwiGLU E{AB, FF, rowss + 2 * L}; pg8::gemm_phase<pg8::EpiSwiGLU, pg8::StaticOrder, true, true>(lds, g, S, E); }
    { TIDS; const int rem = ((L / 256) * (2 * FF / 256)) % G, nl = rem ? G - rem : G, li = rem ? (int)blockIdx.x - rem : (int)blockIdx.x;
      if (li >= 0) convert_dn(p.in[30], ws, lds, li * 8 + wave, nl * 8, lane, wave); }
    xcd_barrier(xbar);
    { pg8::Gemm g{AB, (const bf16_t*)(ws + WS_WDN), L, DM, FF}; pg8::StaticOrder S; S.init(L, DM, G, (int)blockIdx.x);
      pg8::EpiFinal E{XB, p.out, rowss + 3 * L, (unsigned*)(ws + WS_PCNT), p.in[31], 0.5f}; pg8::gemm_phase<pg8::EpiFinal, pg8::StaticOrder, true, true>(lds, g, S, E); }
#endif
}

extern "C" void kernel_launch(void* const* d_in, const int* in_sizes, int n_in, void* d_out, int out_size, void* d_ws, size_t ws_size, hipStream_t stream) {
    static int grid = 0;
    if (grid == 0) {
        if (n_in != 32 || out_size != L * DM || ws_size < WS_END) { fprintf(stderr, "kernel_launch: unexpected problem: n_in %d out %d ws %zu (need %zu)\n", n_in, out_size, ws_size, (size_t)WS_END); grid = -1; return; }
        int dev = 0, cus = 0, per_cu = 0;
        (void)hipGetDevice(&dev); (void)hipDeviceGetAttribute(&cus, hipDeviceAttributeMultiprocessorCount, dev);
        if (hipFuncSetAttribute((const void*)fwd_megakernel, hipFuncAttributeMaxDynamicSharedMemorySize, LDS_BYTES) != hipSuccess) { fprintf(stderr, "kernel_launch: hipFuncSetAttribute failed\n"); grid = -1; return; }
        if (hipOccupancyMaxActiveBlocksPerMultiprocessor(&per_cu, (const void*)fwd_megakernel, NT, LDS_BYTES) != hipSuccess || per_cu < 1) { fprintf(stderr, "kernel_launch: occupancy query gave %d\n", per_cu); per_cu = 1; }
        (void)hipGetLastError();
        grid = cus * per_cu; if (grid > 256) grid = 256;
        if (grid != 256) { fprintf(stderr, "kernel_launch: this kernel needs a 256-workgroup cooperative grid (256 CUs x 1), got %d; nothing launched\n", grid); grid = -1; return; }
        fprintf(stderr, "kernel_launch: cus %d per_cu %d grid %d\n", cus, per_cu, grid);
    }
    if (grid < 0) return;
    Params p{};
    for (int i = 0; i < 32; ++i) p.in[i] = (const float*)d_in[i];
    p.out = (float*)d_out; p.ws = (unsigned char*)d_ws;
    if (hipMemsetAsync((char*)d_ws + WS_BAR, 0, 16384 + 32 * 256, stream) != hipSuccess) { fprintf(stderr, "kernel_launch: hipMemsetAsync failed\n"); return; }
    void* args[] = {&p};
    hipError_t e = hipLaunchCooperativeKernel((const void*)fwd_megakernel, dim3(grid), dim3(NT), args, LDS_BYTES, stream);
    if (e != hipSuccess) fprintf(stderr, "kernel_launch: cooperative launch failed: %s (grid %d)\n", hipGetErrorString(e), grid);
}
```

```cpp
#include <hip/hip_runtime.h>
#include <hip/hip_cooperative_groups.h>
#include <cstdio>
#include <cstdint>
namespace cg = cooperative_groups;

namespace pg8 {
#define PG8_LAS __attribute__((address_space(3)))
typedef unsigned short bf16_t;
typedef short bf16x8 __attribute__((ext_vector_type(8)));
typedef float f32x4 __attribute__((ext_vector_type(4)));
typedef unsigned u32x4 __attribute__((ext_vector_type(4)));
constexpr int BM = 256, BK = 64, HALF = 128, HTB = HALF * BK * 2  , STAGE_BYTES = 8 * HTB, NXCD = 8, WGM = 8;

__host__ __device__ __forceinline__ int lds_byte(int r, int c) { const int st = (r >> 4) * 2 + (c >> 5), rr = r & 15, cc = c & 31, ob = rr * 64 + cc * 2; return st * 1024 + (ob ^ (((ob >> 9) & 1) << 5)); }
__host__ __device__ __forceinline__ void stage_rc(int b, int& R, int& C) { const int st = b / 1024, sb = b % 1024, swz = sb ^ (((sb >> 9) & 1) << 5); R = (st >> 1) * 16 + swz / 64; C = (st & 1) * 32 + (swz % 64) / 2; }
__host__ __device__ __forceinline__ int perm32(int rho) { const int n = rho >> 4, i = rho & 15; return 8 * (i >> 2) + 4 * n + (i & 3); }

struct Unit { int pm, pn; };
struct Gemm { const bf16_t* A; const bf16_t* Bt; int M, N, K; };

struct StaticOrder {
    int nM, nN, nwg, G, c;
    __host__ __device__ void init(int M, int N, int G_, int c_) { nM = M / BM; nN = N / BM; nwg = nM * nN; G = G_; c = c_; }
    __host__ __device__ bool next(int i, Unit& u) const {
        const long L = (long)i * G + c; if (L >= nwg) return false;
        int wgid = (int)L; { const int q = nwg / NXCD, r = nwg % NXCD, xcd = wgid % NXCD, off = wgid / NXCD; wgid = (xcd < r ? xcd * (q + 1) : r * (q + 1) + (xcd - r) * q) + off; }
        const int nig = WGM * nN, gid = wgid / nig, fm = gid * WGM, gsz = (nM - fm) < WGM ? (nM - fm) : WGM;
        u.pm = fm + ((wgid % nig) % gsz); u.pn = (wgid % nig) / gsz; return true;
    }
    __device__ __forceinline__ void a_ready(const Unit&) const {}
    __device__ __forceinline__ void done(const Unit&) const {}
};
__device__ __forceinline__ unsigned cvt_pk_bf16(float lo, float hi) { unsigned r; asm volatile("v_cvt_pk_bf16_f32 %0, %1, %2" : "=v"(r) : "v"(lo), "v"(hi)); return r; }
typedef unsigned u32x4 __attribute__((ext_vector_type(4)));
typedef unsigned u32x2 __attribute__((ext_vector_type(2)));
__device__ __forceinline__ float rstd_of(float ss) { return rsqrtf(ss * (1.0f / 2048.0f) + 1e-6f); }
__device__ __forceinline__ float silu_f(float x) { return x * __builtin_amdgcn_rcpf(1.0f + __expf(-x)); }

struct EpiSwiGLU {
    static constexpr bool PERM = true, AFTER_DRAIN = false;
    bf16_t* O; int ldc; const float* rowss;
    __device__ __forceinline__ void operator()(const f32x4 (&acc)[2][2][4][2], const Unit& u, int wr, int wc, int fr, int fq) const {
        const int row0 = u.pm * BM + wr * 64 + fr, col0 = u.pn * 128 + wc * 32 + 8 * fq;
#pragma unroll
        for (int ai = 0; ai < 2; ++ai)
#pragma unroll
            for (int m = 0; m < 4; ++m) {
                const int row = row0 + ai * HALF + m * 16; const float rs = rstd_of(rowss[row]);
                float v[8];
#pragma unroll
                for (int n = 0; n < 2; ++n)
#pragma unroll
                    for (int j = 0; j < 4; ++j) v[n * 4 + j] = silu_f(acc[ai][0][m][n][j] * rs) * (acc[ai][1][m][n][j] * rs);
                u32x4 w; w.x = cvt_pk_bf16(v[0], v[1]); w.y = cvt_pk_bf16(v[2], v[3]); w.z = cvt_pk_bf16(v[4], v[5]); w.w = cvt_pk_bf16(v[6], v[7]);
                *(u32x4*)(O + (size_t)row * ldc + col0) = w;
            }
    }
};
struct EpiResid {
    static constexpr bool PERM = false, AFTER_DRAIN = false;
    const float* base; const bf16_t* base16; bf16_t* ob; float* rowss; float scale;
    __device__ __forceinline__ void operator()(const f32x4 (&acc)[2][2][4][2], const Unit& u, int wr, int wc, int fr, int fq) const {
        const int row0 = u.pm * BM + wr * 64 + fr, col0 = u.pn * BM + wc * 32 + 4 * fq;
#pragma unroll
        for (int ai = 0; ai < 2; ++ai)
#pragma unroll
            for (int m = 0; m < 4; ++m) {
                const int row = row0 + ai * HALF + m * 16; float ss = 0.f;
#pragma unroll
                for (int bj = 0; bj < 2; ++bj)
#pragma unroll
                    for (int n = 0; n < 2; ++n) {
                        const size_t off = (size_t)row * 2048 + col0 + bj * HALF + n * 16;
                        f32x4 b;
                        if (base) b = *(const f32x4*)(base + off);
                        else { const u32x2 r = *(const u32x2*)(base16 + off); b = (f32x4){__builtin_bit_cast(float, r.x << 16), __builtin_bit_cast(float, r.x & 0xffff0000u), __builtin_bit_cast(float, r.y << 16), __builtin_bit_cast(float, r.y & 0xffff0000u)}; }
                        const f32x4 v = b + acc[ai][bj][m][n] * scale;
                        { u32x2 w; w.x = cvt_pk_bf16(v[0], v[1]); w.y = cvt_pk_bf16(v[2], v[3]); *(u32x2*)(ob + off) = w; }
                        ss += (v[0] * v[0] + v[1] * v[1]) + (v[2] * v[2] + v[3] * v[3]);
                    }
                ss += __shfl_xor(ss, 16); ss += __shfl_xor(ss, 32);
                if (rowss && fq == 0) atomicAdd(rowss + row, ss);
            }
    }
};
struct EpiP {
    static constexpr bool PERM = true, AFTER_DRAIN = false;
    bf16_t* phy; bf16_t* pr; const float* rowss;
    __device__ __forceinline__ void operator()(const f32x4 (&acc)[2][2][4][2], const Unit& u, int wr, int wc, int fr, int fq) const {
        const int row0 = u.pm * BM + wr * 64 + fr;
        bf16_t* O; int ldc, colt;
        if (u.pn < 12) { O = phy; ldc = 3072; colt = u.pn * BM; } else { O = pr; ldc = 3072; colt = (u.pn - 12) * BM; }
        const int col0 = colt + wc * 32 + 8 * fq;
#pragma unroll
        for (int ai = 0; ai < 2; ++ai)
#pragma unroll
            for (int m = 0; m < 4; ++m) {
                const int row = row0 + ai * HALF + m * 16; const float rs = rstd_of(rowss[row]);
#pragma unroll
                for (int bj = 0; bj < 2; ++bj) {
                    const f32x4 v0 = acc[ai][bj][m][0] * rs, v1 = acc[ai][bj][m][1] * rs;
                    u32x4 w; w.x = cvt_pk_bf16(v0[0], v0[1]); w.y = cvt_pk_bf16(v0[2], v0[3]); w.z = cvt_pk_bf16(v1[0], v1[1]); w.w = cvt_pk_bf16(v1[2], v1[3]);
                    *(u32x4*)(O + (size_t)row * ldc + col0 + bj * HALF) = w;
                }
            }
    }
};

struct EpiFilt {
    static constexpr bool PERM = false, AFTER_DRAIN = false;
    bf16_t* Ff; bf16_t* Fb0; bf16_t* Fb1;
    __device__ __forceinline__ void operator()(const f32x4 (&acc)[2][2][4][2], const Unit& u, int wr, int wc, int fr, int fq) const {
        const int row0 = u.pm * BM + wr * 64 + fr, col0 = u.pn * BM + wc * 32 + 4 * fq;
        const float dmin = -3.0701134573253945f, dmax = -15.350567286626973f;
#pragma unroll
        for (int ai = 0; ai < 2; ++ai)
#pragma unroll
            for (int m = 0; m < 4; ++m) {
                const int cc = row0 + ai * HALF + m * 16, c = cc & 1023;
                const float del = __builtin_fabsf(dmin + (float)c * ((dmax - dmin) / 1023.0f)) * (1.0f / 8191.0f);
                bf16_t* dst = cc < 1024 ? Ff + (size_t)c * 8192 : (c < 768 ? Fb0 + (size_t)c * 8192 : Fb1 + (size_t)(c - 768) * 8192);
#pragma unroll
                for (int bj = 0; bj < 2; ++bj)
#pragma unroll
                    for (int n = 0; n < 2; ++n) {
                        const int i = col0 + bj * HALF + n * 16; f32x4 v = acc[ai][bj][m][n];
#pragma unroll
                        for (int j = 0; j < 4; ++j) v[j] *= __expf(-(float)(i + j) * del);
                        { u32x2 w; w.x = cvt_pk_bf16(v[0], v[1]); w.y = cvt_pk_bf16(v[2], v[3]); *(u32x2*)(dst + i) = w; }
                    }
            }
    }
};

struct EpiFinal {
    static constexpr bool PERM = false, AFTER_DRAIN = false;
    const bf16_t* base16; float* out; float* rowss; unsigned* cnt; const float* g; float scale;
    __device__ __forceinline__ void operator()(f32x4 (&acc)[2][2][4][2], const Unit& u, int wr, int wc, int fr, int fq) const {
        const int row0 = u.pm * BM + wr * 64 + fr, col0 = u.pn * BM + wc * 32 + 4 * fq;
#pragma unroll
        for (int ai = 0; ai < 2; ++ai)
#pragma unroll
            for (int m = 0; m < 4; ++m) {
                const int row = row0 + ai * HALF + m * 16; float ss = 0.f;
#pragma unroll
                for (int bj = 0; bj < 2; ++bj)
#pragma unroll
                    for (int n = 0; n < 2; ++n) {
                        const size_t off = (size_t)row * 2048 + col0 + bj * HALF + n * 16;
                        const u32x2 r = *(const u32x2*)(base16 + off);
                        const f32x4 v = (f32x4){__builtin_bit_cast(float, r.x << 16), __builtin_bit_cast(float, r.x & 0xffff0000u), __builtin_bit_cast(float, r.y << 16), __builtin_bit_cast(float, r.y & 0xffff0000u)} + acc[ai][bj][m][n] * scale;
                        acc[ai][bj][m][n] = v; ss += (v[0] * v[0] + v[1] * v[1]) + (v[2] * v[2] + v[3] * v[3]);
                    }
                ss += __shfl_xor(ss, 16); ss += __shfl_xor(ss, 32);
                if (fq == 0) atomicAdd(rowss + row, ss);
            }
        asm volatile("s_waitcnt vmcnt(0)" ::: "memory");
        __syncthreads();
        if (threadIdx.x == 0) {
            unsigned* c = cnt + 64 * u.pm;
            __builtin_amdgcn_fence(__ATOMIC_RELEASE, "agent"); asm volatile("s_waitcnt vmcnt(0)" ::: "memory");
            __hip_atomic_fetch_add(c, 1u, __ATOMIC_RELAXED, __HIP_MEMORY_SCOPE_AGENT);
            unsigned spins = 0;
            while (__hip_atomic_load(c, __ATOMIC_RELAXED, __HIP_MEMORY_SCOPE_AGENT) < 8u) { __builtin_amdgcn_s_sleep(2); if (++spins > (1u << 22)) break; }
            __builtin_amdgcn_fence(__ATOMIC_ACQUIRE, "agent"); asm volatile("s_waitcnt vmcnt(0)" ::: "memory");
        }
        __syncthreads();
#pragma unroll
        for (int ai = 0; ai < 2; ++ai)
#pragma unroll
            for (int m = 0; m < 4; ++m) {
                const int row = row0 + ai * HALF + m * 16; const float rs = rstd_of(__hip_atomic_load(rowss + row, __ATOMIC_RELAXED, __HIP_MEMORY_SCOPE_AGENT));
#pragma unroll
                for (int bj = 0; bj < 2; ++bj)
#pragma unroll
                    for (int n = 0; n < 2; ++n) {
                        const int col = col0 + bj * HALF + n * 16; const f32x4 gg = *(const f32x4*)(g + col);
                        *(f32x4*)(out + (size_t)row * 2048 + col) = acc[ai][bj][m][n] * rs * gg;
                    }
            }
    }
};
template <class Epi, class Sched, bool ALIGN_EPI = false, bool SP2 = false>
__device__ __forceinline__ void gemm_phase(PG8_LAS unsigned char* lds, const Gemm g, const Sched& S, const Epi& E) {
    int tid_ = threadIdx.x; asm volatile("" : "+v"(tid_));
    const int tid = tid_, wid = __builtin_amdgcn_readfirstlane(tid >> 6), lane = tid & 63, wr = wid >> 2, wc = wid & 3, fr = lane & 15, fq = lane >> 4;
    const int K = g.K, nt = K / BK;
    unsigned voffA[2], voffB[2];
#pragma unroll
    for (int i = 0; i < 2; ++i) { int R, C; stage_rc(tid * 16 + i * 8192, R, C); const int Rb = Epi::PERM ? ((R & ~31) + perm32(R & 31)) : R;
        voffA[i] = (unsigned)(R * K + C) * 2u; voffB[i] = (unsigned)(Rb * K + C) * 2u; }
    const size_t kstep = (size_t)(BK * 2);
    const size_t hstep = (size_t)HALF * K * 2;
    const size_t tstep = 2 * hstep;
    const unsigned ldsw = (unsigned)wid * 1024u;
    const int aoff = lds_byte(wr * 64 + fr, fq * 8), boff = lds_byte(wc * 32 + fr, fq * 8);
#define PG8_SA(b, h) (((b) * 2 + (h)) * HTB)
#define PG8_SB(b, h) ((4 + (b) * 2 + (h)) * HTB)
#define PG8_STAGE(bufoff, gbase, voff) do { _Pragma("unroll") for (int _i = 0; _i < 2; ++_i) \
        __builtin_amdgcn_global_load_lds((const unsigned*)((const char*)(gbase) + (voff)[_i]), (PG8_LAS unsigned*)(lds + (bufoff) + ldsw + _i * 8192), 16, 0, 0); } while (0)
#define PG8_LDA(dst, b, h) do { _Pragma("unroll") for (int m = 0; m < 4; ++m) _Pragma("unroll") for (int k = 0; k < 2; ++k) dst[m][k] = *(const PG8_LAS bf16x8*)(lds + PG8_SA(b, h) + aoff + m * 2048 + k * 1024); } while (0)
#define PG8_LDB(dst, b, h) do { _Pragma("unroll") for (int n = 0; n < 2; ++n) _Pragma("unroll") for (int k = 0; k < 2; ++k) dst[n][k] = *(const PG8_LAS bf16x8*)(lds + PG8_SB(b, h) + boff + n * 2048 + k * 1024); } while (0)
#define PG8_MMA(ai, bj, At, Bt) do { __builtin_amdgcn_s_setprio(1); _Pragma("unroll") for (int m = 0; m < 4; ++m) _Pragma("unroll") for (int n = 0; n < 2; ++n) _Pragma("unroll") for (int k = 0; k < 2; ++k) \
        acc[ai][bj][m][n] = __builtin_amdgcn_mfma_f32_16x16x32_bf16(Bt[n][k], At[m][k], acc[ai][bj][m][n], 0, 0, 0); __builtin_amdgcn_s_setprio(0); } while (0)
#define PG8_WAIT_V(n) asm volatile("s_waitcnt vmcnt(" #n ")" ::: "memory")
#define PG8_WAIT_L(n) asm volatile("s_waitcnt lgkmcnt(" #n ")" ::: "memory")
#define PG8_BAR __builtin_amdgcn_s_barrier()
#define PG8_SCHED __builtin_amdgcn_sched_barrier(0)
    Unit cur, nxt; int ui = 0;
    if (!S.next(0, cur)) return;
    f32x4 acc[2][2][4][2];
#pragma unroll
    for (int a = 0; a < 2; ++a)
#pragma unroll
        for (int b = 0; b < 2; ++b)
#pragma unroll
            for (int m = 0; m < 4; ++m)
#pragma unroll
                for (int n = 0; n < 2; ++n) acc[a][b][m][n] = (f32x4){0.f, 0.f, 0.f, 0.f};
    bf16x8 At[4][2], B0[2][2], B1[2][2];
    const char* cA = (const char*)g.A + (size_t)cur.pm * tstep; const char* cB = (const char*)g.Bt + (size_t)cur.pn * tstep;
    S.a_ready(cur);
    if constexpr (SP2) {
        PG8_STAGE(PG8_SB(0, 0), cB, voffB); PG8_STAGE(PG8_SB(0, 1), cB + hstep, voffB); PG8_STAGE(PG8_SA(0, 0), cA, voffA); PG8_STAGE(PG8_SA(0, 1), cA + hstep, voffA);
        if (wr == 1) PG8_BAR;
        PG8_WAIT_V(2); PG8_BAR;
        PG8_STAGE(PG8_SB(1, 0), cB + kstep, voffB); PG8_STAGE(PG8_SA(1, 0), cA + kstep, voffA); PG8_STAGE(PG8_SB(1, 1), cB + hstep + kstep, voffB);
        PG8_WAIT_V(6); PG8_BAR;
    } else {
        PG8_STAGE(PG8_SB(0, 0), cB, voffB); PG8_STAGE(PG8_SA(0, 0), cA, voffA); PG8_STAGE(PG8_SB(0, 1), cB + hstep, voffB); PG8_STAGE(PG8_SA(0, 1), cA + hstep, voffA);
        if (wr == 1) PG8_BAR;
        PG8_WAIT_V(4); PG8_BAR;
        PG8_STAGE(PG8_SB(1, 0), cB + kstep, voffB); PG8_STAGE(PG8_SA(1, 0), cA + kstep, voffA); PG8_STAGE(PG8_SB(1, 1), cB + hstep + kstep, voffB);
        PG8_WAIT_V(6); PG8_BAR;
    }
    for (;;) {
        const bool has_next = S.next(ui + 1, nxt);
        const char* nA = has_next ? (const char*)g.A + (size_t)nxt.pm * tstep : cA; const char* nB = has_next ? (const char*)g.Bt + (size_t)nxt.pn * tstep : cB;
        for (int t = 0; t < nt; t += 2) {
            const bool last = (t == nt - 2);
            const char* a1 = cA + (size_t)(t + 1) * kstep;
            const char* a2 = last ? nA : cA + (size_t)(t + 2) * kstep; const char* b2 = last ? nB : cB + (size_t)(t + 2) * kstep;
            const char* a3 = a2 + kstep; const char* b3 = b2 + kstep;
            if (last && has_next) S.a_ready(nxt);
            if constexpr (SP2) {
            PG8_LDB(B0, 0, 0); PG8_LDB(B1, 0, 1); PG8_SCHED; PG8_LDA(At, 0, 0); PG8_STAGE(PG8_SA(1, 1), a1 + hstep, voffA);
            PG8_WAIT_V(8); PG8_WAIT_L(0); PG8_BAR; PG8_MMA(0, 0, At, B0); PG8_MMA(0, 1, At, B1); PG8_BAR; PG8_SCHED;
            PG8_LDA(At, 0, 1); PG8_STAGE(PG8_SB(0, 0), b2, voffB); PG8_STAGE(PG8_SB(0, 1), b2 + hstep, voffB); PG8_STAGE(PG8_SA(0, 0), a2, voffA);
            PG8_WAIT_V(8); PG8_WAIT_L(0); PG8_BAR; PG8_MMA(1, 0, At, B0); PG8_MMA(1, 1, At, B1); PG8_BAR; PG8_SCHED;
            PG8_LDB(B0, 1, 0); PG8_LDB(B1, 1, 1); PG8_SCHED; PG8_LDA(At, 1, 0); PG8_STAGE(PG8_SA(0, 1), a2 + hstep, voffA);
            PG8_WAIT_V(8); PG8_WAIT_L(0); PG8_BAR; PG8_MMA(0, 0, At, B0); PG8_MMA(0, 1, At, B1); PG8_BAR; PG8_SCHED;
            PG8_LDA(At, 1, 1); PG8_STAGE(PG8_SB(1, 0), b3, voffB); PG8_STAGE(PG8_SB(1, 1), b3 + hstep, voffB); PG8_STAGE(PG8_SA(1, 0), a3, voffA);
            PG8_WAIT_V(8); PG8_WAIT_L(0); PG8_BAR; PG8_MMA(1, 0, At, B0); PG8_MMA(1, 1, At, B1); PG8_BAR; PG8_SCHED;
            } else {
            PG8_LDB(B0, 0, 0); PG8_SCHED; PG8_LDA(At, 0, 0); PG8_STAGE(PG8_SA(1, 1), a1 + hstep, voffA);
            PG8_WAIT_L(8); PG8_BAR; PG8_WAIT_L(0); PG8_MMA(0, 0, At, B0); PG8_BAR; PG8_SCHED;
            PG8_LDB(B1, 0, 1); PG8_STAGE(PG8_SB(0, 0), b2, voffB);
            PG8_BAR; PG8_WAIT_L(0); PG8_MMA(0, 1, At, B1); PG8_BAR;
            PG8_LDA(At, 0, 1); PG8_STAGE(PG8_SA(0, 0), a2, voffA);
            PG8_BAR; PG8_WAIT_L(0); PG8_MMA(1, 0, At, B0); PG8_BAR; PG8_SCHED;
            PG8_STAGE(PG8_SB(0, 1), b2 + hstep, voffB);
            PG8_WAIT_V(6); PG8_BAR; PG8_MMA(1, 1, At, B1); PG8_BAR;
            PG8_LDB(B0, 1, 0); PG8_SCHED; PG8_LDA(At, 1, 0); PG8_STAGE(PG8_SA(0, 1), a2 + hstep, voffA);
            PG8_WAIT_L(8); PG8_BAR; PG8_WAIT_L(0); PG8_MMA(0, 0, At, B0); PG8_BAR; PG8_SCHED;
            PG8_LDB(B1, 1, 1); PG8_STAGE(PG8_SB(1, 0), b3, voffB);
            PG8_BAR; PG8_WAIT_L(0); PG8_MMA(0, 1, At, B1); PG8_BAR;
            PG8_LDA(At, 1, 1); PG8_STAGE(PG8_SA(1, 0), a3, voffA);
            PG8_BAR; PG8_WAIT_L(0); PG8_MMA(1, 0, At, B0); PG8_BAR; PG8_SCHED;
            PG8_STAGE(PG8_SB(1, 1), b3 + hstep, voffB);
            PG8_WAIT_V(6); PG8_BAR; PG8_MMA(1, 1, At, B1); PG8_BAR;
            }
        }
        if constexpr (ALIGN_EPI) { if (wr == 0) PG8_BAR; }
        if constexpr (!Epi::AFTER_DRAIN) { E(acc, cur, wr, wc, fr, fq); S.done(cur); }
        if (!has_next) break;
#pragma unroll
        for (int a = 0; a < 2; ++a)
#pragma unroll
            for (int b = 0; b < 2; ++b)
#pragma unroll
                for (int m = 0; m < 4; ++m)
#pragma unroll
                    for (int n = 0; n < 2; ++n) acc[a][b][m][n] = (f32x4){0.f, 0.f, 0.f, 0.f};
        cur = nxt; cA = nA; cB = nB; ++ui;
        if constexpr (ALIGN_EPI) { if (wr == 1) PG8_BAR; }
    }
    PG8_WAIT_V(0);
    if constexpr (!ALIGN_EPI) { if (wr == 0) PG8_BAR; }
    PG8_BAR;
    if constexpr (Epi::AFTER_DRAIN) { E.fused(acc, cur, wr, wc, fr, fq, lds, wid, lane); S.done(cur); }
#undef PG8_SA
#undef PG8_SB
#undef PG8_STAGE
#undef PG8_LDA
#undef PG8_LDB
#undef PG8_MMA
#undef PG8_WAIT_V
#undef PG8_WAIT_L
#undef PG8_BAR
#undef PG8_SCHED
}
}
using pg8::silu_f;

constexpr int L = 8192, DM = 2048, FF = 5632, NIN = 6176, NING = 6144, HYW = 1024;
constexpr int PHY_LD = 3072, PR_LD = 3072;
constexpr int PR_Q = 0, PR_K = 512, PR_V = 1024, PR_R = 2048;
constexpr int NT = 512;
constexpr int LDS_BYTES = 147456;
constexpr int FN = 16384;

constexpr size_t MiB = 1u << 20;
constexpr size_t WS_ROWSS = 0;
constexpr size_t WS_DEC = 128 * 1024;
constexpr size_t WS_PCNT = 640 * 1024 + 16384;
constexpr size_t WS_BAR = 640 * 1024;
constexpr size_t WS_W4T = 1 * MiB;
constexpr size_t WS_HID = 2 * MiB;
constexpr size_t WS_SK = 6 * MiB;
constexpr size_t SK_STRIDE = 8448;
constexpr size_t WS_WFF = 39 * MiB;
constexpr size_t WS_WDN = WS_WFF + 44 * MiB;
constexpr size_t WS_ST = WS_WFF;
constexpr size_t WS_WIN = 105 * MiB;
constexpr size_t WS_WOUT = 130 * MiB;
constexpr size_t WS_XB = 138 * MiB;
constexpr size_t WS_A = 170 * MiB;
constexpr size_t WS_ZT = WS_A;
constexpr size_t WS_X0T = WS_A + 32 * MiB;
constexpr size_t WS_PHY = 258 * MiB;
constexpr size_t WS_MIX = WS_PHY;
constexpr size_t WS_PR = 306 * MiB;
constexpr size_t WS_LR = WS_PR + 48 * MiB;
constexpr size_t WS_T0 = WS_PR + 49 * MiB;
constexpr size_t WS_END = 358 * MiB;

typedef unsigned short bf16_t;
typedef short bf16x8 __attribute__((ext_vector_type(8)));
typedef float f32x4 __attribute__((ext_vector_type(4)));
typedef unsigned u32x4 __attribute__((ext_vector_type(4)));
typedef unsigned u32x2 __attribute__((ext_vector_type(2)));
#define LAS __attribute__((address_space(3)))
typedef float c2 __attribute__((ext_vector_type(2)));
__device__ __forceinline__ c2 mk2(float a, float b) { return (c2){a, b}; }
#define LDS_WAIT() asm volatile("s_waitcnt lgkmcnt(0)" ::: "memory")

__device__ __forceinline__ unsigned f2bf(float f) { unsigned u = __builtin_bit_cast(unsigned, f); return (u + 0x7fffu + ((u >> 16) & 1u)) >> 16; }
__device__ __forceinline__ unsigned pk2(float lo, float hi) { return f2bf(lo) | (f2bf(hi) << 16); }
__device__ __forceinline__ float bf2f(unsigned h) { return __builtin_bit_cast(float, h << 16); }
__device__ __forceinline__ float wave_sum(float v) {
#pragma unroll
    for (int o = 1; o < 64; o <<= 1) v += __shfl_xor(v, o);
    return v;
}

struct Params {
    const float* in[32];
    float* out;
    unsigned char* ws;
};

__device__ __forceinline__ void transpose_item(const float* __restrict__ W, int K, int N, bf16_t* __restrict__ WT, int mode, const float* __restrict__ gain, LAS float* scr, int item, int lane) {
    const int nblk = N / 32, kb = item / nblk, nb = item % nblk, k0 = 64 * kb, n0 = 32 * nb;
    const int drow0 = mode == 0 ? n0 : (256 * (n0 >> 7) + (n0 & 127) + (mode == 2 ? 128 : 0));
    const int c = lane & 7;
    f32x4 g0 = (f32x4){1.f, 1.f, 1.f, 1.f}, g1 = g0;
    if (gain) { g0 = *(const f32x4*)(gain + k0 + 8 * c); g1 = *(const f32x4*)(gain + k0 + 8 * c + 4); }
    float v[32];
    const float* wp = W + (size_t)(k0 + (lane >> 5)) * N + n0 + (lane & 31);
#pragma unroll
    for (int i = 0; i < 32; ++i) v[i] = __builtin_nontemporal_load(wp + (size_t)(2 * i) * N);
#pragma unroll
    for (int i = 0; i < 32; ++i) scr[(2 * i + (lane >> 5)) * 33 + (lane & 31)] = v[i];
    LDS_WAIT(); asm volatile("" ::: "memory");
#pragma unroll
    for (int j = 0; j < 4; ++j) { const int n = (lane >> 3) + 8 * j; const LAS float* s = scr + (8 * c) * 33 + n;
        u32x4 o; o.x = pk2(s[0 * 33] * g0[0], s[1 * 33] * g0[1]); o.y = pk2(s[2 * 33] * g0[2], s[3 * 33] * g0[3]); o.z = pk2(s[4 * 33] * g1[0], s[5 * 33] * g1[1]); o.w = pk2(s[6 * 33] * g1[2], s[7 * 33] * g1[3]);
        *(u32x4*)(WT + (size_t)(drow0 + n) * K + k0 + 8 * c) = o; }
    LDS_WAIT(); asm volatile("" ::: "memory");
}
constexpr int IT_FF = (DM / 64) * (FF / 32);
__device__ __forceinline__ void convert_gu(const float* wg, const float* wu, const float* gain, unsigned char* ws, LAS unsigned char* lds, int gw, int ngw, int lane, int wave) {
    LAS float* scr = (LAS float*)(lds + wave * 8448); bf16_t* WGU = (bf16_t*)(ws + WS_WFF);
#pragma unroll 1
    for (int it = gw; it < 2 * IT_FF; it += ngw) { if (it < IT_FF) transpose_item(wg, DM, FF, WGU, 1, gain, scr, it, lane); else transpose_item(wu, DM, FF, WGU, 2, gain, scr, it - IT_FF, lane); }
}
__device__ __forceinline__ void convert_dn(const float* wd, unsigned char* ws, LAS unsigned char* lds, int gw, int ngw, int lane, int wave) {
    LAS float* scr = (LAS float*)(lds + wave * 8448); bf16_t* WDN = (bf16_t*)(ws + WS_WDN);
#pragma unroll 1
    for (int it = gw; it < IT_FF; it += ngw) transpose_item(wd, FF, DM, WDN, 0, nullptr, scr, it, lane);
}
__device__ __forceinline__ void convert_tail1(const Params& p, LAS unsigned char* lds, int gw, int ngw, int lane, int wave) {
    LAS float* scr = (LAS float*)(lds + wave * 8448); unsigned char* ws = p.ws;
    constexpr int IT_IN = (DM / 64) * (NIN / 32), IT_OUT = (DM / 64) * (DM / 32);
#pragma unroll 1
    for (int it = gw; it < IT_FF + IT_IN + IT_OUT; it += ngw) {
        if (it < IT_FF) transpose_item(p.in[4], FF, DM, (bf16_t*)(ws + WS_WDN), 0, nullptr, scr, it, lane);
        else if (it < IT_FF + IT_IN) transpose_item(p.in[6], DM, NIN, (bf16_t*)(ws + WS_WIN), 0, p.in[5], scr, it - IT_FF, lane);
        else transpose_item(p.in[26], DM, DM, (bf16_t*)(ws + WS_WOUT), 0, nullptr, scr, it - IT_FF - IT_IN, lane);
    }
}
__device__ __forceinline__ void hid_pass(const Params& p, LAS float* sm, const LAS float* WL, int pos0, int tid) {
    const float* b1 = p.in[10]; const float* f1 = p.in[11]; const float* b2 = p.in[13]; const float* f2 = p.in[14]; const float* b3 = p.in[16]; const float* f3 = p.in[17];
    bf16_t* hidx = (bf16_t*)(p.ws + WS_HID);
    const int pp = tid >> 6, j = tid & 63, pos = pos0 + pp;
    LAS float* Z = sm; LAS float* H1 = sm + 512; LAS float* H2 = sm + 1024;
    const LAS float* w1 = WL; const LAS float* w2 = WL + 33 * 64; const LAS float* w3 = w2 + 64 * 64;
    if (j < 33) {
        float z;
        if (j == 0) z = (float)pos / 8191.0f;
        else {
            const int b = (j - 1) & 15; const float fj = 1e-4f + (float)b * ((15.0f - 1e-4f) / 15.0f);
            const double r = (double)pos * (double)fj * (1.0 / 8192.0); const float fr = (float)(r - floor(r));
            float s, c; sincospif(2.0f * fr, &s, &c);
            z = (j <= 16) ? c : -s;
        }
        Z[pp * 40 + j] = z;
    }
    __syncthreads();
    float a, a0 = b1[j] + Z[pp * 40 + 32] * w1[32 * 64 + j], a1 = 0.f, a2 = 0.f, a3 = 0.f;
#pragma unroll
    for (int k4 = 0; k4 < 8; ++k4) { const f32x4 h = *(const LAS f32x4*)(Z + pp * 40 + 4 * k4);
        a0 += h[0] * w1[(4 * k4 + 0) * 64 + j]; a1 += h[1] * w1[(4 * k4 + 1) * 64 + j]; a2 += h[2] * w1[(4 * k4 + 2) * 64 + j]; a3 += h[3] * w1[(4 * k4 + 3) * 64 + j]; }
    a = (a0 + a1) + (a2 + a3);
    H1[pp * 64 + j] = sinf(f1[j] * a);
    __syncthreads();
    a0 = b2[j]; a1 = 0.f; a2 = 0.f; a3 = 0.f;
#pragma unroll
    for (int k4 = 0; k4 < 16; ++k4) { const f32x4 h = *(const LAS f32x4*)(H1 + pp * 64 + 4 * k4);
        a0 += h[0] * w2[(4 * k4 + 0) * 64 + j]; a1 += h[1] * w2[(4 * k4 + 1) * 64 + j]; a2 += h[2] * w2[(4 * k4 + 2) * 64 + j]; a3 += h[3] * w2[(4 * k4 + 3) * 64 + j]; }
    a = (a0 + a1) + (a2 + a3);
    H2[pp * 64 + j] = sinf(f2[j] * a);
    __syncthreads();
    a0 = b3[j]; a1 = 0.f; a2 = 0.f; a3 = 0.f;
#pragma unroll
    for (int k4 = 0; k4 < 16; ++k4) { const f32x4 h = *(const LAS f32x4*)(H2 + pp * 64 + 4 * k4);
        a0 += h[0] * w3[(4 * k4 + 0) * 64 + j]; a1 += h[1] * w3[(4 * k4 + 1) * 64 + j]; a2 += h[2] * w3[(4 * k4 + 2) * 64 + j]; a3 += h[3] * w3[(4 * k4 + 3) * 64 + j]; }
    a = (a0 + a1) + (a2 + a3);
    { const float h3 = sinf(f3[j] * a); const unsigned hi = f2bf(h3); bf16_t* hr = hidx + (size_t)pos * 256 + j; hr[0] = (bf16_t)hi; hr[64] = (bf16_t)f2bf(h3 - bf2f(hi)); hr[128] = (bf16_t)hi; hr[192] = 0; }
}
__device__ __forceinline__ void phase0(const Params& p, LAS unsigned char* lds, int tid, int lane, int wave, int mask) {
    const int G = gridDim.x, gw = blockIdx.x * 8 + wave, ngw = G * 8;
    unsigned char* ws = p.ws;
#pragma unroll 1
    for (int step = 0; step < 2; ++step) {
    if ((step == 0) == (((blockIdx.x >> 3) & 1) == 0)) {
    if (mask & 1) convert_gu(p.in[2], p.in[3], p.in[1], ws, lds, gw, ngw, lane, wave);
    const int gt = blockIdx.x * NT + tid, ngt = G * NT;
    {
      float* rs = (float*)(ws + WS_ROWSS) + L; for (int i = gt; i < 3 * L; i += ngt) rs[i] = 0.f; }
    { const float* w4 = p.in[18]; bf16_t* tx = (bf16_t*)(ws + WS_W4T);
      for (int i = gt; i < 2048 * 64; i += ngt) { const int c = i >> 6, k = i & 63; const float v = w4[k * 2048 + c]; const unsigned hi = f2bf(v); bf16_t* tr = tx + (size_t)c * 256 + k; tr[0] = (bf16_t)hi; tr[64] = (bf16_t)hi; tr[128] = (bf16_t)f2bf(v - bf2f(hi)); tr[192] = 0; } }
    if (mask & 4) {
        const float* x = p.in[0]; bf16_t* xb = (bf16_t*)(ws + WS_XB); float* rs = (float*)(ws + WS_ROWSS);
#pragma unroll 1
        for (int m = gw; m < L; m += ngw) {
            const f32x4* xr = (const f32x4*)(x + (size_t)m * DM) + lane; u32x2* o = (u32x2*)(xb + (size_t)m * DM) + lane; float s = 0.f;
#pragma unroll
            for (int j = 0; j < 8; ++j) { const f32x4 v = __builtin_nontemporal_load(xr + 64 * j); s += (v[0] * v[0] + v[1] * v[1]) + (v[2] * v[2] + v[3] * v[3]);
                u32x2 w; w.x = pk2(v[0], v[1]); w.y = pk2(v[2], v[3]); o[64 * j] = w; }
            s = wave_sum(s); if (lane == 0) rs[m] = s;
        }
    }
    __syncthreads();
    } else {
    __syncthreads();
    if (mask & 8) { LAS float* WL = (LAS float*)lds + 2048;
      for (int i = tid; i < 33 * 64; i += NT) WL[i] = p.in[9][i];
      for (int i = tid; i < 64 * 64; i += NT) { WL[33 * 64 + i] = p.in[12][i]; WL[33 * 64 + 64 * 64 + i] = p.in[15][i]; }
      __syncthreads();
#pragma unroll 1
      for (int ps = blockIdx.x; ps < L / 8; ps += G) { hid_pass(p, (LAS float*)lds, WL, ps * 8, tid); __syncthreads(); } }
    }
    }
}

__device__ __forceinline__ void convT_fetch(const bf16_t* phy, int tile, int tid, u32x4 (&rw)[4]) {
    const int t0 = (tile >> 4) * 64, c0 = (tile & 15) * 64;
#pragma unroll
    for (int k = 0; k < 4; ++k) { const int idx = tid + NT * k; rw[k] = (u32x4){0u, 0u, 0u, 0u};
        if (idx < 3 * 66 * 8) { const int s = idx / 528, r = (idx % 528) >> 3, c8 = (idx & 7) * 8, tt = t0 - 1 + r;
            if (tt >= 0 && tt < L) rw[k] = *(const u32x4*)(phy + (size_t)tt * PHY_LD + s * HYW + c0 + c8); } }
}
__device__ __forceinline__ void convT_tile(const Params& p, LAS unsigned char* lds, int tile, int tid, const u32x4 (&rw)[4]) {
    bf16_t* zT = (bf16_t*)(p.ws + WS_ZT); bf16_t* x0T = (bf16_t*)(p.ws + WS_X0T);
    const float* cw = p.in[7]; const float* cb = p.in[8];
    LAS float* zt = (LAS float*)lds; LAS float* xt = zt + 64 * 65;
    LAS bf16_t* raw = (LAS bf16_t*)(lds + 33280);
    const int t0 = (tile >> 4) * 64, c0 = (tile & 15) * 64;
#pragma unroll
    for (int k = 0; k < 4; ++k) { const int idx = tid + NT * k; if (idx < 3 * 66 * 8) { const int s = idx / 528, r = (idx % 528) >> 3, c8 = (idx & 7) * 8; *(LAS u32x4*)(raw + (s * 66 + r) * 64 + c8) = rw[k]; } }
    const int c = tid & 63, tg = tid >> 6;
    float w[3][3], b[3];
#pragma unroll
    for (int s = 0; s < 3; ++s) { const int col = s * HYW + c0 + c; b[s] = cb[col];
#pragma unroll
        for (int tap = 0; tap < 3; ++tap) w[s][tap] = cw[tap * 3 * HYW + col]; }
    __syncthreads();
#pragma unroll
    for (int i = 0; i < 8; ++i) {
        const int tl = tg * 8 + i; float u[3];
#pragma unroll
        for (int s = 0; s < 3; ++s) { float a = b[s];
#pragma unroll
            for (int tap = 0; tap < 3; ++tap) a += w[s][tap] * bf2f(raw[(s * 66 + tl + tap) * 64 + c]);
            u[s] = a; }
        zt[c * 65 + tl] = u[2] * u[1]; xt[c * 65 + tl] = u[0];
    }
    __syncthreads();
    { const int t = tid & 63, cg8 = tid >> 6;
#pragma unroll
      for (int i = 0; i < 8; ++i) { const int cc = cg8 * 8 + i; zT[(size_t)(c0 + cc) * L + t0 + t] = (bf16_t)f2bf(zt[cc * 65 + t]); x0T[(size_t)(c0 + cc) * L + t0 + t] = (bf16_t)f2bf(xt[cc * 65 + t]); } }
    __syncthreads();
}

__device__ __forceinline__ float logsig16(float x) { return (fminf(x, 0.f) - __logf(1.0f + __expf(-fabsf(x)))) * (1.0f / 16.0f); }
__device__ __forceinline__ bf16x8 ldfrag(const LAS bf16_t* base, int ld, int row0, int k0, int lane) { return *(const LAS bf16x8*)(base + (row0 + (lane & 15)) * ld + k0 + 8 * (lane >> 4)); }

__device__ __forceinline__ void gla_stage(const bf16_t* pr, const float* lr, int t0, int h, LAS float* lrs, LAS bf16_t* vT, int tid) {
    *(LAS f32x4*)(lrs + tid * 4) = *(const f32x4*)(lr + (size_t)t0 * 32 + tid * 4);
    { const int c = tid & 255, tb = tid >> 8; const bf16_t* vp = pr + (size_t)t0 * PR_LD + PR_V + h * 256 + c;
#pragma unroll
      for (int i = 0; i < 4; ++i) { const int tk = (tb * 4 + i) * 8; unsigned short e[8];
#pragma unroll
          for (int j = 0; j < 8; ++j) e[j] = vp[(size_t)(tk + j) * PR_LD];
          u32x4 w; w.x = e[0] | ((unsigned)e[1] << 16); w.y = e[2] | ((unsigned)e[3] << 16); w.z = e[4] | ((unsigned)e[5] << 16); w.w = e[6] | ((unsigned)e[7] << 16);
          *(LAS u32x4*)(vT + c * 72 + tk) = w; } }
}
struct GateW { float w[16]; float b; };
__device__ __forceinline__ void gate_load(const Params& p, int dir, int h, int d, GateW& g) {
    const float* wa = dir ? p.in[23] : p.in[21]; const float* ba = dir ? p.in[24] : p.in[22];
#pragma unroll
    for (int r = 0; r < 16; ++r) g.w[r] = wa[r * 512 + h * 128 + d];
    g.b = ba[h * 128 + d];
}
__device__ __forceinline__ float gate_eval(const GateW& g, const LAS float* lr) {
    const LAS f32x4* l4 = (const LAS f32x4*)lr; const f32x4 a = l4[0], b = l4[1], c = l4[2], d = l4[3];
    float x0 = g.b, x1 = 0.f, x2 = 0.f, x3 = 0.f;
#pragma unroll
    for (int r = 0; r < 4; ++r) { x0 += a[r] * g.w[r]; x1 += b[r] * g.w[4 + r]; x2 += c[r] * g.w[8 + r]; x3 += d[r] * g.w[12 + r]; }
    return logsig16((x0 + x1) + (x2 + x3));
}

__device__ __forceinline__ void gla_kv_item(const Params& p, LAS unsigned char* lds, int item, int tid, int lane, int wave) {
    const int h = item & 3, n = item >> 2, t0 = n * 64;
    const bf16_t* pr = (const bf16_t*)(p.ws + WS_PR); bf16_t* ST = (bf16_t*)(p.ws + WS_ST); float* dec = (float*)(p.ws + WS_DEC);
    LAS bf16_t* vT = (LAS bf16_t*)lds; LAS bf16_t* kstT = (LAS bf16_t*)(lds + 36864);
    LAS float* lrs = (LAS float*)(lds + 73728); LAS float* tot = (LAS float*)(lds + 81920);
    gla_stage(pr, (const float*)(p.ws + WS_LR), t0, h, lrs, vT, tid);
    const int d = tid & 127, dir = (tid >> 7) & 1, half = tid >> 8;
    GateW gw; gate_load(p, dir, h, d, gw);
    const bf16_t* kp = pr + (size_t)t0 * PR_LD + PR_K + h * 128 + d;
    unsigned short kr[8];
#pragma unroll
    for (int u = 0; u < 8; ++u) { const int q = half * 32 + u, t = dir ? 63 - q : q; kr[u] = kp[(size_t)t * PR_LD]; }
    __syncthreads();
    {
        float b = 0.f;
#pragma unroll 1
        for (int sg = 0; sg < 4; ++sg) {
            unsigned short kn[8];
#pragma unroll
            for (int u = 0; u < 8; ++u) { const int q = half * 32 + ((sg * 8 + 8 + u) & 31), t = dir ? 63 - q : q; kn[u] = kp[(size_t)t * PR_LD]; }
            unsigned ke[8];
#pragma unroll
            for (int u = 0; u < 8; ++u) { const int q = half * 32 + sg * 8 + u, t = dir ? 63 - q : q; b += gate_eval(gw, lrs + t * 32 + dir * 16);
                ke[dir ? 7 - u : u] = f2bf(bf2f(kr[u]) * __expf(-b)); }
            { const int q0 = half * 32 + sg * 8, tlo = dir ? 63 - q0 - 7 : q0; u32x4 w; w.x = ke[0] | (ke[1] << 16); w.y = ke[2] | (ke[3] << 16); w.z = ke[4] | (ke[5] << 16); w.w = ke[6] | (ke[7] << 16);
              *(LAS u32x4*)(kstT + (dir * 128 + d) * 72 + tlo) = w; }
#pragma unroll
            for (int u = 0; u < 8; ++u) kr[u] = kn[u];
        }
        tot[(dir * 2 + half) * 128 + d] = b;
    }
    __syncthreads();
    if (half == 0) { const float T0 = tot[(dir * 2 + 0) * 128 + d]; const size_t ti = ((size_t)(dir * 128 + n) * 4 + h) * 128 + d;
        dec[ti] = __expf(T0 + tot[(dir * 2 + 1) * 128 + d]); ((float*)(p.ws + WS_T0))[ti] = T0; }
    const int q4 = lane >> 4, v0 = wave * 32;
#pragma unroll 1
    for (int dr = 0; dr < 2; ++dr) {
        f32x4 acc[8][2];
#pragma unroll
        for (int mt = 0; mt < 8; ++mt) { acc[mt][0] = (f32x4){0.f, 0.f, 0.f, 0.f}; acc[mt][1] = (f32x4){0.f, 0.f, 0.f, 0.f}; }
#pragma unroll
        for (int ks = 0; ks < 2; ++ks) {
            const bf16x8 b0 = ldfrag(vT, 72, v0, 32 * ks, lane), b1 = ldfrag(vT, 72, v0 + 16, 32 * ks, lane);
#pragma unroll
            for (int mt = 0; mt < 8; ++mt) { const bf16x8 a = ldfrag(kstT + dr * 128 * 72, 72, 16 * mt, 32 * ks, lane);
                acc[mt][0] = __builtin_amdgcn_mfma_f32_16x16x32_bf16(a, b0, acc[mt][0], 0, 0, 0);
                acc[mt][1] = __builtin_amdgcn_mfma_f32_16x16x32_bf16(a, b1, acc[mt][1], 0, 0, 0); }
            if (ks == 0) {
#pragma unroll
                for (int mt = 0; mt < 8; ++mt) { const f32x4 T0 = *(const LAS f32x4*)(tot + (dr * 2 + 0) * 128 + 16 * mt + 4 * q4);
                    f32x4 rt;
#pragma unroll
                    for (int r = 0; r < 4; ++r) rt[r] = __expf(dr ? -T0[r] : T0[r]);
                    acc[mt][0] *= rt; acc[mt][1] *= rt; }
            }
        }
        bf16_t* S = ST + ((size_t)(dr * 4 + h) * 128 + n) * 32768;
#pragma unroll
        for (int mt = 0; mt < 8; ++mt) {
            const f32x4 T0 = *(const LAS f32x4*)(tot + (dr * 2 + 0) * 128 + 16 * mt + 4 * q4), T1 = *(const LAS f32x4*)(tot + (dr * 2 + 1) * 128 + 16 * mt + 4 * q4);
            f32x4 s1;
#pragma unroll
            for (int r = 0; r < 4; ++r) s1[r] = __expf(dr ? T0[r] + T1[r] : T1[r]);
#pragma unroll
            for (int nt = 0; nt < 2; ++nt) { const f32x4 v = acc[mt][nt] * s1; u32x2 w; w.x = pk2(v[0], v[1]); w.y = pk2(v[2], v[3]);
                *(u32x2*)(S + (size_t)(v0 + 16 * nt + (lane & 15)) * 128 + 16 * mt + 4 * q4) = w; }
        }
    }
    __syncthreads();
}

#ifndef REP_FA
#define REP_FA 0
#endif
#ifndef REP_FB
#define REP_FB 0
#endif
__device__ __forceinline__ void lr_task(const Params& p, LAS unsigned char* lds, int task, int tid, int lane, int wave) {
    const bf16_t* xb = (const bf16_t*)(p.ws + WS_XB); const bf16_t* wt = (const bf16_t*)(p.ws + WS_WIN) + (size_t)NING * DM;
    const float* rowss1 = (const float*)(p.ws + WS_ROWSS) + L; float* lr = (float*)(p.ws + WS_LR);
    const int mt = wave >> 2, nt = (wave >> 1) & 1, kh = wave & 1, fr = lane & 15, q4 = lane >> 4, t0 = task * 32;
    const bf16_t* ap = xb + (size_t)(t0 + 16 * mt + fr) * DM + kh * 1024 + 8 * q4; const bf16_t* bp = wt + (size_t)(16 * nt + fr) * DM + kh * 1024 + 8 * q4;
    f32x4 acc = (f32x4){0.f, 0.f, 0.f, 0.f};
#pragma unroll 1
    for (int kb = 0; kb < 2; ++kb) { bf16x8 a[16], b[16];
#pragma unroll
        for (int u = 0; u < 16; ++u) { a[u] = *(const bf16x8*)(ap + (kb * 16 + u) * 32); b[u] = *(const bf16x8*)(bp + (kb * 16 + u) * 32); }
#pragma unroll
        for (int u = 0; u < 16; ++u) acc = __builtin_amdgcn_mfma_f32_16x16x32_bf16(a[u], b[u], acc, 0, 0, 0); }
    LAS f32x4* ex = (LAS f32x4*)lds;
    if (kh) ex[(wave >> 1) * 64 + lane] = acc;
    __syncthreads();
    if (!kh) { const f32x4 o = ex[(wave >> 1) * 64 + lane];
#pragma unroll
        for (int r = 0; r < 4; ++r) { const int t = t0 + 16 * mt + 4 * q4 + r; lr[(size_t)t * 32 + 16 * nt + fr] = (acc[r] + o[r]) * pg8::rstd_of(rowss1[t]); } }
    __syncthreads();
}
__device__ __forceinline__ c2 cmul(c2 a, c2 b) { return mk2(a.x * b.x - a.y * b.y, a.x * b.y + a.y * b.x); }
__device__ __forceinline__ c2 twid(int m) { const float r = (float)m * (1.0f / 16384.0f); return mk2(__builtin_amdgcn_cosf(r), -__builtin_amdgcn_sinf(r)); }
__device__ __forceinline__ c2 cmulc(c2 a, c2 b) { return mk2(a.x * b.x + a.y * b.y, a.y * b.x - a.x * b.y); }
#define XI(i) ((i) + ((i) >> 5))
constexpr int XPAD_BYTES = (FN + FN / 32) * 8;
__constant__ const float C16c[8] = {1.f, 0.9238795325112867f, 0.7071067811865476f, 0.3826834323650898f, 0.f, -0.3826834323650898f, -0.7071067811865476f, -0.9238795325112867f};
__constant__ const float C16s[8] = {0.f, 0.3826834323650898f, 0.7071067811865476f, 0.9238795325112867f, 1.f, 0.9238795325112867f, 0.7071067811865476f, 0.3826834323650898f};
template <int R, bool INV, int UNR> __device__ __forceinline__ void fft_pass(LAS c2* X, int lo, int tid) {
    constexpr int RAD = 1 << R;
    const int stride = 1 << lo, ls = lo + R - 1;
    int tt = tid; asm volatile("" : "+v"(tt));
#pragma unroll 1
    for (int g = tt; g < FN / RAD; g += NT) {
        const int j0 = g & (stride - 1), i = ((g - j0) << R) + j0;
        c2 e[RAD];
#pragma unroll
        for (int q = 0; q < RAD; ++q) e[q] = X[XI(i + q * stride)];
#pragma unroll
        for (int t = 0; t < R; ++t) {
            const int Hq = INV ? (1 << t) : (RAD >> (t + 1));
            const c2 base = twid(j0 << (INV ? (13 - lo - t) : (13 - ls + t)));
#pragma unroll
            for (int bf = 0; bf < RAD / 2; ++bf) {
                const int qm = bf & (Hq - 1), q = ((bf - qm) << 1) + qm, k16 = qm * (8 / Hq);
                const c2 w = (k16 == 0) ? base : cmul(base, mk2(C16c[k16], -C16s[k16]));
                if (!INV) { const c2 a = e[q], b = e[q + Hq]; e[q] = a + b; e[q + Hq] = cmul(a - b, w); }
                else { const c2 a = e[q], b = cmulc(e[q + Hq], w); e[q] = a + b; e[q + Hq] = a - b; }
            }
        }
#pragma unroll
        for (int q = 0; q < RAD; ++q) X[XI(i + q * stride)] = e[q];
    }
    __syncthreads();
}
__device__ __forceinline__ void fft_dif(LAS c2* X, int tid) { fft_pass<4, false, 2>(X, 10, tid); fft_pass<4, false, 2>(X, 6, tid); fft_pass<4, false, 2>(X, 2, tid); fft_pass<2, false, 4>(X, 0, tid); }
__device__ __forceinline__ void fft_dit_inv(LAS c2* X, int tid) { fft_pass<2, true, 4>(X, 0, tid); fft_pass<4, true, 2>(X, 2, tid); fft_pass<4, true, 2>(X, 6, tid); fft_pass<4, true, 2>(X, 10, tid); }
__device__ __forceinline__ int br14(int x) { return (int)(__brev((unsigned)x) >> 18); }
__device__ __forceinline__ float block_sum(float v, LAS float* red, int tid, int lane, int wave) {
    v = wave_sum(v); __syncthreads(); if (lane == 0) red[wave] = v; __syncthreads();
    float s = 0.f;
#pragma unroll
    for (int i = 0; i < 8; ++i) s += red[i];
    return s;
}
__device__ __forceinline__ void hyena_fft_pair(const Params& p, LAS unsigned char* lds, int pair, int tid, int lane, int wave) {
    const int c = pair * 2;
    const float* skip = p.in[19];
    bf16_t* zT = (bf16_t*)(p.ws + WS_ZT); const bf16_t* x0T = (const bf16_t*)(p.ws + WS_X0T);
    f32x4* SK = (f32x4*)(p.ws + WS_SK) + (size_t)blockIdx.x * SK_STRIDE;
    LAS c2* X = (LAS c2*)lds; LAS float* red = (LAS float*)(lds + XPAD_BYTES);
    const float dmin = -3.0701134573253945f, dmax = -15.350567286626973f;
    const float del0 = fabsf(dmin + (float)c * ((dmax - dmin) / 1023.0f)), del1 = fabsf(dmin + (float)(c + 1) * ((dmax - dmin) / 1023.0f));
    float n0 = 0.f, n1 = 0.f, inv0 = 0.f, inv1 = 0.f;
#pragma unroll 1
    for (int rb = 0; rb <= REP_FB; ++rb) {
    n0 = 0.f; n1 = 0.f;
    {
        const bf16_t* ff = (const bf16_t*)p.out + (size_t)c * L; const bf16_t* fb = (const bf16_t*)p.out + (size_t)(HYW + c) * L;
#pragma unroll 1
        for (int ub = 0; ub < 2; ++ub) { float f0[8], f1[8], g0[8], g1[8];
#pragma unroll
            for (int u = 0; u < 8; ++u) { const int i = tid + NT * (ub * 8 + u); f0[u] = bf2f(ff[i]); f1[u] = bf2f(ff[L + i]); g0[u] = bf2f(fb[i]); g1[u] = bf2f(fb[L + i]); }
#pragma unroll
            for (int u = 0; u < 8; ++u) { const int i = tid + NT * (ub * 8 + u);
                X[XI(i)] = mk2(f0[u], f1[u]); n0 += fabsf(f0[u]); n1 += fabsf(f1[u]);
                if (i >= 1) { X[XI(FN - i)] = mk2(g0[u], g1[u]); n0 += fabsf(g0[u]); n1 += fabsf(g1[u]); } } }
    }
    if (tid == 0) X[XI(L)] = mk2(0.f, 0.f);
    inv0 = 1.0f / block_sum(n0, red, tid, lane, wave); inv1 = 1.0f / block_sum(n1, red, tid, lane, wave);
    __syncthreads();
    fft_dif(X, tid);
#pragma unroll 2
    for (int m = tid; m < FN / 2; m += NT) { const int pp = 2 * m, k = br14(pp), pm = br14((FN - k) & (FN - 1)); const c2 F = X[XI(pp)], Fm = X[XI(pm)];
        SK[m] = (f32x4){0.5f * (F.x + Fm.x), 0.5f * (F.y - Fm.y), 0.5f * (F.y + Fm.y), -0.5f * (F.x - Fm.x)}; }
    if (tid == 0) { const c2 F = X[XI(1)]; SK[FN / 2] = (f32x4){F.x, 0.f, F.y, 0.f}; }
    __syncthreads();
    }
    { float za[16], zb[16];
#pragma unroll
      for (int u = 0; u < 16; ++u) { za[u] = bf2f(zT[(size_t)c * L + tid + NT * u]); zb[u] = bf2f(zT[(size_t)(c + 1) * L + tid + NT * u]); }
#pragma unroll
      for (int u = 0; u < 16; ++u) { X[XI(tid + NT * u)] = mk2(za[u], zb[u]); X[XI(L + tid + NT * u)] = mk2(0.f, 0.f); } }
    __syncthreads();
    fft_dif(X, tid);
#pragma unroll 2
    for (int m = tid; m < FN / 2; m += NT) {
        const int pp = 2 * m, k = br14(pp); const f32x4 kk = SK[m]; const c2 K1 = mk2(kk[0], kk[1]), K2 = mk2(kk[2], kk[3]);
        if (k == 0) { const c2 F = X[XI(0)]; X[XI(0)] = mk2(F.x * K1.x, F.y * K2.x);
            const f32x4 kh = SK[FN / 2]; const c2 F1 = X[XI(1)]; X[XI(1)] = mk2(F1.x * kh[0], F1.y * kh[2]); }
        else { const int pm = br14(FN - k); const c2 F = X[XI(pp)], Fm = X[XI(pm)];
            const c2 Z1 = mk2(0.5f * (F.x + Fm.x), 0.5f * (F.y - Fm.y)), Z2 = mk2(0.5f * (F.y + Fm.y), -0.5f * (F.x - Fm.x));
            const c2 A = cmul(Z1, K1), B = cmul(Z2, K2);
            X[XI(pp)] = mk2(A.x - B.y, A.y + B.x); X[XI(pm)] = mk2(A.x + B.y, -A.y + B.x); }
    }
    __syncthreads();
    fft_dit_inv(X, tid);
    const float sk0 = skip[c], sk1 = skip[c + 1], sc = 1.0f / (float)FN;
#pragma unroll 1
    for (int ub = 0; ub < 2; ++ub) { float z0[8], z1[8], x0[8], x1[8];
#pragma unroll
        for (int u = 0; u < 8; ++u) { const int i = tid + NT * (ub * 8 + u); const size_t o0 = (size_t)c * L + i, o1 = (size_t)(c + 1) * L + i; z0[u] = bf2f(zT[o0]); z1[u] = bf2f(zT[o1]); x0[u] = bf2f(x0T[o0]); x1[u] = bf2f(x0T[o1]); }
#pragma unroll
        for (int u = 0; u < 8; ++u) { const int i = tid + NT * (ub * 8 + u); const size_t o0 = (size_t)c * L + i, o1 = (size_t)(c + 1) * L + i; const c2 y = X[XI(i)];
            zT[o0] = (bf16_t)f2bf((y.x * sc * inv0 + sk0 * z0[u]) * x0[u]); zT[o1] = (bf16_t)f2bf((y.y * sc * inv1 + sk1 * z1[u]) * x1[u]); } }
    __syncthreads();
}
__device__ __forceinline__ void gla_scan(const Params& p, int tid) {
    unsigned* ST = (unsigned*)(p.ws + WS_ST); const float* dec = (const float*)(p.ws + WS_DEC);
    const int gt = blockIdx.x * NT + tid, ngt = gridDim.x * NT;
#pragma unroll 1
    for (int e = gt; e < 8 * 16384; e += ngt) {
        const int dh = e >> 14, idx = e & 16383, dir = dh >> 2, h = dh & 3, d = (2 * idx) & 127;
        unsigned* base = ST + (size_t)dh * 128 * 16384 + idx;
        const float* db = dec + ((size_t)dir * 128 * 4 + h) * 128 + d;
        float s0 = 0.f, s1 = 0.f;
#pragma unroll 1
        for (int nb = 0; nb < 128; nb += 16) {
            unsigned kv[16]; c2 dc[16];
#pragma unroll
            for (int u = 0; u < 16; ++u) { const int n = dir ? 127 - (nb + u) : nb + u; kv[u] = base[(size_t)n * 16384]; dc[u] = *(const c2*)(db + (size_t)n * 512); }
#pragma unroll
            for (int u = 0; u < 16; ++u) { const int n = dir ? 127 - (nb + u) : nb + u; base[(size_t)n * 16384] = pk2(s0, s1);
                s0 = dc[u].x * s0 + bf2f(kv[u] & 0xffffu); s1 = dc[u].y * s1 + bf2f(kv[u] >> 16); }
        }
    }
}

__device__ __forceinline__ void gla_out_item(const Params& p, LAS unsigned char* lds, int item, int tid, int lane, int wave) {
    const int h = item & 3, n = item >> 2, t0 = n * 64;
    const bf16_t* pr = (const bf16_t*)(p.ws + WS_PR); const bf16_t* ST = (const bf16_t*)(p.ws + WS_ST); bf16_t* mix = (bf16_t*)(p.ws + WS_MIX);
    const float* og = p.in[25];
    LAS bf16_t* qin = (LAS bf16_t*)lds;
    LAS bf16_t* kin = (LAS bf16_t*)(lds + 34816);
    LAS bf16_t* vT = (LAS bf16_t*)(lds + 69632);
    LAS bf16_t* P = (LAS bf16_t*)(lds + 106496);
    LAS float* lrs = (LAS float*)(lds + 115712); LAS float* tot = (LAS float*)(lds + 123904); LAS float* red = (LAS float*)(lds + 125952);
    gla_stage(pr, (const float*)(p.ws + WS_LR), t0, h, lrs, vT, tid);
    const int d = tid & 127, dir = (tid >> 7) & 1, half = tid >> 8;
    GateW gw; gate_load(p, dir, h, d, gw);
    const bf16_t* qp = pr + (size_t)t0 * PR_LD + PR_Q + h * 128 + d;
    unsigned short kr[8], qr[8];
#pragma unroll
    for (int u = 0; u < 8; ++u) { const int q = half * 32 + u, t = dir ? 63 - q : q; qr[u] = qp[(size_t)t * PR_LD]; kr[u] = qp[(size_t)t * PR_LD + (PR_K - PR_Q)]; }
    const float bpre = half ? ((const float*)(p.ws + WS_T0))[((size_t)(dir * 128 + n) * 4 + h) * 128 + d] : 0.f;
    __syncthreads();
    {
        float b = bpre;
#pragma unroll 1
        for (int sg = 0; sg < 4; ++sg) {
            unsigned short kn[8], qn[8];
#pragma unroll
            for (int u = 0; u < 8; ++u) { const int q = half * 32 + ((sg * 8 + 8 + u) & 31), t = dir ? 63 - q : q; qn[u] = qp[(size_t)t * PR_LD]; kn[u] = qp[(size_t)t * PR_LD + (PR_K - PR_Q)]; }
#pragma unroll
            for (int u = 0; u < 8; ++u) { const int q = half * 32 + sg * 8 + u, t = dir ? 63 - q : q; b += gate_eval(gw, lrs + t * 32 + dir * 16);
                const float qv = bf2f(qr[u]) * 0.08838834764831845f, kv = bf2f(kr[u]);
                qin[(dir * 64 + t) * 136 + d] = (bf16_t)f2bf(qv * __expf(b)); kin[(dir * 64 + t) * 136 + d] = (bf16_t)f2bf(kv * __expf(-b)); }
#pragma unroll
            for (int u = 0; u < 8; ++u) { kr[u] = kn[u]; qr[u] = qn[u]; }
        }
    }
    __syncthreads();
    const int q4 = lane >> 4, fr = lane & 15;
#pragma unroll 1
    for (int ti = 0; ti < 2; ++ti) {
        const int id = wave * 2 + ti, tt = id >> 2, st = id & 3;
        f32x4 af = (f32x4){0.f, 0.f, 0.f, 0.f}, ab = (f32x4){0.f, 0.f, 0.f, 0.f};
        if (tt >= st) {
#pragma unroll
            for (int ks = 0; ks < 4; ++ks) af = __builtin_amdgcn_mfma_f32_16x16x32_bf16(ldfrag(qin, 136, 16 * tt, 32 * ks, lane), ldfrag(kin, 136, 16 * st, 32 * ks, lane), af, 0, 0, 0); }
        if (tt <= st) {
#pragma unroll
            for (int ks = 0; ks < 4; ++ks) ab = __builtin_amdgcn_mfma_f32_16x16x32_bf16(ldfrag(qin + 64 * 136, 136, 16 * tt, 32 * ks, lane), ldfrag(kin + 64 * 136, 136, 16 * st, 32 * ks, lane), ab, 0, 0, 0); }
#pragma unroll
        for (int r = 0; r < 4; ++r) { const int t = 16 * tt + 4 * q4 + r, s = 16 * st + fr; P[t * 72 + s] = (bf16_t)f2bf(t >= s ? af[r] : ab[r]); }
    }
    __syncthreads();
    f32x4 acc[2][4];
#pragma unroll
    for (int mt = 0; mt < 2; ++mt)
#pragma unroll
        for (int nt = 0; nt < 4; ++nt) acc[mt][nt] = (f32x4){0.f, 0.f, 0.f, 0.f};
    const int v0 = wave * 32;
#pragma unroll
    for (int ks = 0; ks < 2; ++ks) {
        const bf16x8 a0 = ldfrag(vT, 72, v0, 32 * ks, lane), a1 = ldfrag(vT, 72, v0 + 16, 32 * ks, lane);
#pragma unroll
        for (int nt = 0; nt < 4; ++nt) { const bf16x8 b = ldfrag(P, 72, 16 * nt, 32 * ks, lane);
            acc[0][nt] = __builtin_amdgcn_mfma_f32_16x16x32_bf16(a0, b, acc[0][nt], 0, 0, 0); acc[1][nt] = __builtin_amdgcn_mfma_f32_16x16x32_bf16(a1, b, acc[1][nt], 0, 0, 0); }
    }
#pragma unroll 1
    for (int dr = 0; dr < 2; ++dr) {
        const bf16_t* S = ST + ((size_t)(dr * 4 + h) * 128 + n) * 32768;
        bf16x8 sa[4][2];
#pragma unroll
        for (int ks = 0; ks < 4; ++ks) { sa[ks][0] = *(const bf16x8*)(S + (size_t)(v0 + fr) * 128 + 32 * ks + 8 * q4); sa[ks][1] = *(const bf16x8*)(S + (size_t)(v0 + 16 + fr) * 128 + 32 * ks + 8 * q4); }
#pragma unroll
        for (int ks = 0; ks < 4; ++ks)
#pragma unroll
            for (int nt = 0; nt < 4; ++nt) { const bf16x8 b = ldfrag(qin + dr * 64 * 136, 136, 16 * nt, 32 * ks, lane);
                acc[0][nt] = __builtin_amdgcn_mfma_f32_16x16x32_bf16(sa[ks][0], b, acc[0][nt], 0, 0, 0); acc[1][nt] = __builtin_amdgcn_mfma_f32_16x16x32_bf16(sa[ks][1], b, acc[1][nt], 0, 0, 0); }
    }
#pragma unroll
    for (int nt = 0; nt < 4; ++nt) { float ss = 0.f;
#pragma unroll
        for (int mt = 0; mt < 2; ++mt) ss += (acc[mt][nt][0] * acc[mt][nt][0] + acc[mt][nt][1] * acc[mt][nt][1]) + (acc[mt][nt][2] * acc[mt][nt][2] + acc[mt][nt][3] * acc[mt][nt][3]);
        ss += __shfl_xor(ss, 16); ss += __shfl_xor(ss, 32);
        if (q4 == 0) red[wave * 64 + 16 * nt + fr] = ss; }
    __syncthreads();
#pragma unroll
    for (int nt = 0; nt < 4; ++nt) { const int t = 16 * nt + fr; float ss = 0.f;
#pragma unroll
        for (int w = 0; w < 8; ++w) ss += red[w * 64 + t];
        const float rs = rsqrtf(ss * (1.0f / 256.0f) + 1e-6f);
#pragma unroll
        for (int mt = 0; mt < 2; ++mt) { const int v = v0 + 16 * mt + 4 * q4; const f32x4 g = *(const f32x4*)(og + h * 256 + v);
            const u32x2 rw = *(const u32x2*)(pr + (size_t)(t0 + t) * PR_LD + PR_R + h * 256 + v);
            const float r0 = bf2f(rw.x & 0xffffu), r1 = bf2f(rw.x >> 16), r2 = bf2f(rw.y & 0xffffu), r3 = bf2f(rw.y >> 16);
            u32x2 w; w.x = pk2(acc[mt][nt][0] * rs * g[0] * silu_f(r0), acc[mt][nt][1] * rs * g[1] * silu_f(r1));
            w.y = pk2(acc[mt][nt][2] * rs * g[2] * silu_f(r2), acc[mt][nt][3] * rs * g[3] * silu_f(r3));
            *(u32x2*)(mix + (size_t)(t0 + t) * DM + HYW + h * 256 + v) = w; }
    }
    __syncthreads();
}
__device__ __forceinline__ void hynorm_tile(const Params& p, LAS unsigned char* lds, int tile, int tid) {
    const bf16_t* yT = (const bf16_t*)(p.ws + WS_ZT); bf16_t* mix = (bf16_t*)(p.ws + WS_MIX); const float* og = p.in[20];
    LAS float* yt = (LAS float*)lds; LAS float* red = yt + 128 * 65;
    const int g = tile & 7, t0 = (tile >> 3) * 64, c0 = g * 128;
    { const int t = tid & 63, cg8 = tid >> 6; float ss = 0.f;
#pragma unroll
      for (int i = 0; i < 16; ++i) { const int cc = cg8 * 16 + i; const float v = bf2f(yT[(size_t)(c0 + cc) * L + t0 + t]); yt[cc * 65 + t] = v; ss += v * v; }
      red[cg8 * 64 + t] = ss; }
    __syncthreads();
    { const int c2 = (tid & 63) * 2, tg = tid >> 6; const float g0 = og[c0 + c2], g1 = og[c0 + c2 + 1];
#pragma unroll
      for (int i = 0; i < 8; ++i) { const int t = tg * 8 + i; float ss = 0.f;
#pragma unroll
          for (int w = 0; w < 8; ++w) ss += red[w * 64 + t];
          const float rs = rsqrtf(ss * (1.0f / 128.0f) + 1e-6f);
          *(unsigned*)(mix + (size_t)(t0 + t) * DM + c0 + c2) = pk2(yt[c2 * 65 + t] * rs * g0, yt[(c2 + 1) * 65 + t] * rs * g1); } }
    __syncthreads();
}

#define XB_TMO      128
#define XB_XCNT(j)  (256  + 64 * (j))
#define XB_XSUB(j)  (1280 + 64 * (j))
#define XB_XGEN(j)  (2304 + 64 * (j))
#define XB_TOP      3328
#define XB_TOPGEN   3392
#define XCD_BAR_WORDS 3456
#define XB_SPIN_CAP (1u << 18)

__device__ __forceinline__ unsigned xb_ld(unsigned* p)              { return __hip_atomic_load(p, __ATOMIC_RELAXED, __HIP_MEMORY_SCOPE_AGENT); }
__device__ __forceinline__ unsigned xb_add(unsigned* p, unsigned v) { return __hip_atomic_fetch_add(p, v, __ATOMIC_RELAXED, __HIP_MEMORY_SCOPE_AGENT); }
__device__ __forceinline__ unsigned xb_xcc_id() { return (unsigned)__builtin_amdgcn_s_getreg((3 << 11) | 20) & 0xFu; }
#define XB_SPIN(cond, bar) do { unsigned _sp = 0; while (cond) { __builtin_amdgcn_s_sleep(1); \
    if ((++_sp & 255u) == 0u) { if (xb_ld(&(bar)[XB_TMO])) break; if (_sp > XB_SPIN_CAP) { atomicAdd(&(bar)[XB_TMO], 1u); break; } } } } while (0)

struct XcdBarrier {
    unsigned* bar; unsigned x;
    volatile LAS unsigned* st;
};

__device__ __forceinline__ XcdBarrier xcd_barrier_post(unsigned* bar, volatile LAS unsigned* st) {
    XcdBarrier b; b.bar = bar; b.x = xb_xcc_id(); b.st = st;
    if (threadIdx.x == 0) (void)xb_add(&bar[XB_XCNT(b.x)], 1u);
    return b;
}
__device__ __forceinline__ void xcd_barrier_complete(unsigned* bar, unsigned x, unsigned& nloc, unsigned& nx) {
    const unsigned G = gridDim.x * gridDim.y * gridDim.z;
    unsigned sum, cnt, mine, sp = 0u;
    for (;;) {
        sum = 0u; cnt = 0u; mine = 0u;
#pragma unroll
        for (unsigned j = 0; j < 16; ++j) { const unsigned c = xb_ld(&bar[XB_XCNT(j)]); sum += c; cnt += (c > 0u) ? 1u : 0u; mine = (j == x) ? c : mine; }
        if (sum == G) break;
        __builtin_amdgcn_s_sleep(1);
        if ((++sp & 255u) == 0u) { if (xb_ld(&bar[XB_TMO])) break; if (sp > XB_SPIN_CAP) { atomicAdd(&bar[XB_TMO], 1u); break; } }
    }
    nloc = mine > 0u ? mine : 1u; nx = cnt > 0u ? cnt : 1u;
}

__device__ __forceinline__ void xcd_barrier(const XcdBarrier& b) {
    asm volatile("s_waitcnt vmcnt(0)" ::: "memory");
    __syncthreads();
    if (threadIdx.x == 0) {
        unsigned* bar = b.bar;
        __builtin_amdgcn_s_waitcnt(0);
        unsigned nloc = b.st[0], nx = b.st[1]; const unsigned bx = b.st[2];
        if (nloc == 0u) { xcd_barrier_complete(bar, bx, nloc, nx); b.st[0] = nloc; b.st[1] = nx; }
        const unsigned old = xb_add(&bar[XB_XSUB(bx)], 1u);
        const unsigned gen = old / nloc;
        if (old + 1u == (gen + 1u) * nloc) {
            __builtin_amdgcn_fence(__ATOMIC_RELEASE, "agent");
            asm volatile("s_waitcnt vmcnt(0)" ::: "memory");
            const unsigned og = xb_add(&bar[XB_TOP], 1u);
            const unsigned tg = og / nx;
            if (og + 1u == (tg + 1u) * nx) xb_add(&bar[XB_TOPGEN], 1u);
            else XB_SPIN(xb_ld(&bar[XB_TOPGEN]) == tg, bar);
            __builtin_amdgcn_fence(__ATOMIC_ACQUIRE, "agent");
            xb_add(&bar[XB_XGEN(bx)], 1u);
            asm volatile("s_waitcnt vmcnt(0)" ::: "memory");
        } else {
            XB_SPIN(xb_ld(&bar[XB_XGEN(bx)]) == gen, bar);
            __builtin_amdgcn_fence(__ATOMIC_ACQUIRE, "agent");
            asm volatile("s_waitcnt vmcnt(0)" ::: "memory");
        }
    }
    __syncthreads();
}

#ifndef REP_P0
#define REP_P0 0
#endif
#ifndef PA_MASK
#define PA_MASK 3
#endif
#ifndef PC_MASK
#define PC_MASK 3
#endif
#ifndef REP_G1
#define REP_G1 0
#endif
#ifndef REP_G3
#define REP_G3 0
#endif
#ifndef P0_MASK
#define P0_MASK 15
#endif
#ifndef REP_PA
#define REP_PA 0
#endif
#ifndef REP_PAB
#define REP_PAB 0
#endif
#ifndef REP_PC
#define REP_PC 0
#endif
__global__ void __launch_bounds__(NT, 2) fwd_megakernel(Params p) {
    extern __shared__ __attribute__((aligned(16))) unsigned char smem[];
    LAS unsigned char* lds = (LAS unsigned char*)smem;
    cg::grid_group grid = cg::this_grid();
    const int G = gridDim.x;
    volatile LAS unsigned* bst = (volatile LAS unsigned*)(lds + LDS_BYTES - 64);
    if (threadIdx.x < 2) bst[threadIdx.x] = 0u;
    __syncthreads();
    XcdBarrier xbar = xcd_barrier_post((unsigned*)(p.ws + WS_BAR), bst);
    if (threadIdx.x == 0) bst[2] = xbar.x;
    if (p.ws == nullptr) grid.sync();
#define TIDS int tid = threadIdx.x; asm volatile("" : "+v"(tid)); const int lane = tid & 63, wave = __builtin_amdgcn_readfirstlane(tid >> 6); (void)lane; (void)wave;
    unsigned char* ws = p.ws;
    float* rowss = (float*)(ws + WS_ROWSS);
    bf16_t* XB = (bf16_t*)(ws + WS_XB); bf16_t* AB = (bf16_t*)(ws + WS_A);

#pragma unroll 1
    for (int rep = 0; rep <= REP_P0; ++rep) {
#ifndef SKIP_P0
        { TIDS; phase0(p, lds, tid, lane, wave, rep == 0 ? 15 : P0_MASK); }
#endif
        xcd_barrier(xbar); }
#ifndef NO_GEMM
#pragma unroll 1
    for (int rg = 0; rg <= REP_G1; ++rg) {
    { pg8::Gemm g{XB, (const bf16_t*)(ws + WS_WFF), L, 2 * FF, DM}; pg8::StaticOrder S; S.init(L, 2 * FF, G, (int)blockIdx.x);
      pg8::EpiSwiGLU E{AB, FF, rowss}; pg8::gemm_phase<pg8::EpiSwiGLU, pg8::StaticOrder, true, true>(lds, g, S, E); }
    { TIDS; const int rem = ((L / 256) * (2 * FF / 256)) % G, nl = rem ? G - rem : G, li = rem ? (int)blockIdx.x - rem : (int)blockIdx.x;
      if (li >= 0) convert_tail1(p, lds, li * 8 + wave, nl * 8, lane, wave); }
    xcd_barrier(xbar);
    }
    { pg8::Gemm g{AB, (const bf16_t*)(ws + WS_WDN), L, DM, FF}; pg8::StaticOrder S; S.init(L, DM, G, (int)blockIdx.x);
      pg8::EpiResid E{p.in[0], nullptr, XB, rowss + L, 0.5f}; pg8::gemm_phase<pg8::EpiResid, pg8::StaticOrder, true, true>(lds, g, S, E); }
    xcd_barrier(xbar);
#pragma unroll 1
    for (int rg = 0; rg <= REP_G3; ++rg) {
    { pg8::Gemm g{XB, (const bf16_t*)(ws + WS_WIN), L, NING, DM}; pg8::StaticOrder S; S.init(L, NING, G, (int)blockIdx.x);
      pg8::EpiP E{(bf16_t*)(ws + WS_PHY), (bf16_t*)(ws + WS_PR), rowss + L}; pg8::gemm_phase<pg8::EpiP, pg8::StaticOrder, true, true>(lds, g, S, E); }
    { TIDS; for (int it = blockIdx.x; it < L / 32; it += G) lr_task(p, lds, it, tid, lane, wave); }
    xcd_barrier(xbar);
    }
#endif
#pragma unroll 1
    for (int rep = 0; rep <= REP_PAB; ++rep) {
#pragma unroll 1
        for (int r2 = 0; r2 <= REP_PA; ++r2) {
#ifndef SKIP_PA
            { pg8::Gemm g{(const bf16_t*)(ws + WS_W4T), (const bf16_t*)(ws + WS_HID), 2048, L, 256}; pg8::StaticOrder S; S.init(2048, L, G, (int)blockIdx.x);
              pg8::EpiFilt E{(bf16_t*)p.out, (bf16_t*)p.out + (size_t)HYW * L, (bf16_t*)p.out + (size_t)(HYW + 768) * L}; pg8::gemm_phase<pg8::EpiFilt, pg8::StaticOrder, true, true>(lds, g, S, E); }
            if (r2 == 0 || (PA_MASK & 1)) { TIDS; for (int it = blockIdx.x; it < 512; it += G) gla_kv_item(p, lds, it, tid, lane, wave); }
            if (r2 == 0 || (PA_MASK & 2)) { TIDS; const bf16_t* phy = (const bf16_t*)(ws + WS_PHY); u32x4 rw[4], rn[4];
              if ((int)blockIdx.x < 2048) convT_fetch(phy, blockIdx.x, tid, rw);
#pragma unroll 1
              for (int it = blockIdx.x; it < 2048; it += G) { const bool more = it + G < 2048; if (more) convT_fetch(phy, it + G, tid, rn);
                  convT_tile(p, lds, it, tid, rw);
                  if (more) {
#pragma unroll
                      for (int k = 0; k < 4; ++k) rw[k] = rn[k]; } } }
#endif
            xcd_barrier(xbar);
        }
#ifndef SKIP_PB
        { TIDS; gla_scan(p, tid); }
        { TIDS; for (int it = blockIdx.x; it < HYW / 2; it += G) hyena_fft_pair(p, lds, it, tid, lane, wave); }
#endif
        xcd_barrier(xbar);
    }
#pragma unroll 1
    for (int rep = 0; rep <= REP_PC; ++rep) {
#ifndef SKIP_PC
        if (rep == 0 || (PC_MASK & 1)) { TIDS; for (int it = blockIdx.x; it < 512; it += G) gla_out_item(p, lds, it, tid, lane, wave); }
        if (rep == 0 || (PC_MASK & 2)) { TIDS; for (int it = blockIdx.x; it < 1024; it += G) hynorm_tile(p, lds, it, tid); }
#endif
        xcd_barrier(xbar);
    }
#ifndef NO_GEMM
    { pg8::Gemm g{(const bf16_t*)(ws + WS_MIX), (const bf16_t*)(ws + WS_WOUT), L, DM, DM}; pg8::StaticOrder S; S.init(L, DM, G, (int)blockIdx.x);
      pg8::EpiResid E{nullptr, XB, XB, rowss + 2 * L, 1.0f}; pg8::gemm_phase<pg8::EpiResid, pg8::StaticOrder, true, true>(lds, g, S, E); }
    __syncthreads();
    { TIDS; convert_gu(p.in[28], p.in[29], p.in[27], ws, lds, blockIdx.x * 8 + wave, G * 8, lane, wave); }
    xcd_barrier(xbar);
    { pg8::Gemm g{XB, (const bf16_t*)(ws + WS_WFF), L, 2 * FF, DM}; pg8::StaticOrder S; S.init(L, 2 * FF, G, (int)blockIdx.x);
      pg8::EpiSwiGLU E{AB, FF, rowss + 2 * L}; pg8::gemm_phase<pg8::EpiSwiGLU, pg8::StaticOrder, true, true>(lds, g, S, E); }
    { TIDS; const int rem = ((L / 256) * (2 * FF / 256)) % G, nl = rem ? G - rem : G, li = rem ? (int)blockIdx.x - rem : (int)blockIdx.x;
      if (li >= 0) convert_dn(p.in[30], ws, lds, li * 8 + wave, nl * 8, lane, wave); }
    xcd_barrier(xbar);
    { pg8::Gemm g{AB, (const bf16_t*)(ws + WS_WDN), L, DM, FF}; pg8::StaticOrder S; S.init(L, DM, G, (int)blockIdx.x);
      pg8::EpiFinal E{XB, p.out, rowss + 3 * L, (unsigned*)(ws + WS_PCNT), p.in[31], 0.5f}; pg8::gemm_phase<pg8::EpiFinal, pg8::StaticOrder, true, true>(lds, g, S, E); }
#endif
}

extern "C" void kernel_launch(void* const* d_in, const int* in_sizes, int n_in, void* d_out, int out_size, void* d_ws, size_t ws_size, hipStream_t stream) {
    static int grid = 0;
    if (grid == 0) {
        if (n_in != 32 || out_size != L * DM || ws_size < WS_END) { fprintf(stderr, "kernel_launch: unexpected problem: n_in %d out %d ws %zu (need %zu)\n", n_in, out_size, ws_size, (size_t)WS_END); grid = -1; return; }
        int dev = 0, cus = 0, per_cu = 0;
        (void)hipGetDevice(&dev); (void)hipDeviceGetAttribute(&cus, hipDeviceAttributeMultiprocessorCount, dev);
        if (hipFuncSetAttribute((const void*)fwd_megakernel, hipFuncAttributeMaxDynamicSharedMemorySize, LDS_BYTES) != hipSuccess) { fprintf(stderr, "kernel_launch: hipFuncSetAttribute failed\n"); grid = -1; return; }
        if (hipOccupancyMaxActiveBlocksPerMultiprocessor(&per_cu, (const void*)fwd_megakernel, NT, LDS_BYTES) != hipSuccess || per_cu < 1) { fprintf(stderr, "kernel_launch: occupancy query gave %d\n", per_cu); per_cu = 1; }
        (void)hipGetLastError();
        grid = cus * per_cu; if (grid > 256) grid = 256;
        if (grid != 256) { fprintf(stderr, "kernel_launch: this kernel needs a 256-workgroup cooperative grid (256 CUs x 1), got %d; nothing launched\n", grid); grid = -1; return; }
        fprintf(stderr, "kernel_launch: cus %d per_cu %d grid %d\n", cus, per_cu, grid);
    }
    if (grid < 0) return;
    Params p{};
    for (int i = 0; i < 32; ++i) p.in[i] = (const float*)d_in[i];
    p.out = (float*)d_out; p.ws = (unsigned char*)d_ws;
    if (hipMemsetAsync((char*)d_ws + WS_BAR, 0, 16384 + 32 * 256, stream) != hipSuccess) { fprintf(stderr, "kernel_launch: hipMemsetAsync failed\n"); return; }
    void* args[] = {&p};
    hipError_t e = hipLaunchCooperativeKernel((const void*)fwd_megakernel, dim3(grid), dim3(NT), args, LDS_BYTES, stream);
    if (e != hipSuccess) fprintf(stderr, "kernel_launch: cooperative launch failed: %s (grid %d)\n", hipGetErrorString(e), grid);
}
```

```cpp
#include <hip/hip_runtime.h>
#include <hip/hip_cooperative_groups.h>
#include <cstdio>
#include <cstdint>
namespace cg = cooperative_groups;

namespace pg8 {
#define PG8_LAS __attribute__((address_space(3)))
typedef unsigned short bf16_t;
typedef short bf16x8 __attribute__((ext_vector_type(8)));
typedef float f32x4 __attribute__((ext_vector_type(4)));
typedef unsigned u32x4 __attribute__((ext_vector_type(4)));
constexpr int BM = 256, BK = 64, HALF = 128, HTB = HALF * BK * 2  , STAGE_BYTES = 8 * HTB, NXCD = 8, WGM = 8;

__host__ __device__ __forceinline__ int lds_byte(int r, int c) { const int st = (r >> 4) * 2 + (c >> 5), rr = r & 15, cc = c & 31, ob = rr * 64 + cc * 2; return st * 1024 + (ob ^ (((ob >> 9) & 1) << 5)); }
__host__ __device__ __forceinline__ void stage_rc(int b, int& R, int& C) { const int st = b / 1024, sb = b % 1024, swz = sb ^ (((sb >> 9) & 1) << 5); R = (st >> 1) * 16 + swz / 64; C = (st & 1) * 32 + (swz % 64) / 2; }
__host__ __device__ __forceinline__ int perm32(int rho) { const int n = rho >> 4, i = rho & 15; return 8 * (i >> 2) + 4 * n + (i & 3); }

struct Unit { int pm, pn; };
struct Gemm { const bf16_t* A; const bf16_t* Bt; int M, N, K; };

struct StaticOrder {
    int nM, nN, nwg, G, c;
    __host__ __device__ void init(int M, int N, int G_, int c_) { nM = M / BM; nN = N / BM; nwg = nM * nN; G = G_; c = c_; }
    __host__ __device__ bool next(int i, Unit& u) const {
        const long L = (long)i * G + c; if (L >= nwg) return false;
        int wgid = (int)L; { const int q = nwg / NXCD, r = nwg % NXCD, xcd = wgid % NXCD, off = wgid / NXCD; wgid = (xcd < r ? xcd * (q + 1) : r * (q + 1) + (xcd - r) * q) + off; }
        const int nig = WGM * nN, gid = wgid / nig, fm = gid * WGM, gsz = (nM - fm) < WGM ? (nM - fm) : WGM;
        u.pm = fm + ((wgid % nig) % gsz); u.pn = (wgid % nig) / gsz; return true;
    }
    __device__ __forceinline__ void a_ready(const Unit&) const {}
    __device__ __forceinline__ void done(const Unit&) const {}
};
__device__ __forceinline__ unsigned cvt_pk_bf16(float lo, float hi) { unsigned r; asm volatile("v_cvt_pk_bf16_f32 %0, %1, %2" : "=v"(r) : "v"(lo), "v"(hi)); return r; }
typedef unsigned u32x4 __attribute__((ext_vector_type(4)));
typedef unsigned u32x2 __attribute__((ext_vector_type(2)));
__device__ __forceinline__ float rstd_of(float ss) { return rsqrtf(ss * (1.0f / 2048.0f) + 1e-6f); }
__device__ __forceinline__ float silu_f(float x) { return x * __builtin_amdgcn_rcpf(1.0f + __expf(-x)); }

struct EpiSwiGLU {
    static constexpr bool PERM = true, AFTER_DRAIN = false;
    bf16_t* O; int ldc; const float* rowss;
    __device__ __forceinline__ void operator()(const f32x4 (&acc)[2][2][4][2], const Unit& u, int wr, int wc, int fr, int fq) const {
        const int row0 = u.pm * BM + wr * 64 + fr, col0 = u.pn * 128 + wc * 32 + 8 * fq;
#pragma unroll
        for (int ai = 0; ai < 2; ++ai)
#pragma unroll
            for (int m = 0; m < 4; ++m) {
                const int row = row0 + ai * HALF + m * 16; const float rs = rstd_of(rowss[row]);
                float v[8];
#pragma unroll
                for (int n = 0; n < 2; ++n)
#pragma unroll
                    for (int j = 0; j < 4; ++j) v[n * 4 + j] = silu_f(acc[ai][0][m][n][j] * rs) * (acc[ai][1][m][n][j] * rs);
                u32x4 w; w.x = cvt_pk_bf16(v[0], v[1]); w.y = cvt_pk_bf16(v[2], v[3]); w.z = cvt_pk_bf16(v[4], v[5]); w.w = cvt_pk_bf16(v[6], v[7]);
                *(u32x4*)(O + (size_t)row * ldc + col0) = w;
            }
    }
};
struct EpiResid {
    static constexpr bool PERM = false, AFTER_DRAIN = false;
    const float* base; const bf16_t* base16; bf16_t* ob; float* rowss; float scale;
    __device__ __forceinline__ void operator()(const f32x4 (&acc)[2][2][4][2], const Unit& u, int wr, int wc, int fr, int fq) const {
        const int row0 = u.pm * BM + wr * 64 + fr, col0 = u.pn * BM + wc * 32 + 4 * fq;
#pragma unroll
        for (int ai = 0; ai < 2; ++ai)
#pragma unroll
            for (int m = 0; m < 4; ++m) {
                const int row = row0 + ai * HALF + m * 16; float ss = 0.f;
#pragma unroll
                for (int bj = 0; bj < 2; ++bj)
#pragma unroll
                    for (int n = 0; n < 2; ++n) {
                        const size_t off = (size_t)row * 2048 + col0 + bj * HALF + n * 16;
                        f32x4 b;
                        if (base) b = *(const f32x4*)(base + off);
                        else { const u32x2 r = *(const u32x2*)(base16 + off); b = (f32x4){__builtin_bit_cast(float, r.x << 16), __builtin_bit_cast(float, r.x & 0xffff0000u), __builtin_bit_cast(float, r.y << 16), __builtin_bit_cast(float, r.y & 0xffff0000u)}; }
                        const f32x4 v = b + acc[ai][bj][m][n] * scale;
                        { u32x2 w; w.x = cvt_pk_bf16(v[0], v[1]); w.y = cvt_pk_bf16(v[2], v[3]); *(u32x2*)(ob + off) = w; }
                        ss += (v[0] * v[0] + v[1] * v[1]) + (v[2] * v[2] + v[3] * v[3]);
                    }
                ss += __shfl_xor(ss, 16); ss += __shfl_xor(ss, 32);
                if (rowss && fq == 0) atomicAdd(rowss + row, ss);
            }
    }
};
struct EpiP {
    static constexpr bool PERM = true, AFTER_DRAIN = false;
    bf16_t* phy; bf16_t* pr; const float* rowss;
    __device__ __forceinline__ void operator()(const f32x4 (&acc)[2][2][4][2], const Unit& u, int wr, int wc, int fr, int fq) const {
        const int row0 = u.pm * BM + wr * 64 + fr;
        bf16_t* O; int ldc, colt;
        if (u.pn < 12) { O = phy; ldc = 3072; colt = u.pn * BM; } else { O = pr; ldc = 3072; colt = (u.pn - 12) * BM; }
        const int col0 = colt + wc * 32 + 8 * fq;
#pragma unroll
        for (int ai = 0; ai < 2; ++ai)
#pragma unroll
            for (int m = 0; m < 4; ++m) {
                const int row = row0 + ai * HALF + m * 16; const float rs = rstd_of(rowss[row]);
#pragma unroll
                for (int bj = 0; bj < 2; ++bj) {
                    const f32x4 v0 = acc[ai][bj][m][0] * rs, v1 = acc[ai][bj][m][1] * rs;
                    u32x4 w; w.x = cvt_pk_bf16(v0[0], v0[1]); w.y = cvt_pk_bf16(v0[2], v0[3]); w.z = cvt_pk_bf16(v1[0], v1[1]); w.w = cvt_pk_bf16(v1[2], v1[3]);
                    *(u32x4*)(O + (size_t)row * ldc + col0 + bj * HALF) = w;
                }
            }
    }
};

struct EpiFilt {
    static constexpr bool PERM = false, AFTER_DRAIN = false;
    bf16_t* Ff; bf16_t* Fb0; bf16_t* Fb1;
    __device__ __forceinline__ void operator()(const f32x4 (&acc)[2][2][4][2], const Unit& u, int wr, int wc, int fr, int fq) const {
        const int row0 = u.pm * BM + wr * 64 + fr, col0 = u.pn * BM + wc * 32 + 4 * fq;
        const float dmin = -3.0701134573253945f, dmax = -15.350567286626973f;
#pragma unroll
        for (int ai = 0; ai < 2; ++ai)
#pragma unroll
            for (int m = 0; m < 4; ++m) {
                const int cc = row0 + ai * HALF + m * 16, c = cc & 1023;
                const float del = __builtin_fabsf(dmin + (float)c * ((dmax - dmin) / 1023.0f)) * (1.0f / 8191.0f);
                bf16_t* dst = cc < 1024 ? Ff + (size_t)c * 8192 : (c < 768 ? Fb0 + (size_t)c * 8192 : Fb1 + (size_t)(c - 768) * 8192);
#pragma unroll
                for (int bj = 0; bj < 2; ++bj)
#pragma unroll
                    for (int n = 0; n < 2; ++n) {
                        const int i = col0 + bj * HALF + n * 16; f32x4 v = acc[ai][bj][m][n];
#pragma unroll
                        for (int j = 0; j < 4; ++j) v[j] *= __expf(-(float)(i + j) * del);
                        { u32x2 w; w.x = cvt_pk_bf16(v[0], v[1]); w.y = cvt_pk_bf16(v[2], v[3]); *(u32x2*)(dst + i) = w; }
                    }
            }
    }
};

struct EpiFinal {
    static constexpr bool PERM = false, AFTER_DRAIN = false;
    const bf16_t* base16; float* out; float* rowss; unsigned* cnt; const float* g; float scale;
    __device__ __forceinline__ void operator()(f32x4 (&acc)[2][2][4][2], const Unit& u, int wr, int wc, int fr, int fq) const {
        const int row0 = u.pm * BM + wr * 64 + fr, col0 = u.pn * BM + wc * 32 + 4 * fq;
#pragma unroll
        for (int ai = 0; ai < 2; ++ai)
#pragma unroll
            for (int m = 0; m < 4; ++m) {
                const int row = row0 + ai * HALF + m * 16; float ss = 0.f;
#pragma unroll
                for (int bj = 0; bj < 2; ++bj)
#pragma unroll
                    for (int n = 0; n < 2; ++n) {
                        const size_t off = (size_t)row * 2048 + col0 + bj * HALF + n * 16;
                        const u32x2 r = *(const u32x2*)(base16 + off);
                        const f32x4 v = (f32x4){__builtin_bit_cast(float, r.x << 16), __builtin_bit_cast(float, r.x & 0xffff0000u), __builtin_bit_cast(float, r.y << 16), __builtin_bit_cast(float, r.y & 0xffff0000u)} + acc[ai][bj][m][n] * scale;
                        acc[ai][bj][m][n] = v; ss += (v[0] * v[0] + v[1] * v[1]) + (v[2] * v[2] + v[3] * v[3]);
                    }
                ss += __shfl_xor(ss, 16); ss += __shfl_xor(ss, 32);
                if (fq == 0) atomicAdd(rowss + row, ss);
            }
        asm volatile("s_waitcnt vmcnt(0)" ::: "memory");
        __syncthreads();
        if (threadIdx.x == 0) {
            unsigned* c = cnt + 64 * u.pm;
            __builtin_amdgcn_fence(__ATOMIC_RELEASE, "agent"); asm volatile("s_waitcnt vmcnt(0)" ::: "memory");
            __hip_atomic_fetch_add(c, 1u, __ATOMIC_RELAXED, __HIP_MEMORY_SCOPE_AGENT);
            unsigned spins = 0;
            while (__hip_atomic_load(c, __ATOMIC_RELAXED, __HIP_MEMORY_SCOPE_AGENT) < 8u) { __builtin_amdgcn_s_sleep(2); if (++spins > (1u << 22)) break; }
            __builtin_amdgcn_fence(__ATOMIC_ACQUIRE, "agent"); asm volatile("s_waitcnt vmcnt(0)" ::: "memory");
        }
        __syncthreads();
#pragma unroll
        for (int ai = 0; ai < 2; ++ai)
#pragma unroll
            for (int m = 0; m < 4; ++m) {
                const int row = row0 + ai * HALF + m * 16; const float rs = rstd_of(__hip_atomic_load(rowss + row, __ATOMIC_RELAXED, __HIP_MEMORY_SCOPE_AGENT));
#pragma unroll
                for (int bj = 0; bj < 2; ++bj)
#pragma unroll
                    for (int n = 0; n < 2; ++n) {
                        const int col = col0 + bj * HALF + n * 16; const f32x4 gg = *(const f32x4*)(g + col);
                        *(f32x4*)(out + (size_t)row * 2048 + col) = acc[ai][bj][m][n] * rs * gg;
                    }
            }
    }
};
template <class Epi, class Sched, bool ALIGN_EPI = false, bool SP2 = false>
__device__ __forceinline__ void gemm_phase(PG8_LAS unsigned char* lds, const Gemm g, const Sched& S, const Epi& E) {
    int tid_ = threadIdx.x; asm volatile("" : "+v"(tid_));
    const int tid = tid_, wid = __builtin_amdgcn_readfirstlane(tid >> 6), lane = tid & 63, wr = wid >> 2, wc = wid & 3, fr = lane & 15, fq = lane >> 4;
    const int K = g.K, nt = K / BK;
    unsigned voffA[2], voffB[2];
#pragma unroll
    for (int i = 0; i < 2; ++i) { int R, C; stage_rc(tid * 16 + i * 8192, R, C); const int Rb = Epi::PERM ? ((R & ~31) + perm32(R & 31)) : R;
        voffA[i] = (unsigned)(R * K + C) * 2u; voffB[i] = (unsigned)(Rb * K + C) * 2u; }
    const size_t kstep = (size_t)(BK * 2);
    const size_t hstep = (size_t)HALF * K * 2;
    const size_t tstep = 2 * hstep;
    const unsigned ldsw = (unsigned)wid * 1024u;
    const int aoff = lds_byte(wr * 64 + fr, fq * 8), boff = lds_byte(wc * 32 + fr, fq * 8);
#define PG8_SA(b, h) (((b) * 2 + (h)) * HTB)
#define PG8_SB(b, h) ((4 + (b) * 2 + (h)) * HTB)
#define PG8_STAGE(bufoff, gbase, voff) do { _Pragma("unroll") for (int _i = 0; _i < 2; ++_i) \
        __builtin_amdgcn_global_load_lds((const unsigned*)((const char*)(gbase) + (voff)[_i]), (PG8_LAS unsigned*)(lds + (bufoff) + ldsw + _i * 8192), 16, 0, 0); } while (0)
#define PG8_LDA(dst, b, h) do { _Pragma("unroll") for (int m = 0; m < 4; ++m) _Pragma("unroll") for (int k = 0; k < 2; ++k) dst[m][k] = *(const PG8_LAS bf16x8*)(lds + PG8_SA(b, h) + aoff + m * 2048 + k * 1024); } while (0)
#define PG8_LDB(dst, b, h) do { _Pragma("unroll") for (int n = 0; n < 2; ++n) _Pragma("unroll") for (int k = 0; k < 2; ++k) dst[n][k] = *(const PG8_LAS bf16x8*)(lds + PG8_SB(b, h) + boff + n * 2048 + k * 1024); } while (0)
#define PG8_MMA(ai, bj, At, Bt) do { __builtin_amdgcn_s_setprio(1); _Pragma("unroll") for (int m = 0; m < 4; ++m) _Pragma("unroll") for (int n = 0; n < 2; ++n) _Pragma("unroll") for (int k = 0; k < 2; ++k) \
        acc[ai][bj][m][n] = __builtin_amdgcn_mfma_f32_16x16x32_bf16(Bt[n][k], At[m][k], acc[ai][bj][m][n], 0, 0, 0); __builtin_amdgcn_s_setprio(0); } while (0)
#define PG8_WAIT_V(n) asm volatile("s_waitcnt vmcnt(" #n ")" ::: "memory")
#define PG8_WAIT_L(n) asm volatile("s_waitcnt lgkmcnt(" #n ")" ::: "memory")
#define PG8_BAR __builtin_amdgcn_s_barrier()
#define PG8_SCHED __builtin_amdgcn_sched_barrier(0)
    Unit cur, nxt; int ui = 0;
    if (!S.next(0, cur)) return;
    f32x4 acc[2][2][4][2];
#pragma unroll
    for (int a = 0; a < 2; ++a)
#pragma unroll
        for (int b = 0; b < 2; ++b)
#pragma unroll
            for (int m = 0; m < 4; ++m)
#pragma unroll
                for (int n = 0; n < 2; ++n) acc[a][b][m][n] = (f32x4){0.f, 0.f, 0.f, 0.f};
    bf16x8 At[4][2], B0[2][2], B1[2][2];
    const char* cA = (const char*)g.A + (size_t)cur.pm * tstep; const char* cB = (const char*)g.Bt + (size_t)cur.pn * tstep;
    S.a_ready(cur);
    if constexpr (SP2) {
        PG8_STAGE(PG8_SB(0, 0), cB, voffB); PG8_STAGE(PG8_SB(0, 1), cB + hstep, voffB); PG8_STAGE(PG8_SA(0, 0), cA, voffA); PG8_STAGE(PG8_SA(0, 1), cA + hstep, voffA);
        if (wr == 1) PG8_BAR;
        PG8_WAIT_V(2); PG8_BAR;
        PG8_STAGE(PG8_SB(1, 0), cB + kstep, voffB); PG8_STAGE(PG8_SA(1, 0), cA + kstep, voffA); PG8_STAGE(PG8_SB(1, 1), cB + hstep + kstep, voffB);
        PG8_WAIT_V(6); PG8_BAR;
    } else {
        PG8_STAGE(PG8_SB(0, 0), cB, voffB); PG8_STAGE(PG8_SA(0, 0), cA, voffA); PG8_STAGE(PG8_SB(0, 1), cB + hstep, voffB); PG8_STAGE(PG8_SA(0, 1), cA + hstep, voffA);
        if (wr == 1) PG8_BAR;
        PG8_WAIT_V(4); PG8_BAR;
        PG8_STAGE(PG8_SB(1, 0), cB + kstep, voffB); PG8_STAGE(PG8_SA(1, 0), cA + kstep, voffA); PG8_STAGE(PG8_SB(1, 1), cB + hstep + kstep, voffB);
        PG8_WAIT_V(6); PG8_BAR;
    }
    for (;;) {
        const bool has_next = S.next(ui + 1, nxt);
        const char* nA = has_next ? (const char*)g.A + (size_t)nxt.pm * tstep : cA; const char* nB = has_next ? (const char*)g.Bt + (size_t)nxt.pn * tstep : cB;
        for (int t = 0; t < nt; t += 2) {
            const bool last = (t == nt - 2);
            const char* a1 = cA + (size_t)(t + 1) * kstep;
            const char* a2 = last ? nA : cA + (size_t)(t + 2) * kstep; const char* b2 = last ? nB : cB + (size_t)(t + 2) * kstep;
            const char* a3 = a2 + kstep; const char* b3 = b2 + kstep;
            if (last && has_next) S.a_ready(nxt);
            if constexpr (SP2) {
            PG8_LDB(B0, 0, 0); PG8_LDB(B1, 0, 1); PG8_SCHED; PG8_LDA(At, 0, 0); PG8_STAGE(PG8_SA(1, 1), a1 + hstep, voffA);
            PG8_WAIT_V(8); PG8_WAIT_L(0); PG8_BAR; PG8_MMA(0, 0, At, B0); PG8_MMA(0, 1, At, B1); PG8_BAR; PG8_SCHED;
            PG8_LDA(At, 0, 1); PG8_STAGE(PG8_SB(0, 0), b2, voffB); PG8_STAGE(PG8_SB(0, 1), b2 + hstep, voffB); PG8_STAGE(PG8_SA(0, 0), a2, voffA);
            PG8_WAIT_V(8); PG8_WAIT_L(0); PG8_BAR; PG8_MMA(1, 0, At, B0); PG8_MMA(1, 1, At, B1); PG8_BAR; PG8_SCHED;
            PG8_LDB(B0, 1, 0); PG8_LDB(B1, 1, 1); PG8_SCHED; PG8_LDA(At, 1, 0); PG8_STAGE(PG8_SA(0, 1), a2 + hstep, voffA);
            PG8_WAIT_V(8); PG8_WAIT_L(0); PG8_BAR; PG8_MMA(0, 0, At, B0); PG8_MMA(0, 1, At, B1); PG8_BAR; PG8_SCHED;
            PG8_LDA(At, 1, 1); PG8_STAGE(PG8_SB(1, 0), b3, voffB); PG8_STAGE(PG8_SB(1, 1), b3 + hstep, voffB); PG8_STAGE(PG8_SA(1, 0), a3, voffA);
            PG8_WAIT_V(8); PG8_WAIT_L(0); PG8_BAR; PG8_MMA(1, 0, At, B0); PG8_MMA(1, 1, At, B1); PG8_BAR; PG8_SCHED;
            } else {
            PG8_LDB(B0, 0, 0); PG8_SCHED; PG8_LDA(At, 0, 0); PG8_STAGE(PG8_SA(1, 1), a1 + hstep, voffA);
            PG8_WAIT_L(8); PG8_BAR; PG8_WAIT_L(0); PG8_MMA(0, 0, At, B0); PG8_BAR; PG8_SCHED;
            PG8_LDB(B1, 0, 1); PG8_STAGE(PG8_SB(0, 0), b2, voffB);
            PG8_BAR; PG8_WAIT_L(0); PG8_MMA(0, 1, At, B1); PG8_BAR;
            PG8_LDA(At, 0, 1); PG8_STAGE(PG8_SA(0, 0), a2, voffA);
            PG8_BAR; PG8_WAIT_L(0); PG8_MMA(1, 0, At, B0); PG8_BAR; PG8_SCHED;
            PG8_STAGE(PG8_SB(0, 1), b2 + hstep, voffB);
            PG8_WAIT_V(6); PG8_BAR; PG8_MMA(1, 1, At, B1); PG8_BAR;
            PG8_LDB(B0, 1, 0); PG8_SCHED; PG8_LDA(At, 1, 0); PG8_STAGE(PG8_SA(0, 1), a2 + hstep, voffA);
            PG8_WAIT_L(8); PG8_BAR; PG8_WAIT_L(0); PG8_MMA(0, 0, At, B0); PG8_BAR; PG8_SCHED;
            PG8_LDB(B1, 1, 1); PG8_STAGE(PG8_SB(1, 0), b3, voffB);
            PG8_BAR; PG8_WAIT_L(0); PG8_MMA(0, 1, At, B1); PG8_BAR;
            PG8_LDA(At, 1, 1); PG8_STAGE(PG8_SA(1, 0), a3, voffA);
            PG8_BAR; PG8_WAIT_L(0); PG8_MMA(1, 0, At, B0); PG8_BAR; PG8_SCHED;
            PG8_STAGE(PG8_SB(1, 1), b3 + hstep, voffB);
            PG8_WAIT_V(6); PG8_BAR; PG8_MMA(1, 1, At, B1); PG8_BAR;
            }
        }
        if constexpr (ALIGN_EPI) { if (wr == 0) PG8_BAR; }
        if constexpr (!Epi::AFTER_DRAIN) { E(acc, cur, wr, wc, fr, fq); S.done(cur); }
        if (!has_next) break;
#pragma unroll
        for (int a = 0; a < 2; ++a)
#pragma unroll
            for (int b = 0; b < 2; ++b)
#pragma unroll
                for (int m = 0; m < 4; ++m)
#pragma unroll
                    for (int n = 0; n < 2; ++n) acc[a][b][m][n] = (f32x4){0.f, 0.f, 0.f, 0.f};
        cur = nxt; cA = nA; cB = nB; ++ui;
        if constexpr (ALIGN_EPI) { if (wr == 1) PG8_BAR; }
    }
    PG8_WAIT_V(0);
    if constexpr (!ALIGN_EPI) { if (wr == 0) PG8_BAR; }
    PG8_BAR;
    if constexpr (Epi::AFTER_DRAIN) { E.fused(acc, cur, wr, wc, fr, fq, lds, wid, lane); S.done(cur); }
#undef PG8_SA
#undef PG8_SB
#undef PG8_STAGE
#undef PG8_LDA
#undef PG8_LDB
#undef PG8_MMA
#undef PG8_WAIT_V
#undef PG8_WAIT_L
#undef PG8_BAR
#undef PG8_SCHED
}
}
using pg8::silu_f;

constexpr int L = 8192, DM = 2048, FF = 5632, NIN = 6176, NING = 6144, HYW = 1024;
constexpr int PHY_LD = 3072, PR_LD = 3072;
constexpr int PR_Q = 0, PR_K = 512, PR_V = 1024, PR_R = 2048;
constexpr int NT = 512;
constexpr int LDS_BYTES = 147456;
constexpr int FN = 16384;

constexpr size_t MiB = 1u << 20;
constexpr size_t WS_ROWSS = 0;
constexpr size_t WS_DEC = 128 * 1024;
constexpr size_t WS_PCNT = 640 * 1024 + 16384;
constexpr size_t WS_BAR = 640 * 1024;
constexpr size_t WS_W4T = 1 * MiB;
constexpr size_t WS_HID = 2 * MiB;
constexpr size_t WS_SK = 6 * MiB;
constexpr size_t SK_STRIDE = 8448;
constexpr size_t WS_WFF = 39 * MiB;
constexpr size_t WS_WDN = WS_WFF + 44 * MiB;
constexpr size_t WS_ST = WS_WFF;
constexpr size_t WS_WIN = 105 * MiB;
constexpr size_t WS_WOUT = 130 * MiB;
constexpr size_t WS_XB = 138 * MiB;
constexpr size_t WS_A = 170 * MiB;
constexpr size_t WS_ZT = WS_A;
constexpr size_t WS_X0T = WS_A + 32 * MiB;
constexpr size_t WS_PHY = 258 * MiB;
constexpr size_t WS_MIX = WS_PHY;
constexpr size_t WS_PR = 306 * MiB;
constexpr size_t WS_LR = WS_PR + 48 * MiB;
constexpr size_t WS_T0 = WS_PR + 49 * MiB;
constexpr size_t WS_END = 358 * MiB;

typedef unsigned short bf16_t;
typedef short bf16x8 __attribute__((ext_vector_type(8)));
typedef float f32x4 __attribute__((ext_vector_type(4)));
typedef unsigned u32x4 __attribute__((ext_vector_type(4)));
typedef unsigned u32x2 __attribute__((ext_vector_type(2)));
#define LAS __attribute__((address_space(3)))
typedef float c2 __attribute__((ext_vector_type(2)));
__device__ __forceinline__ c2 mk2(float a, float b) { return (c2){a, b}; }
#define LDS_WAIT() asm volatile("s_waitcnt lgkmcnt(0)" ::: "memory")

__device__ __forceinline__ unsigned f2bf(float f) { unsigned u = __builtin_bit_cast(unsigned, f); return (u + 0x7fffu + ((u >> 16) & 1u)) >> 16; }
__device__ __forceinline__ unsigned pk2(float lo, float hi) { return f2bf(lo) | (f2bf(hi) << 16); }
__device__ __forceinline__ float bf2f(unsigned h) { return __builtin_bit_cast(float, h << 16); }
__device__ __forceinline__ float wave_sum(float v) {
#pragma unroll
    for (int o = 1; o < 64; o <<= 1) v += __shfl_xor(v, o);
    return v;
}

struct Params {
    const float* in[32];
    float* out;
    unsigned char* ws;
};

__device__ __forceinline__ void transpose_item(const float* __restrict__ W, int K, int N, bf16_t* __restrict__ WT, int mode, const float* __restrict__ gain, LAS float* scr, int item, int lane) {
    const int nblk = N / 32, kb = item / nblk, nb = item % nblk, k0 = 64 * kb, n0 = 32 * nb;
    const int drow0 = mode == 0 ? n0 : (256 * (n0 >> 7) + (n0 & 127) + (mode == 2 ? 128 : 0));
    const int c = lane & 7;
    f32x4 g0 = (f32x4){1.f, 1.f, 1.f, 1.f}, g1 = g0;
    if (gain) { g0 = *(const f32x4*)(gain + k0 + 8 * c); g1 = *(const f32x4*)(gain + k0 + 8 * c + 4); }
    float v[32];
    const float* wp = W + (size_t)(k0 + (lane >> 5)) * N + n0 + (lane & 31);
#pragma unroll
    for (int i = 0; i < 32; ++i) v[i] = __builtin_nontemporal_load(wp + (size_t)(2 * i) * N);
#pragma unroll
    for (int i = 0; i < 32; ++i) scr[(2 * i + (lane >> 5)) * 33 + (lane & 31)] = v[i];
    LDS_WAIT(); asm volatile("" ::: "memory");
#pragma unroll
    for (int j = 0; j < 4; ++j) { const int n = (lane >> 3) + 8 * j; const LAS float* s = scr + (8 * c) * 33 + n;
        u32x4 o; o.x = pk2(s[0 * 33] * g0[0], s[1 * 33] * g0[1]); o.y = pk2(s[2 * 33] * g0[2], s[3 * 33] * g0[3]); o.z = pk2(s[4 * 33] * g1[0], s[5 * 33] * g1[1]); o.w = pk2(s[6 * 33] * g1[2], s[7 * 33] * g1[3]);
        *(u32x4*)(WT + (size_t)(drow0 + n) * K + k0 + 8 * c) = o; }
    LDS_WAIT(); asm volatile("" ::: "memory");
}
constexpr int IT_FF = (DM / 64) * (FF / 32);
__device__ __forceinline__ void convert_gu(const float* wg, const float* wu, const float* gain, unsigned char* ws, LAS unsigned char* lds, int gw, int ngw, int lane, int wave) {
    LAS float* scr = (LAS float*)(lds + wave * 8448); bf16_t* WGU = (bf16_t*)(ws + WS_WFF);
#pragma unroll 1
    for (int it = gw; it < 2 * IT_FF; it += ngw) { if (it < IT_FF) transpose_item(wg, DM, FF, WGU, 1, gain, scr, it, lane); else transpose_item(wu, DM, FF, WGU, 2, gain, scr, it - IT_FF, lane); }
}
__device__ __forceinline__ void convert_dn(const float* wd, unsigned char* ws, LAS unsigned char* lds, int gw, int ngw, int lane, int wave) {
    LAS float* scr = (LAS float*)(lds + wave * 8448); bf16_t* WDN = (bf16_t*)(ws + WS_WDN);
#pragma unroll 1
    for (int it = gw; it < IT_FF; it += ngw) transpose_item(wd, FF, DM, WDN, 0, nullptr, scr, it, lane);
}
__device__ __forceinline__ void convert_tail1(const Params& p, LAS unsigned char* lds, int gw, int ngw, int lane, int wave) {
    LAS float* scr = (LAS float*)(lds + wave * 8448); unsigned char* ws = p.ws;
    constexpr int IT_IN = (DM / 64) * (NIN / 32), IT_OUT = (DM / 64) * (DM / 32);
#pragma unroll 1
    for (int it = gw; it < IT_FF + IT_IN + IT_OUT; it += ngw) {
        if (it < IT_FF) transpose_item(p.in[4], FF, DM, (bf16_t*)(ws + WS_WDN), 0, nullptr, scr, it, lane);
        else if (it < IT_FF + IT_IN) transpose_item(p.in[6], DM, NIN, (bf16_t*)(ws + WS_WIN), 0, p.in[5], scr, it - IT_FF, lane);
        else transpose_item(p.in[26], DM, DM, (bf16_t*)(ws + WS_WOUT), 0, nullptr, scr, it - IT_FF - IT_IN, lane);
    }
}
__device__ __forceinline__ void hid_pass(const Params& p, LAS float* sm, const LAS float* WL, int pos0, int tid) {
    const float* b1 = p.in[10]; const float* f1 = p.in[11]; const float* b2 = p.in[13]; const float* f2 = p.in[14]; const float* b3 = p.in[16]; const float* f3 = p.in[17];
    bf16_t* hidx = (bf16_t*)(p.ws + WS_HID);
    const int pp = tid >> 6, j = tid & 63, pos = pos0 + pp;
    LAS float* Z = sm; LAS float* H1 = sm + 512; LAS float* H2 = sm + 1024;
    const LAS float* w1 = WL; const LAS float* w2 = WL + 33 * 64; const LAS float* w3 = w2 + 64 * 64;
    if (j < 33) {
        float z;
        if (j == 0) z = (float)pos / 8191.0f;
        else {
            const int b = (j - 1) & 15; const float fj = 1e-4f + (float)b * ((15.0f - 1e-4f) / 15.0f);
            const double r = (double)pos * (double)fj * (1.0 / 8192.0); const float fr = (float)(r - floor(r));
            float s, c; sincospif(2.0f * fr, &s, &c);
            z = (j <= 16) ? c : -s;
        }
        Z[pp * 40 + j] = z;
    }
    __syncthreads();
    float a, a0 = b1[j] + Z[pp * 40 + 32] * w1[32 * 64 + j], a1 = 0.f, a2 = 0.f, a3 = 0.f;
#pragma unroll
    for (int k4 = 0; k4 < 8; ++k4) { const f32x4 h = *(const LAS f32x4*)(Z + pp * 40 + 4 * k4);
        a0 += h[0] * w1[(4 * k4 + 0) * 64 + j]; a1 += h[1] * w1[(4 * k4 + 1) * 64 + j]; a2 += h[2] * w1[(4 * k4 + 2) * 64 + j]; a3 += h[3] * w1[(4 * k4 + 3) * 64 + j]; }
    a = (a0 + a1) + (a2 + a3);
    H1[pp * 64 + j] = sinf(f1[j] * a);
    __syncthreads();
    a0 = b2[j]; a1 = 0.f; a2 = 0.f; a3 = 0.f;
#pragma unroll
    for (int k4 = 0; k4 < 16; ++k4) { const f32x4 h = *(const LAS f32x4*)(H1 + pp * 64 + 4 * k4);
        a0 += h[0] * w2[(4 * k4 + 0) * 64 + j]; a1 += h[1] * w2[(4 * k4 + 1) * 64 + j]; a2 += h[2] * w2[(4 * k4 + 2) * 64 + j]; a3 += h[3] * w2[(4 * k4 + 3) * 64 + j]; }
    a = (a0 + a1) + (a2 + a3);
    H2[pp * 64 + j] = sinf(f2[j] * a);
    __syncthreads();
    a0 = b3[j]; a1 = 0.f; a2 = 0.f; a3 = 0.f;
#pragma unroll
    for (int k4 = 0; k4 < 16; ++k4) { const f32x4 h = *(const LAS f32x4*)(H2 + pp * 64 + 4 * k4);
        a0 += h[0] * w3[(4 * k4 + 0) * 64 + j]; a1 += h[1] * w3[(4 * k4 + 1) * 64 + j]; a2 += h[2] * w3[(4 * k4 + 2) * 64 + j]; a3 += h[3] * w3[(4 * k4 + 3) * 64 + j]; }
    a = (a0 + a1) + (a2 + a3);
    { const float h3 = sinf(f3[j] * a); const unsigned hi = f2bf(h3); bf16_t* hr = hidx + (size_t)pos * 256 + j; hr[0] = (bf16_t)hi; hr[64] = (bf16_t)f2bf(h3 - bf2f(hi)); hr[128] = (bf16_t)hi; hr[192] = 0; }
}
__device__ __forceinline__ void phase0(const Params& p, LAS unsigned char* lds, int tid, int lane, int wave, int mask) {
    const int G = gridDim.x, gw = blockIdx.x * 8 + wave, ngw = G * 8;
    unsigned char* ws = p.ws;
#pragma unroll 1
    for (int step = 0; step < 2; ++step) {
    if ((step == 0) == (((blockIdx.x >> 3) & 1) == 0)) {
    if (mask & 1) convert_gu(p.in[2], p.in[3], p.in[1], ws, lds, gw, ngw, lane, wave);
    const int gt = blockIdx.x * NT + tid, ngt = G * NT;
    {
      float* rs = (float*)(ws + WS_ROWSS) + L; for (int i = gt; i < 3 * L; i += ngt) rs[i] = 0.f; }
    { const float* w4 = p.in[18]; bf16_t* tx = (bf16_t*)(ws + WS_W4T);
      for (int i = gt; i < 2048 * 64; i += ngt) { const int c = i >> 6, k = i & 63; const float v = w4[k * 2048 + c]; const unsigned hi = f2bf(v); bf16_t* tr = tx + (size_t)c * 256 + k; tr[0] = (bf16_t)hi; tr[64] = (bf16_t)hi; tr[128] = (bf16_t)f2bf(v - bf2f(hi)); tr[192] = 0; } }
    if (mask & 4) {
        const float* x = p.in[0]; bf16_t* xb = (bf16_t*)(ws + WS_XB); float* rs = (float*)(ws + WS_ROWSS);
#pragma unroll 1
        for (int m = gw; m < L; m += ngw) {
            const f32x4* xr = (const f32x4*)(x + (size_t)m * DM) + lane; u32x2* o = (u32x2*)(xb + (size_t)m * DM) + lane; float s = 0.f;
#pragma unroll
            for (int j = 0; j < 8; ++j) { const f32x4 v = __builtin_nontemporal_load(xr + 64 * j); s += (v[0] * v[0] + v[1] * v[1]) + (v[2] * v[2] + v[3] * v[3]);
                u32x2 w; w.x = pk2(v[0], v[1]); w.y = pk2(v[2], v[3]); o[64 * j] = w; }
            s = wave_sum(s); if (lane == 0) rs[m] = s;
        }
    }
    __syncthreads();
    } else {
    __syncthreads();
    if (mask & 8) { LAS float* WL = (LAS float*)lds + 2048;
      for (int i = tid; i < 33 * 64; i += NT) WL[i] = p.in[9][i];
      for (int i = tid; i < 64 * 64; i += NT) { WL[33 * 64 + i] = p.in[12][i]; WL[33 * 64 + 64 * 64 + i] = p.in[15][i]; }
      __syncthreads();
#pragma unroll 1
      for (int ps = blockIdx.x; ps < L / 8; ps += G) { hid_pass(p, (LAS float*)lds, WL, ps * 8, tid); __syncthreads(); } }
    }
    }
}

__device__ __forceinline__ void convT_fetch(const bf16_t* phy, int tile, int tid, u32x4 (&rw)[4]) {
    const int t0 = (tile >> 4) * 64, c0 = (tile & 15) * 64;
#pragma unroll
    for (int k = 0; k < 4; ++k) { const int idx = tid + NT * k; rw[k] = (u32x4){0u, 0u, 0u, 0u};
        if (idx < 3 * 66 * 8) { const int s = idx / 528, r = (idx % 528) >> 3, c8 = (idx & 7) * 8, tt = t0 - 1 + r;
            if (tt >= 0 && tt < L) rw[k] = *(const u32x4*)(phy + (size_t)tt * PHY_LD + s * HYW + c0 + c8); } }
}
__device__ __forceinline__ void convT_tile(const Params& p, LAS unsigned char* lds, int tile, int tid, const u32x4 (&rw)[4]) {
    bf16_t* zT = (bf16_t*)(p.ws + WS_ZT); bf16_t* x0T = (bf16_t*)(p.ws + WS_X0T);
    const float* cw = p.in[7]; const float* cb = p.in[8];
    LAS float* zt = (LAS float*)lds; LAS float* xt = zt + 64 * 65;
    LAS bf16_t* raw = (LAS bf16_t*)(lds + 33280);
    const int t0 = (tile >> 4) * 64, c0 = (tile & 15) * 64;
#pragma unroll
    for (int k = 0; k < 4; ++k) { const int idx = tid + NT * k; if (idx < 3 * 66 * 8) { const int s = idx / 528, r = (idx % 528) >> 3, c8 = (idx & 7) * 8; *(LAS u32x4*)(raw + (s * 66 + r) * 64 + c8) = rw[k]; } }
    const int c = tid & 63, tg = tid >> 6;
    float w[3][3], b[3];
#pragma unroll
    for (int s = 0; s < 3; ++s) { const int col = s * HYW + c0 + c; b[s] = cb[col];
#pragma unroll
        for (int tap = 0; tap < 3; ++tap) w[s][tap] = cw[tap * 3 * HYW + col]; }
    __syncthreads();
#pragma unroll
    for (int i = 0; i < 8; ++i) {
        const int tl = tg * 8 + i; float u[3];
#pragma unroll
        for (int s = 0; s < 3; ++s) { float a = b[s];
#pragma unroll
            for (int tap = 0; tap < 3; ++tap) a += w[s][tap] * bf2f(raw[(s * 66 + tl + tap) * 64 + c]);
            u[s] = a; }
        zt[c * 65 + tl] = u[2] * u[1]; xt[c * 65 + tl] = u[0];
    }
    __syncthreads();
    { const int t = tid & 63, cg8 = tid >> 6;
#pragma unroll
      for (int i = 0; i < 8; ++i) { const int cc = cg8 * 8 + i; zT[(size_t)(c0 + cc) * L + t0 + t] = (bf16_t)f2bf(zt[cc * 65 + t]); x0T[(size_t)(c0 + cc) * L + t0 + t] = (bf16_t)f2bf(xt[cc * 65 + t]); } }
    __syncthreads();
}

__device__ __forceinline__ float logsig16(float x) { return (fminf(x, 0.f) - __logf(1.0f + __expf(-fabsf(x)))) * (1.0f / 16.0f); }
__device__ __forceinline__ bf16x8 ldfrag(const LAS bf16_t* base, int ld, int row0, int k0, int lane) { return *(const LAS bf16x8*)(base + (row0 + (lane & 15)) * ld + k0 + 8 * (lane >> 4)); }

__device__ __forceinline__ void gla_stage(const bf16_t* pr, const float* lr, int t0, int h, LAS float* lrs, LAS bf16_t* vT, int tid) {
    *(LAS f32x4*)(lrs + tid * 4) = *(const f32x4*)(lr + (size_t)t0 * 32 + tid * 4);
    { const int c = tid & 255, tb = tid >> 8; const bf16_t* vp = pr + (size_t)t0 * PR_LD + PR_V + h * 256 + c;
#pragma unroll
      for (int i = 0; i < 4; ++i) { const int tk = (tb * 4 + i) * 8; unsigned short e[8];
#pragma unroll
          for (int j = 0; j < 8; ++j) e[j] = vp[(size_t)(tk + j) * PR_LD];
          u32x4 w; w.x = e[0] | ((unsigned)e[1] << 16); w.y = e[2] | ((unsigned)e[3] << 16); w.z = e[4] | ((unsigned)e[5] << 16); w.w = e[6] | ((unsigned)e[7] << 16);
          *(LAS u32x4*)(vT + c * 72 + tk) = w; } }
}
struct GateW { float w[16]; float b; };
__device__ __forceinline__ void gate_load(const Params& p, int dir, int h, int d, GateW& g) {
    const float* wa = dir ? p.in[23] : p.in[21]; const float* ba = dir ? p.in[24] : p.in[22];
#pragma unroll
    for (int r = 0; r < 16; ++r) g.w[r] = wa[r * 512 + h * 128 + d];
    g.b = ba[h * 128 + d];
}
__device__ __forceinline__ float gate_eval(const GateW& g, const LAS float* lr) {
    const LAS f32x4* l4 = (const LAS f32x4*)lr; const f32x4 a = l4[0], b = l4[1], c = l4[2], d = l4[3];
    float x0 = g.b, x1 = 0.f, x2 = 0.f, x3 = 0.f;
#pragma unroll
    for (int r = 0; r < 4; ++r) { x0 += a[r] * g.w[r]; x1 += b[r] * g.w[4 + r]; x2 += c[r] * g.w[8 + r]; x3 += d[r] * g.w[12 + r]; }
    return logsig16((x0 + x1) + (x2 + x3));
}

__device__ __forceinline__ void gla_kv_item(const Params& p, LAS unsigned char* lds, int item, int tid, int lane, int wave) {
    const int h = item & 3, n = item >> 2, t0 = n * 64;
    const bf16_t* pr = (const bf16_t*)(p.ws + WS_PR); bf16_t* ST = (bf16_t*)(p.ws + WS_ST); float* dec = (float*)(p.ws + WS_DEC);
    LAS bf16_t* vT = (LAS bf16_t*)lds; LAS bf16_t* kstT = (LAS bf16_t*)(lds + 36864);
    LAS float* lrs = (LAS float*)(lds + 73728); LAS float* tot = (LAS float*)(lds + 81920);
    gla_stage(pr, (const float*)(p.ws + WS_LR), t0, h, lrs, vT, tid);
    const int d = tid & 127, dir = (tid >> 7) & 1, half = tid >> 8;
    GateW gw; gate_load(p, dir, h, d, gw);
    const bf16_t* kp = pr + (size_t)t0 * PR_LD + PR_K + h * 128 + d;
    unsigned short kr[8];
#pragma unroll
    for (int u = 0; u < 8; ++u) { const int q = half * 32 + u, t = dir ? 63 - q : q; kr[u] = kp[(size_t)t * PR_LD]; }
    __syncthreads();
    {
        float b = 0.f;
#pragma unroll 1
        for (int sg = 0; sg < 4; ++sg) {
            unsigned short kn[8];
#pragma unroll
            for (int u = 0; u < 8; ++u) { const int q = half * 32 + ((sg * 8 + 8 + u) & 31), t = dir ? 63 - q : q; kn[u] = kp[(size_t)t * PR_LD]; }
            unsigned ke[8];
#pragma unroll
            for (int u = 0; u < 8; ++u) { const int q = half * 32 + sg * 8 + u, t = dir ? 63 - q : q; b += gate_eval(gw, lrs + t * 32 + dir * 16);
                ke[dir ? 7 - u : u] = f2bf(bf2f(kr[u]) * __expf(-b)); }
            { const int q0 = half * 32 + sg * 8, tlo = dir ? 63 - q0 - 7 : q0; u32x4 w; w.x = ke[0] | (ke[1] << 16); w.y = ke[2] | (ke[3] << 16); w.z = ke[4] | (ke[5] << 16); w.w = ke[6] | (ke[7] << 16);
              *(LAS u32x4*)(kstT + (dir * 128 + d) * 72 + tlo) = w; }
#pragma unroll
            for (int u = 0; u < 8; ++u) kr[u] = kn[u];
        }
        tot[(dir * 2 + half) * 128 + d] = b;
    }
    __syncthreads();
    if (half == 0) { const float T0 = tot[(dir * 2 + 0) * 128 + d]; const size_t ti = ((size_t)(dir * 128 + n) * 4 + h) * 128 + d;
        dec[ti] = __expf(T0 + tot[(dir * 2 + 1) * 128 + d]); ((float*)(p.ws + WS_T0))[ti] = T0; }
    const int q4 = lane >> 4, v0 = wave * 32;
#pragma unroll 1
    for (int dr = 0; dr < 2; ++dr) {
        f32x4 acc[8][2];
#pragma unroll
        for (int mt = 0; mt < 8; ++mt) { acc[mt][0] = (f32x4){0.f, 0.f, 0.f, 0.f}; acc[mt][1] = (f32x4){0.f, 0.f, 0.f, 0.f}; }
#pragma unroll
        for (int ks = 0; ks < 2; ++ks) {
            const bf16x8 b0 = ldfrag(vT, 72, v0, 32 * ks, lane), b1 = ldfrag(vT, 72, v0 + 16, 32 * ks, lane);
#pragma unroll
            for (int mt = 0; mt < 8; ++mt) { const bf16x8 a = ldfrag(kstT + dr * 128 * 72, 72, 16 * mt, 32 * ks, lane);
                acc[mt][0] = __builtin_amdgcn_mfma_f32_16x16x32_bf16(a, b0, acc[mt][0], 0, 0, 0);
                acc[mt][1] = __builtin_amdgcn_mfma_f32_16x16x32_bf16(a, b1, acc[mt][1], 0, 0, 0); }
            if (ks == 0) {
#pragma unroll
                for (int mt = 0; mt < 8; ++mt) { const f32x4 T0 = *(const LAS f32x4*)(tot + (dr * 2 + 0) * 128 + 16 * mt + 4 * q4);
                    f32x4 rt;
#pragma unroll
                    for (int r = 0; r < 4; ++r) rt[r] = __expf(dr ? -T0[r] : T0[r]);
                    acc[mt][0] *= rt; acc[mt][1] *= rt; }
            }
        }
        bf16_t* S = ST + ((size_t)(dr * 4 + h) * 128 + n) * 32768;
#pragma unroll
        for (int mt = 0; mt < 8; ++mt) {
            const f32x4 T0 = *(const LAS f32x4*)(tot + (dr * 2 + 0) * 128 + 16 * mt + 4 * q4), T1 = *(const LAS f32x4*)(tot + (dr * 2 + 1) * 128 + 16 * mt + 4 * q4);
            f32x4 s1;
#pragma unroll
            for (int r = 0; r < 4; ++r) s1[r] = __expf(dr ? T0[r] + T1[r] : T1[r]);
#pragma unroll
            for (int nt = 0; nt < 2; ++nt) { const f32x4 v = acc[mt][nt] * s1; u32x2 w; w.x = pk2(v[0], v[1]); w.y = pk2(v[2], v[3]);
                *(u32x2*)(S + (size_t)(v0 + 16 * nt + (lane & 15)) * 128 + 16 * mt + 4 * q4) = w; }
        }
    }
    __syncthreads();
}

#ifndef REP_FA
#define REP_FA 0
#endif
#ifndef REP_FB
#define REP_FB 0
#endif
__device__ __forceinline__ void lr_task(const Params& p, LAS unsigned char* lds, int task, int tid, int lane, int wave) {
    const bf16_t* xb = (const bf16_t*)(p.ws + WS_XB); const bf16_t* wt = (const bf16_t*)(p.ws + WS_WIN) + (size_t)NING * DM;
    const float* rowss1 = (const float*)(p.ws + WS_ROWSS) + L; float* lr = (float*)(p.ws + WS_LR);
    const int mt = wave >> 2, nt = (wave >> 1) & 1, kh = wave & 1, fr = lane & 15, q4 = lane >> 4, t0 = task * 32;
    const bf16_t* ap = xb + (size_t)(t0 + 16 * mt + fr) * DM + kh * 1024 + 8 * q4; const bf16_t* bp = wt + (size_t)(16 * nt + fr) * DM + kh * 1024 + 8 * q4;
    f32x4 acc = (f32x4){0.f, 0.f, 0.f, 0.f};
#pragma unroll 1
    for (int kb = 0; kb < 2; ++kb) { bf16x8 a[16], b[16];
#pragma unroll
        for (int u = 0; u < 16; ++u) { a[u] = *(const bf16x8*)(ap + (kb * 16 + u) * 32); b[u] = *(const bf16x8*)(bp + (kb * 16 + u) * 32); }
#pragma unroll
        for (int u = 0; u < 16; ++u) acc = __builtin_amdgcn_mfma_f32_16x16x32_bf16(a[u], b[u], acc, 0, 0, 0); }
    LAS f32x4* ex = (LAS f32x4*)lds;
    if (kh) ex[(wave >> 1) * 64 + lane] = acc;
    __syncthreads();
    if (!kh) { const f32x4 o = ex[(wave >> 1) * 64 + lane];
#pragma unroll
        for (int r = 0; r < 4; ++r) { const int t = t0 + 16 * mt + 4 * q4 + r; lr[(size_t)t * 32 + 16 * nt + fr] = (acc[r] + o[r]) * pg8::rstd_of(rowss1[t]); } }
    __syncthreads();
}
__device__ __forceinline__ c2 cmul(c2 a, c2 b) { return mk2(a.x * b.x - a.y * b.y, a.x * b.y + a.y * b.x); }
__device__ __forceinline__ c2 twid(int m) { const float r = (float)m * (1.0f / 16384.0f); return mk2(__builtin_amdgcn_cosf(r), -__builtin_amdgcn_sinf(r)); }
__device__ __forceinline__ c2 cmulc(c2 a, c2 b) { return mk2(a.x * b.x + a.y * b.y, a.y * b.x - a.x * b.y); }
#define XI(i) ((i) + ((i) >> 5))
constexpr int XPAD_BYTES = (FN + FN / 32) * 8;
__constant__ const float C16c[8] = {1.f, 0.9238795325112867f, 0.7071067811865476f, 0.3826834323650898f, 0.f, -0.3826834323650898f, -0.7071067811865476f, -0.9238795325112867f};
__constant__ const float C16s[8] = {0.f, 0.3826834323650898f, 0.7071067811865476f, 0.9238795325112867f, 1.f, 0.9238795325112867f, 0.7071067811865476f, 0.3826834323650898f};
template <int R, bool INV, int UNR, bool ZHI = false, bool OLO = false> __device__ __forceinline__ void fft_pass(LAS c2* X, int lo, int tid) {
    constexpr int RAD = 1 << R;
    const int stride = 1 << lo, ls = lo + R - 1;
    int tt = tid; asm volatile("" : "+v"(tt));
#pragma unroll 1
    for (int g = tt; g < FN / RAD; g += NT) {
        const int j0 = g & (stride - 1), i = ((g - j0) << R) + j0;
        c2 e[RAD];
#pragma unroll
        for (int q = 0; q < RAD; ++q) e[q] = (ZHI && q >= RAD / 2) ? mk2(0.f, 0.f) : X[XI(i + q * stride)];
#pragma unroll
        for (int t = 0; t < R; ++t) {
            const int Hq = INV ? (1 << t) : (RAD >> (t + 1));
            const c2 base = twid(j0 << (INV ? (13 - lo - t) : (13 - ls + t)));
#pragma unroll
            for (int bf = 0; bf < RAD / 2; ++bf) {
                const int qm = bf & (Hq - 1), q = ((bf - qm) << 1) + qm, k16 = qm * (8 / Hq);
                const c2 w = (k16 == 0) ? base : cmul(base, mk2(C16c[k16], -C16s[k16]));
                if (!INV) { const c2 a = e[q], b = e[q + Hq]; e[q] = a + b; e[q + Hq] = cmul(a - b, w); }
                else { const c2 a = e[q], b = cmulc(e[q + Hq], w); e[q] = a + b; e[q + Hq] = a - b; }
            }
        }
#pragma unroll
        for (int q = 0; q < RAD; ++q) if (!(OLO && q >= RAD / 2)) X[XI(i + q * stride)] = e[q];
    }
    __syncthreads();
}
__device__ __forceinline__ void fft_dif(LAS c2* X, int tid) { fft_pass<4, false, 2>(X, 10, tid); fft_pass<4, false, 2>(X, 6, tid); fft_pass<4, false, 2>(X, 2, tid); fft_pass<2, false, 4>(X, 0, tid); }
__device__ __forceinline__ void fft_dif_zhi(LAS c2* X, int tid) { fft_pass<4, false, 2, true>(X, 10, tid); fft_pass<4, false, 2>(X, 6, tid); fft_pass<4, false, 2>(X, 2, tid); fft_pass<2, false, 4>(X, 0, tid); }
__device__ __forceinline__ void fft_dit_inv(LAS c2* X, int tid) { fft_pass<2, true, 4>(X, 0, tid); fft_pass<4, true, 2>(X, 2, tid); fft_pass<4, true, 2>(X, 6, tid); fft_pass<4, true, 2, false, true>(X, 10, tid); }
__device__ __forceinline__ int br14(int x) { return (int)(__brev((unsigned)x) >> 18); }
__device__ __forceinline__ float block_sum(float v, LAS float* red, int tid, int lane, int wave) {
    v = wave_sum(v); __syncthreads(); if (lane == 0) red[wave] = v; __syncthreads();
    float s = 0.f;
#pragma unroll
    for (int i = 0; i < 8; ++i) s += red[i];
    return s;
}
__device__ __forceinline__ void hyena_fft_pair(const Params& p, LAS unsigned char* lds, int pair, int tid, int lane, int wave) {
    const int c = pair * 2;
    const float* skip = p.in[19];
    bf16_t* zT = (bf16_t*)(p.ws + WS_ZT); const bf16_t* x0T = (const bf16_t*)(p.ws + WS_X0T);
    f32x4* SK = (f32x4*)(p.ws + WS_SK) + (size_t)blockIdx.x * SK_STRIDE;
    LAS c2* X = (LAS c2*)lds; LAS float* red = (LAS float*)(lds + XPAD_BYTES);
    const float dmin = -3.0701134573253945f, dmax = -15.350567286626973f;
    const float del0 = fabsf(dmin + (float)c * ((dmax - dmin) / 1023.0f)), del1 = fabsf(dmin + (float)(c + 1) * ((dmax - dmin) / 1023.0f));
    float n0 = 0.f, n1 = 0.f, inv0 = 0.f, inv1 = 0.f;
#pragma unroll 1
    for (int rb = 0; rb <= REP_FB; ++rb) {
    n0 = 0.f; n1 = 0.f;
    {
        const bf16_t* ff = (const bf16_t*)p.out + (size_t)c * L; const bf16_t* fb = (const bf16_t*)p.out + (size_t)(HYW + c) * L;
#pragma unroll 1
        for (int ub = 0; ub < 2; ++ub) { float f0[8], f1[8], g0[8], g1[8];
#pragma unroll
            for (int u = 0; u < 8; ++u) { const int i = tid + NT * (ub * 8 + u); f0[u] = bf2f(ff[i]); f1[u] = bf2f(ff[L + i]); g0[u] = bf2f(fb[i]); g1[u] = bf2f(fb[L + i]); }
#pragma unroll
            for (int u = 0; u < 8; ++u) { const int i = tid + NT * (ub * 8 + u);
                X[XI(i)] = mk2(f0[u], f1[u]); n0 += fabsf(f0[u]); n1 += fabsf(f1[u]);
                if (i >= 1) { X[XI(FN - i)] = mk2(g0[u], g1[u]); n0 += fabsf(g0[u]); n1 += fabsf(g1[u]); } } }
    }
    if (tid == 0) X[XI(L)] = mk2(0.f, 0.f);
    inv0 = 1.0f / block_sum(n0, red, tid, lane, wave); inv1 = 1.0f / block_sum(n1, red, tid, lane, wave);
    __syncthreads();
    fft_dif(X, tid);
#pragma unroll 2
    for (int m = tid; m < FN / 2; m += NT) { const int pp = 2 * m, k = br14(pp), pm = br14((FN - k) & (FN - 1)); const c2 F = X[XI(pp)], Fm = X[XI(pm)];
        SK[m] = (f32x4){0.5f * (F.x + Fm.x), 0.5f * (F.y - Fm.y), 0.5f * (F.y + Fm.y), -0.5f * (F.x - Fm.x)}; }
    if (tid == 0) { const c2 F = X[XI(1)]; SK[FN / 2] = (f32x4){F.x, 0.f, F.y, 0.f}; }
    __syncthreads();
    }
    { float za[16], zb[16];
#pragma unroll
      for (int u = 0; u < 16; ++u) { za[u] = bf2f(zT[(size_t)c * L + tid + NT * u]); zb[u] = bf2f(zT[(size_t)(c + 1) * L + tid + NT * u]); }
#pragma unroll
      for (int u = 0; u < 16; ++u) { X[XI(tid + NT * u)] = mk2(za[u], zb[u]); } }
    __syncthreads();
    fft_dif_zhi(X, tid);
#pragma unroll 2
    for (int m = tid; m < FN / 2; m += NT) {
        const int pp = 2 * m, k = br14(pp); const f32x4 kk = SK[m]; const c2 K1 = mk2(kk[0], kk[1]), K2 = mk2(kk[2], kk[3]);
        if (k == 0) { const c2 F = X[XI(0)]; X[XI(0)] = mk2(F.x * K1.x, F.y * K2.x);
            const f32x4 kh = SK[FN / 2]; const c2 F1 = X[XI(1)]; X[XI(1)] = mk2(F1.x * kh[0], F1.y * kh[2]); }
        else { const int pm = br14(FN - k); const c2 F = X[XI(pp)], Fm = X[XI(pm)];
            const c2 Z1 = mk2(0.5f * (F.x + Fm.x), 0.5f * (F.y - Fm.y)), Z2 = mk2(0.5f * (F.y + Fm.y), -0.5f * (F.x - Fm.x));
            const c2 A = cmul(Z1, K1), B = cmul(Z2, K2);
            X[XI(pp)] = mk2(A.x - B.y, A.y + B.x); X[XI(pm)] = mk2(A.x + B.y, -A.y + B.x); }
    }
    __syncthreads();
    fft_dit_inv(X, tid);
    const float sk0 = skip[c], sk1 = skip[c + 1], sc = 1.0f / (float)FN;
#pragma unroll 1
    for (int ub = 0; ub < 2; ++ub) { float z0[8], z1[8], x0[8], x1[8];
#pragma unroll
        for (int u = 0; u < 8; ++u) { const int i = tid + NT * (ub * 8 + u); const size_t o0 = (size_t)c * L + i, o1 = (size_t)(c + 1) * L + i; z0[u] = bf2f(zT[o0]); z1[u] = bf2f(zT[o1]); x0[u] = bf2f(x0T[o0]); x1[u] = bf2f(x0T[o1]); }
#pragma unroll
        for (int u = 0; u < 8; ++u) { const int i = tid + NT * (ub * 8 + u); const size_t o0 = (size_t)c * L + i, o1 = (size_t)(c + 1) * L + i; const c2 y = X[XI(i)];
            zT[o0] = (bf16_t)f2bf((y.x * sc * inv0 + sk0 * z0[u]) * x0[u]); zT[o1] = (bf16_t)f2bf((y.y * sc * inv1 + sk1 * z1[u]) * x1[u]); } }
    __syncthreads();
}
__device__ __forceinline__ void gla_scan(const Params& p, int tid) {
    unsigned* ST = (unsigned*)(p.ws + WS_ST); const float* dec = (const float*)(p.ws + WS_DEC);
    const int gt = blockIdx.x * NT + tid, ngt = gridDim.x * NT;
#pragma unroll 1
    for (int e = gt; e < 8 * 16384; e += ngt) {
        const int dh = e >> 14, idx = e & 16383, dir = dh >> 2, h = dh & 3, d = (2 * idx) & 127;
        unsigned* base = ST + (size_t)dh * 128 * 16384 + idx;
        const float* db = dec + ((size_t)dir * 128 * 4 + h) * 128 + d;
        float s0 = 0.f, s1 = 0.f;
#pragma unroll 1
        for (int nb = 0; nb < 128; nb += 16) {
            unsigned kv[16]; c2 dc[16];
#pragma unroll
            for (int u = 0; u < 16; ++u) { const int n = dir ? 127 - (nb + u) : nb + u; kv[u] = base[(size_t)n * 16384]; dc[u] = *(const c2*)(db + (size_t)n * 512); }
#pragma unroll
            for (int u = 0; u < 16; ++u) { const int n = dir ? 127 - (nb + u) : nb + u; base[(size_t)n * 16384] = pk2(s0, s1);
                s0 = dc[u].x * s0 + bf2f(kv[u] & 0xffffu); s1 = dc[u].y * s1 + bf2f(kv[u] >> 16); }
        }
    }
}

__device__ __forceinline__ void gla_out_item(const Params& p, LAS unsigned char* lds, int item, int tid, int lane, int wave) {
    const int h = item & 3, n = item >> 2, t0 = n * 64;
    const bf16_t* pr = (const bf16_t*)(p.ws + WS_PR); const bf16_t* ST = (const bf16_t*)(p.ws + WS_ST); bf16_t* mix = (bf16_t*)(p.ws + WS_MIX);
    const float* og = p.in[25];
    LAS bf16_t* qin = (LAS bf16_t*)lds;
    LAS bf16_t* kin = (LAS bf16_t*)(lds + 34816);
    LAS bf16_t* vT = (LAS bf16_t*)(lds + 69632);
    LAS bf16_t* P = (LAS bf16_t*)(lds + 106496);
    LAS float* lrs = (LAS float*)(lds + 115712); LAS float* tot = (LAS float*)(lds + 123904); LAS float* red = (LAS float*)(lds + 125952);
    gla_stage(pr, (const float*)(p.ws + WS_LR), t0, h, lrs, vT, tid);
    const int d = tid & 127, dir = (tid >> 7) & 1, half = tid >> 8;
    GateW gw; gate_load(p, dir, h, d, gw);
    const bf16_t* qp = pr + (size_t)t0 * PR_LD + PR_Q + h * 128 + d;
    unsigned short kr[8], qr[8];
#pragma unroll
    for (int u = 0; u < 8; ++u) { const int q = half * 32 + u, t = dir ? 63 - q : q; qr[u] = qp[(size_t)t * PR_LD]; kr[u] = qp[(size_t)t * PR_LD + (PR_K - PR_Q)]; }
    const float bpre = half ? ((const float*)(p.ws + WS_T0))[((size_t)(dir * 128 + n) * 4 + h) * 128 + d] : 0.f;
    __syncthreads();
    {
        float b = bpre;
#pragma unroll 1
        for (int sg = 0; sg < 4; ++sg) {
            unsigned short kn[8], qn[8];
#pragma unroll
            for (int u = 0; u < 8; ++u) { const int q = half * 32 + ((sg * 8 + 8 + u) & 31), t = dir ? 63 - q : q; qn[u] = qp[(size_t)t * PR_LD]; kn[u] = qp[(size_t)t * PR_LD + (PR_K - PR_Q)]; }
#pragma unroll
            for (int u = 0; u < 8; ++u) { const int q = half * 32 + sg * 8 + u, t = dir ? 63 - q : q; b += gate_eval(gw, lrs + t * 32 + dir * 16);
                const float qv = bf2f(qr[u]) * 0.08838834764831845f, kv = bf2f(kr[u]);
                qin[(dir * 64 + t) * 136 + d] = (bf16_t)f2bf(qv * __expf(b)); kin[(dir * 64 + t) * 136 + d] = (bf16_t)f2bf(kv * __expf(-b)); }
#pragma unroll
            for (int u = 0; u < 8; ++u) { kr[u] = kn[u]; qr[u] = qn[u]; }
        }
    }
    __syncthreads();
    const int q4 = lane >> 4, fr = lane & 15;
#pragma unroll 1
    for (int ti = 0; ti < 2; ++ti) {
        const int id = wave * 2 + ti, tt = id >> 2, st = id & 3;
        f32x4 af = (f32x4){0.f, 0.f, 0.f, 0.f}, ab = (f32x4){0.f, 0.f, 0.f, 0.f};
        if (tt >= st) {
#pragma unroll
            for (int ks = 0; ks < 4; ++ks) af = __builtin_amdgcn_mfma_f32_16x16x32_bf16(ldfrag(qin, 136, 16 * tt, 32 * ks, lane), ldfrag(kin, 136, 16 * st, 32 * ks, lane), af, 0, 0, 0); }
        if (tt <= st) {
#pragma unroll
            for (int ks = 0; ks < 4; ++ks) ab = __builtin_amdgcn_mfma_f32_16x16x32_bf16(ldfrag(qin + 64 * 136, 136, 16 * tt, 32 * ks, lane), ldfrag(kin + 64 * 136, 136, 16 * st, 32 * ks, lane), ab, 0, 0, 0); }
#pragma unroll
        for (int r = 0; r < 4; ++r) { const int t = 16 * tt + 4 * q4 + r, s = 16 * st + fr; P[t * 72 + s] = (bf16_t)f2bf(t >= s ? af[r] : ab[r]); }
    }
    __syncthreads();
    f32x4 acc[2][4];
#pragma unroll
    for (int mt = 0; mt < 2; ++mt)
#pragma unroll
        for (int nt = 0; nt < 4; ++nt) acc[mt][nt] = (f32x4){0.f, 0.f, 0.f, 0.f};
    const int v0 = wave * 32;
#pragma unroll
    for (int ks = 0; ks < 2; ++ks) {
        const bf16x8 a0 = ldfrag(vT, 72, v0, 32 * ks, lane), a1 = ldfrag(vT, 72, v0 + 16, 32 * ks, lane);
#pragma unroll
        for (int nt = 0; nt < 4; ++nt) { const bf16x8 b = ldfrag(P, 72, 16 * nt, 32 * ks, lane);
            acc[0][nt] = __builtin_amdgcn_mfma_f32_16x16x32_bf16(a0, b, acc[0][nt], 0, 0, 0); acc[1][nt] = __builtin_amdgcn_mfma_f32_16x16x32_bf16(a1, b, acc[1][nt], 0, 0, 0); }
    }
#pragma unroll 1
    for (int dr = 0; dr < 2; ++dr) {
        const bf16_t* S = ST + ((size_t)(dr * 4 + h) * 128 + n) * 32768;
        bf16x8 sa[4][2];
#pragma unroll
        for (int ks = 0; ks < 4; ++ks) { sa[ks][0] = *(const bf16x8*)(S + (size_t)(v0 + fr) * 128 + 32 * ks + 8 * q4); sa[ks][1] = *(const bf16x8*)(S + (size_t)(v0 + 16 + fr) * 128 + 32 * ks + 8 * q4); }
#pragma unroll
        for (int ks = 0; ks < 4; ++ks)
#pragma unroll
            for (int nt = 0; nt < 4; ++nt) { const bf16x8 b = ldfrag(qin + dr * 64 * 136, 136, 16 * nt, 32 * ks, lane);
                acc[0][nt] = __builtin_amdgcn_mfma_f32_16x16x32_bf16(sa[ks][0], b, acc[0][nt], 0, 0, 0); acc[1][nt] = __builtin_amdgcn_mfma_f32_16x16x32_bf16(sa[ks][1], b, acc[1][nt], 0, 0, 0); }
    }
#pragma unroll
    for (int nt = 0; nt < 4; ++nt) { float ss = 0.f;
#pragma unroll
        for (int mt = 0; mt < 2; ++mt) ss += (acc[mt][nt][0] * acc[mt][nt][0] + acc[mt][nt][1] * acc[mt][nt][1]) + (acc[mt][nt][2] * acc[mt][nt][2] + acc[mt][nt][3] * acc[mt][nt][3]);
        ss += __shfl_xor(ss, 16); ss += __shfl_xor(ss, 32);
        if (q4 == 0) red[wave * 64 + 16 * nt + fr] = ss; }
    __syncthreads();
#pragma unroll
    for (int nt = 0; nt < 4; ++nt) { const int t = 16 * nt + fr; float ss = 0.f;
#pragma unroll
        for (int w = 0; w < 8; ++w) ss += red[w * 64 + t];
        const float rs = rsqrtf(ss * (1.0f / 256.0f) + 1e-6f);
#pragma unroll
        for (int mt = 0; mt < 2; ++mt) { const int v = v0 + 16 * mt + 4 * q4; const f32x4 g = *(const f32x4*)(og + h * 256 + v);
            const u32x2 rw = *(const u32x2*)(pr + (size_t)(t0 + t) * PR_LD + PR_R + h * 256 + v);
            const float r0 = bf2f(rw.x & 0xffffu), r1 = bf2f(rw.x >> 16), r2 = bf2f(rw.y & 0xffffu), r3 = bf2f(rw.y >> 16);
            u32x2 w; w.x = pk2(acc[mt][nt][0] * rs * g[0] * silu_f(r0), acc[mt][nt][1] * rs * g[1] * silu_f(r1));
            w.y = pk2(acc[mt][nt][2] * rs * g[2] * silu_f(r2), acc[mt][nt][3] * rs * g[3] * silu_f(r3));
            *(u32x2*)(mix + (size_t)(t0 + t) * DM + HYW + h * 256 + v) = w; }
    }
    __syncthreads();
}
__device__ __forceinline__ void hynorm_tile(const Params& p, LAS unsigned char* lds, int tile, int tid) {
    const bf16_t* yT = (const bf16_t*)(p.ws + WS_ZT); bf16_t* mix = (bf16_t*)(p.ws + WS_MIX); const float* og = p.in[20];
    LAS float* yt = (LAS float*)lds; LAS float* red = yt + 128 * 65;
    const int g = tile & 7, t0 = (tile >> 3) * 64, c0 = g * 128;
    { const int t = tid & 63, cg8 = tid >> 6; float ss = 0.f;
#pragma unroll
      for (int i = 0; i < 16; ++i) { const int cc = cg8 * 16 + i; const float v = bf2f(yT[(size_t)(c0 + cc) * L + t0 + t]); yt[cc * 65 + t] = v; ss += v * v; }
      red[cg8 * 64 + t] = ss; }
    __syncthreads();
    { const int c2 = (tid & 63) * 2, tg = tid >> 6; const float g0 = og[c0 + c2], g1 = og[c0 + c2 + 1];
#pragma unroll
      for (int i = 0; i < 8; ++i) { const int t = tg * 8 + i; float ss = 0.f;
#pragma unroll
          for (int w = 0; w < 8; ++w) ss += red[w * 64 + t];
          const float rs = rsqrtf(ss * (1.0f / 128.0f) + 1e-6f);
          *(unsigned*)(mix + (size_t)(t0 + t) * DM + c0 + c2) = pk2(yt[c2 * 65 + t] * rs * g0, yt[(c2 + 1) * 65 + t] * rs * g1); } }
    __syncthreads();
}

#define XB_TMO      128
#define XB_XCNT(j)  (256  + 64 * (j))
#define XB_XSUB(j)  (1280 + 64 * (j))
#define XB_XGEN(j)  (2304 + 64 * (j))
#define XB_TOP      3328
#define XB_TOPGEN   3392
#define XCD_BAR_WORDS 3456
#define XB_SPIN_CAP (1u << 18)

__device__ __forceinline__ unsigned xb_ld(unsigned* p)              { return __hip_atomic_load(p, __ATOMIC_RELAXED, __HIP_MEMORY_SCOPE_AGENT); }
__device__ __forceinline__ unsigned xb_add(unsigned* p, unsigned v) { return __hip_atomic_fetch_add(p, v, __ATOMIC_RELAXED, __HIP_MEMORY_SCOPE_AGENT); }
__device__ __forceinline__ unsigned xb_xcc_id() { return (unsigned)__builtin_amdgcn_s_getreg((3 << 11) | 20) & 0xFu; }
#define XB_SPIN(cond, bar) do { unsigned _sp = 0; while (cond) { __builtin_amdgcn_s_sleep(1); \
    if ((++_sp & 255u) == 0u) { if (xb_ld(&(bar)[XB_TMO])) break; if (_sp > XB_SPIN_CAP) { atomicAdd(&(bar)[XB_TMO], 1u); break; } } } } while (0)

struct XcdBarrier {
    unsigned* bar; unsigned x;
    volatile LAS unsigned* st;
};

__device__ __forceinline__ XcdBarrier xcd_barrier_post(unsigned* bar, volatile LAS unsigned* st) {
    XcdBarrier b; b.bar = bar; b.x = xb_xcc_id(); b.st = st;
    if (threadIdx.x == 0) (void)xb_add(&bar[XB_XCNT(b.x)], 1u);
    return b;
}
__device__ __forceinline__ void xcd_barrier_complete(unsigned* bar, unsigned x, unsigned& nloc, unsigned& nx) {
    const unsigned G = gridDim.x * gridDim.y * gridDim.z;
    unsigned sum, cnt, mine, sp = 0u;
    for (;;) {
        sum = 0u; cnt = 0u; mine = 0u;
#pragma unroll
        for (unsigned j = 0; j < 16; ++j) { const unsigned c = xb_ld(&bar[XB_XCNT(j)]); sum += c; cnt += (c > 0u) ? 1u : 0u; mine = (j == x) ? c : mine; }
        if (sum == G) break;
        __builtin_amdgcn_s_sleep(1);
        if ((++sp & 255u) == 0u) { if (xb_ld(&bar[XB_TMO])) break; if (sp > XB_SPIN_CAP) { atomicAdd(&bar[XB_TMO], 1u); break; } }
    }
    nloc = mine > 0u ? mine : 1u; nx = cnt > 0u ? cnt : 1u;
}

__device__ __forceinline__ void xcd_barrier(const XcdBarrier& b) {
    asm volatile("s_waitcnt vmcnt(0)" ::: "memory");
    __syncthreads();
    if (threadIdx.x == 0) {
        unsigned* bar = b.bar;
        __builtin_amdgcn_s_waitcnt(0);
        unsigned nloc = b.st[0], nx = b.st[1]; const unsigned bx = b.st[2];
        if (nloc == 0u) { xcd_barrier_complete(bar, bx, nloc, nx); b.st[0] = nloc; b.st[1] = nx; }
        const unsigned old = xb_add(&bar[XB_XSUB(bx)], 1u);
        const unsigned gen = old / nloc;
        if (old + 1u == (gen + 1u) * nloc) {
            __builtin_amdgcn_fence(__ATOMIC_RELEASE, "agent");
            asm volatile("s_waitcnt vmcnt(0)" ::: "memory");
            const unsigned og = xb_add(&bar[XB_TOP], 1u);
            const unsigned tg = og / nx;
            if (og + 1u == (tg + 1u) * nx) xb_add(&bar[XB_TOPGEN], 1u);
            else XB_SPIN(xb_ld(&bar[XB_TOPGEN]) == tg, bar);
            __builtin_amdgcn_fence(__ATOMIC_ACQUIRE, "agent");
            xb_add(&bar[XB_XGEN(bx)], 1u);
            asm volatile("s_waitcnt vmcnt(0)" ::: "memory");
        } else {
            XB_SPIN(xb_ld(&bar[XB_XGEN(bx)]) == gen, bar);
            __builtin_amdgcn_fence(__ATOMIC_ACQUIRE, "agent");
            asm volatile("s_waitcnt vmcnt(0)" ::: "memory");
        }
    }
    __syncthreads();
}

#ifndef REP_P0
#define REP_P0 0
#endif
#ifndef PA_MASK
#define PA_MASK 3
#endif
#ifndef PC_MASK
#define PC_MASK 3
#endif
#ifndef REP_G1
#define REP_G1 0
#endif
#ifndef REP_G3
#define REP_G3 0
#endif
#ifndef P0_MASK
#define P0_MASK 15
#endif
#ifndef REP_PA
#define REP_PA 0
#endif
#ifndef REP_PAB
#define REP_PAB 0
#endif
#ifndef REP_PC
#define REP_PC 0
#endif
__global__ void __launch_bounds__(NT, 2) fwd_megakernel(Params p) {
    extern __shared__ __attribute__((aligned(16))) unsigned char smem[];
    LAS unsigned char* lds = (LAS unsigned char*)smem;
    cg::grid_group grid = cg::this_grid();
    const int G = gridDim.x;
    volatile LAS unsigned* bst = (volatile LAS unsigned*)(lds + LDS_BYTES - 64);
    if (threadIdx.x < 2) bst[threadIdx.x] = 0u;
    __syncthreads();
    XcdBarrier xbar = xcd_barrier_post((unsigned*)(p.ws + WS_BAR), bst);
    if (threadIdx.x == 0) bst[2] = xbar.x;
    if (p.ws == nullptr) grid.sync();
#define TIDS int tid = threadIdx.x; asm volatile("" : "+v"(tid)); const int lane = tid & 63, wave = __builtin_amdgcn_readfirstlane(tid >> 6); (void)lane; (void)wave;
    unsigned char* ws = p.ws;
    float* rowss = (float*)(ws + WS_ROWSS);
    bf16_t* XB = (bf16_t*)(ws + WS_XB); bf16_t* AB = (bf16_t*)(ws + WS_A);

#pragma unroll 1
    for (int rep = 0; rep <= REP_P0; ++rep) {
#ifndef SKIP_P0
        { TIDS; phase0(p, lds, tid, lane, wave, rep == 0 ? 15 : P0_MASK); }
#endif
        xcd_barrier(xbar); }
#ifndef NO_GEMM
#pragma unroll 1
    for (int rg = 0; rg <= REP_G1; ++rg) {
    { pg8::Gemm g{XB, (const bf16_t*)(ws + WS_WFF), L, 2 * FF, DM}; pg8::StaticOrder S; S.init(L, 2 * FF, G, (int)blockIdx.x);
      pg8::EpiSwiGLU E{AB, FF, rowss}; pg8::gemm_phase<pg8::EpiSwiGLU, pg8::StaticOrder, true, true>(lds, g, S, E); }
    { TIDS; const int rem = ((L / 256) * (2 * FF / 256)) % G, nl = rem ? G - rem : G, li = rem ? (int)blockIdx.x - rem : (int)blockIdx.x;
      if (li >= 0) convert_tail1(p, lds, li * 8 + wave, nl * 8, lane, wave); }
    xcd_barrier(xbar);
    }
    { pg8::Gemm g{AB, (const bf16_t*)(ws + WS_WDN), L, DM, FF}; pg8::StaticOrder S; S.init(L, DM, G, (int)blockIdx.x);
      pg8::EpiResid E{p.in[0], nullptr, XB, rowss + L, 0.5f}; pg8::gemm_phase<pg8::EpiResid, pg8::StaticOrder, true, true>(lds, g, S, E); }
    xcd_barrier(xbar);
#pragma unroll 1
    for (int rg = 0; rg <= REP_G3; ++rg) {
    { pg8::Gemm g{XB, (const bf16_t*)(ws + WS_WIN), L, NING, DM}; pg8::StaticOrder S; S.init(L, NING, G, (int)blockIdx.x);
      pg8::EpiP E{(bf16_t*)(ws + WS_PHY), (bf16_t*)(ws + WS_PR), rowss + L}; pg8::gemm_phase<pg8::EpiP, pg8::StaticOrder, true, true>(lds, g, S, E); }
    { TIDS; for (int it = blockIdx.x; it < L / 32; it += G) lr_task(p, lds, it, tid, lane, wave); }
    xcd_barrier(xbar);
    }
#endif
#pragma unroll 1
    for (int rep = 0; rep <= REP_PAB; ++rep) {
#pragma unroll 1
        for (int r2 = 0; r2 <= REP_PA; ++r2) {
#ifndef SKIP_PA
            { pg8::Gemm g{(const bf16_t*)(ws + WS_W4T), (const bf16_t*)(ws + WS_HID), 2048, L, 256}; pg8::StaticOrder S; S.init(2048, L, G, (int)blockIdx.x);
              pg8::EpiFilt E{(bf16_t*)p.out, (bf16_t*)p.out + (size_t)HYW * L, (bf16_t*)p.out + (size_t)(HYW + 768) * L}; pg8::gemm_phase<pg8::EpiFilt, pg8::StaticOrder, true, true>(lds, g, S, E); }
            if (r2 == 0 || (PA_MASK & 1)) { TIDS; for (int it = blockIdx.x; it < 512; it += G) gla_kv_item(p, lds, it, tid, lane, wave); }
            if (r2 == 0 || (PA_MASK & 2)) { TIDS; const bf16_t* phy = (const bf16_t*)(ws + WS_PHY); u32x4 rw[4], rn[4];
              if ((int)blockIdx.x < 2048) convT_fetch(phy, blockIdx.x, tid, rw);
#pragma unroll 1
              for (int it = blockIdx.x; it < 2048; it += G) { const bool more = it + G < 2048; if (more) convT_fetch(phy, it + G, tid, rn);
                  convT_tile(p, lds, it, tid, rw);
                  if (more) {
#pragma unroll
                      for (int k = 0; k < 4; ++k) rw[k] = rn[k]; } } }
#endif
            xcd_barrier(xbar);
        }
#ifndef SKIP_PB
        { TIDS; gla_scan(p, tid); }
        { TIDS; for (int it = blockIdx.x; it < HYW / 2; it += G) hyena_fft_pair(p, lds, it, tid, lane, wave); }
#endif
        xcd_barrier(xbar);
    }
#pragma unroll 1
    for (int rep = 0; rep <= REP_PC; ++rep) {
#ifndef SKIP_PC
        if (rep == 0 || (PC_MASK & 1)) { TIDS; for (int it = blockIdx.x; it < 512; it += G) gla_out_item(p, lds, it, tid, lane, wave); }
        if (rep == 0 || (PC_MASK & 2)) { TIDS; for (int it = blockIdx.x; it < 1024; it += G) hynorm_tile(p, lds, it, tid); }
#endif
        xcd_barrier(xbar);
    }
#ifndef NO_GEMM
    { pg8::Gemm g{(const bf16_t*)(ws + WS_MIX), (const bf16_t*)(ws + WS_WOUT), L, DM, DM}; pg8::StaticOrder S; S.init(L, DM, G, (int)blockIdx.x);
      pg8::EpiResid E{nullptr, XB, XB, rowss + 2 * L, 1.0f}; pg8::gemm_phase<pg8::EpiResid, pg8::StaticOrder, true, true>(lds, g, S, E); }
    __syncthreads();
    { TIDS; convert_gu(p.in[28], p.in[29], p.in[27], ws, lds, blockIdx.x * 8 + wave, G * 8, lane, wave); }
    xcd_barrier(xbar);
    { pg8::Gemm g{XB, (const bf16_t*)(ws + WS_WFF), L, 2 * FF, DM}; pg8::StaticOrder S; S.init(L, 2 * FF, G, (int)blockIdx.x);
      pg8::EpiSwiGLU E{AB, FF, rowss + 2 * L}; pg8::gemm_phase<pg8::EpiSwiGLU, pg8::StaticOrder, true, true>(lds, g, S, E); }
    { TIDS; const int rem = ((L / 256) * (2 * FF / 256)) % G, nl = rem ? G - rem : G, li = rem ? (int)blockIdx.x - rem : (int)blockIdx.x;
      if (li >= 0) convert_dn(p.in[30], ws, lds, li * 8 + wave, nl * 8, lane, wave); }
    xcd_barrier(xbar);
    { pg8::Gemm g{AB, (const bf16_t*)(ws + WS_WDN), L, DM, FF}; pg8::StaticOrder S; S.init(L, DM, G, (int)blockIdx.x);
      pg8::EpiFinal E{XB, p.out, rowss + 3 * L, (unsigned*)(ws + WS_PCNT), p.in[31], 0.5f}; pg8::gemm_phase<pg8::EpiFinal, pg8::StaticOrder, true, true>(lds, g, S, E); }
#endif
}

extern "C" void kernel_launch(void* const* d_in, const int* in_sizes, int n_in, void* d_out, int out_size, void* d_ws, size_t ws_size, hipStream_t stream) {
    static int grid = 0;
    if (grid == 0) {
        if (n_in != 32 || out_size != L * DM || ws_size < WS_END) { fprintf(stderr, "kernel_launch: unexpected problem: n_in %d out %d ws %zu (need %zu)\n", n_in, out_size, ws_size, (size_t)WS_END); grid = -1; return; }
        int dev = 0, cus = 0, per_cu = 0;
        (void)hipGetDevice(&dev); (void)hipDeviceGetAttribute(&cus, hipDeviceAttributeMultiprocessorCount, dev);
        if (hipFuncSetAttribute((const void*)fwd_megakernel, hipFuncAttributeMaxDynamicSharedMemorySize, LDS_BYTES) != hipSuccess) { fprintf(stderr, "kernel_launch: hipFuncSetAttribute failed\n"); grid = -1; return; }
        if (hipOccupancyMaxActiveBlocksPerMultiprocessor(&per_cu, (const void*)fwd_megakernel, NT, LDS_BYTES) != hipSuccess || per_cu < 1) { fprintf(stderr, "kernel_launch: occupancy query gave %d\n", per_cu); per_cu = 1; }
        (void)hipGetLastError();
        grid = cus * per_cu; if (grid > 256) grid = 256;
        if (grid != 256) { fprintf(stderr, "kernel_launch: this kernel needs a 256-workgroup cooperative grid (256 CUs x 1), got %d; nothing launched\n", grid); grid = -1; return; }
        fprintf(stderr, "kernel_launch: cus %d per_cu %d grid %d\n", cus, per_cu, grid);
    }
    if (grid < 0) return;
    Params p{};
    for (int i = 0; i < 32; ++i) p.in[i] = (const float*)d_in[i];
    p.out = (float*)d_out; p.ws = (unsigned char*)d_ws;
    if (hipMemsetAsync((char*)d_ws + WS_BAR, 0, 16384 + 32 * 256, stream) != hipSuccess) { fprintf(stderr, "kernel_launch: hipMemsetAsync failed\n"); return; }
    void* args[] = {&p};
    hipError_t e = hipLaunchCooperativeKernel((const void*)fwd_megakernel, dim3(grid), dim3(NT), args, LDS_BYTES, stream);
    if (e != hipSuccess) fprintf(stderr, "kernel_launch: cooperative launch failed: %s (grid %d)\n", hipGetErrorString(e), grid);
}
```
